# Optimizing an MI355X kernel written in HIP

```python
import jax, jax.numpy as jnp
from jax import lax
import numpy as np

D_MODEL = 2048
BATCH = 2
SEQ = 4096
DEPTH = 1

GLA_HEADS = 4
GLA_VAL = D_MODEL // 2
GLA_DV = GLA_VAL // GLA_HEADS
GLA_DK = GLA_DV // 2
GLA_KEY = GLA_HEADS * GLA_DK
GLA_LR = 16
GLA_TAU = 16.0
GLA_CHUNK = 64
RW_HEAD = 64
RW_WIDTH = D_MODEL // 2
RW_HEADS = RW_WIDTH // RW_HEAD
RW_W_LR = 64
RW_A_LR = 64
RW_G_LR = 128
RW_DECAY_SCALE = 0.606531
RW_LN_EPS = 64e-5
N_EXPERTS = 16
CAPACITY = 2
D_FF_EXPERT = D_MODEL // 2
DEEPNORM_ALPHA = (2 * DEPTH) ** 0.25
DEEPNORM_BETA = (8 * DEPTH) ** -0.25
LN_EPS = 1e-5

GLA_SPLITS = (GLA_KEY, GLA_KEY, GLA_VAL, GLA_VAL, GLA_LR, GLA_LR)
RW_SPLITS = (RW_WIDTH, RW_WIDTH, RW_WIDTH, RW_W_LR, RW_W_LR, RW_A_LR, RW_G_LR)
GLA_COLS = sum(GLA_SPLITS)
RW_COLS = sum(RW_SPLITS)
N_IN_COLS = GLA_COLS + RW_COLS + 2 * D_MODEL

kernel_name = 'hybrid_gla_rwkv7_ecmoe_deepnorm'


def _split(t, sizes):
    return jnp.split(t, np.cumsum(sizes)[:-1].tolist(), axis=-1)


def _rev(t):
    return jnp.flip(t, axis=1)


def layer_norm(x, g, b):
    xf = x.astype(jnp.float32)
    mu = jnp.mean(xf, -1, keepdims=True)
    var = jnp.mean(jnp.square(xf - mu), -1, keepdims=True)
    return ((xf - mu) * lax.rsqrt(var + LN_EPS) * g.astype(jnp.float32) + b.astype(jnp.float32)).astype(x.dtype)


def gla_chunked(q, k, v, log_a):
    B, S, H, K = q.shape
    V = v.shape[-1]
    C = GLA_CHUNK
    n = S // C

    def blocks(t):
        return t.astype(jnp.float32).reshape(B, n, C, H, t.shape[-1]).transpose(1, 0, 3, 2, 4)

    tri = jnp.tril(jnp.ones((C, C), dtype=bool))

    def step(state, inp):
        qc, kc, vc, gc = inp
        b = jnp.cumsum(gc, axis=2)
        diff = jnp.where(tri[:, :, None], b[:, :, :, None, :] - b[:, :, None, :, :], -jnp.inf)
        att = jnp.einsum('bhik,bhjk,bhijk->bhij', qc, kc, jnp.exp(diff))
        o = jnp.einsum('bhij,bhjv->bhiv', att, vc) + jnp.einsum('bhik,bhkv->bhiv', qc * jnp.exp(b), state)
        b_last = b[:, :, -1:, :]
        state = state * jnp.exp(b_last[:, :, 0, :, None]) + jnp.einsum('bhjk,bhjv->bhkv', kc * jnp.exp(b_last - b), vc)
        return state, o

    state0 = jnp.zeros((B, H, K, V), jnp.float32)
    _, o = lax.scan(step, state0, (blocks(q), blocks(k), blocks(v), blocks(log_a)))
    return o.transpose(1, 0, 3, 2, 4).reshape(B, S, H, V)


def gla_branch(q, k, v, g, af, ab, a_up_f, a_bias_f, a_up_b, a_bias_b, norm_g):
    B, S, _ = q.shape
    qh = q.reshape(B, S, GLA_HEADS, GLA_DK) * (GLA_DK ** -0.5)
    kh = k.reshape(B, S, GLA_HEADS, GLA_DK)
    vh = v.reshape(B, S, GLA_HEADS, GLA_DV)
    log_f = (jax.nn.log_sigmoid((af @ a_up_f + a_bias_f).astype(jnp.float32)) / GLA_TAU).reshape(B, S, GLA_HEADS, GLA_DK)
    log_b = (jax.nn.log_sigmoid((ab @ a_up_b + a_bias_b).astype(jnp.float32)) / GLA_TAU).reshape(B, S, GLA_HEADS, GLA_DK)
    o = gla_chunked(qh, kh, vh, log_f) + _rev(gla_chunked(_rev(qh), _rev(kh), _rev(vh), _rev(log_b)))
    o = o * lax.rsqrt(jnp.mean(jnp.square(o), -1, keepdims=True) + LN_EPS)
    o = o.reshape(B, S, GLA_VAL) * norm_g.astype(jnp.float32)
    return (o * jax.nn.silu(g.astype(jnp.float32))).astype(q.dtype)


def rwkv7_scan(r, w, k, v, a, b):
    Bsz, S, H, N = r.shape

    def step(st, inp):
        r_t, w_t, k_t, v_t, a_t, b_t = inp
        sa = jnp.einsum('bhvk,bhk->bhv', st, a_t)
        st = st * w_t[:, :, None, :] + sa[..., None] * b_t[:, :, None, :] + v_t[..., None] * k_t[:, :, None, :]
        return st, jnp.einsum('bhvk,bhk->bhv', st, r_t)

    xs = tuple(jnp.moveaxis(t.astype(jnp.float32), 1, 0) for t in (r, w, k, v, a, b))
    _, y = lax.scan(step, jnp.zeros((Bsz, H, N, N), jnp.float32), xs)
    return jnp.moveaxis(y, 0, 1)


def rwkv_branch(p, mu, w0_f, w_up_f, w0_b, w_up_b, a0, a_up, g_up, k_k, k_a, r_k, ln_g, ln_b):
    B, S, _ = p.shape
    prev = jnp.pad(p, ((0, 0), (1, 0), (0, 0)))[:, :-1]
    nxt = jnp.pad(p, ((0, 0), (0, 1), (0, 0)))[:, 1:]
    p = p + mu * (0.5 * (prev + nxt) - p)
    r, k, v, xwf, xwb, xa, xg = _split(p, RW_SPLITS)
    f32 = jnp.float32
    w_f = jnp.exp(-RW_DECAY_SCALE * jax.nn.sigmoid((w0_f + jnp.tanh(xwf) @ w_up_f).astype(f32)))
    w_b = jnp.exp(-RW_DECAY_SCALE * jax.nn.sigmoid((w0_b + jnp.tanh(xwb) @ w_up_b).astype(f32)))
    a = jax.nn.sigmoid((a0 + xa @ a_up).astype(f32))
    g = (jax.nn.sigmoid(xg) @ g_up).astype(f32)
    heads = lambda t: t.astype(f32).reshape(B, S, RW_HEADS, RW_HEAD)
    kk = heads(k * k_k)
    kk = kk / jnp.maximum(jnp.sqrt(jnp.sum(jnp.square(kk), -1, keepdims=True)), 1e-12)
    k = k.astype(f32) * (1.0 + (a - 1.0) * k_a.astype(f32))
    rh, kh, vh, ah = heads(r), heads(k), heads(v), heads(a)
    wfh, wbh = heads(w_f), heads(w_b)
    a_vec, b_vec = -kk, kk * ah
    y = rwkv7_scan(rh, wfh, kh, vh, a_vec, b_vec) + _rev(rwkv7_scan(_rev(rh), _rev(wbh), _rev(kh), _rev(vh), _rev(a_vec), _rev(b_vec)))
    mu_y = jnp.mean(y, -1, keepdims=True)
    var_y = jnp.mean(jnp.square(y - mu_y), -1, keepdims=True)
    y = (y - mu_y) * lax.rsqrt(var_y + RW_LN_EPS)
    y = y.reshape(B, S, RW_WIDTH) * ln_g.astype(f32) + ln_b.astype(f32)
    bonus = jnp.sum(rh * kh * r_k.astype(f32), -1, keepdims=True) * vh
    y = (y + bonus.reshape(B, S, RW_WIDTH)) * g
    return y.astype(p.dtype)


def expert_choice_ffn(h, w_router, w1, w3, w2):
    B, S, D = h.shape
    cap = CAPACITY * S // N_EXPERTS
    aff = jax.nn.softmax(jnp.einsum('bsd,de->bse', h, w_router).astype(jnp.float32), axis=-1)
    gate, idx = lax.top_k(jnp.swapaxes(aff, 1, 2), cap)
    xe = jax.vmap(lambda hb, ib: hb[ib])(h, idx)
    hid = jax.nn.silu(jnp.einsum('becd,edf->becf', xe, w1)) * jnp.einsum('becd,edf->becf', xe, w3)
    eo = jnp.einsum('becf,efd->becd', hid, w2) * gate[..., None].astype(h.dtype)
    scatter = lambda ib, vb: jnp.zeros((S, D), eo.dtype).at[ib.reshape(-1)].add(vb.reshape(-1, D))
    return jax.vmap(scatter)(idx, eo)


def hybrid_layer(x, w_in, gla_a_up_f, gla_a_bias_f, gla_a_up_b, gla_a_bias_b, gla_norm_g,
                 rw_mu, rw_w0_f, rw_w_up_f, rw_w0_b, rw_w_up_b, rw_a0, rw_a_up, rw_g_up,
                 rw_k_k, rw_k_a, rw_r_k, rw_ln_g, rw_ln_b, w_up_gla, w_up_rwkv, w_out,
                 ln1_g, ln1_b, w_router, w1, w3, w2, ln2_g, ln2_b):
    cols = jnp.einsum('bsd,dc->bsc', x, w_in)
    gla_p, rw_p, gate_p = _split(cols, (GLA_COLS, RW_COLS, 2 * D_MODEL))
    q, k, v, g, af, ab = _split(gla_p, GLA_SPLITS)
    y_gla = gla_branch(q, k, v, g, af, ab, gla_a_up_f, gla_a_bias_f, gla_a_up_b, gla_a_bias_b, gla_norm_g)
    y_rw = rwkv_branch(rw_p, rw_mu, rw_w0_f, rw_w_up_f, rw_w0_b, rw_w_up_b, rw_a0, rw_a_up, rw_g_up,
                       rw_k_k, rw_k_a, rw_r_k, rw_ln_g, rw_ln_b)
    gate_gla, gate_rw = _split(gate_p, (D_MODEL, D_MODEL))
    merged = jax.nn.sigmoid(gate_gla) * (y_gla @ w_up_gla) + jax.nn.sigmoid(gate_rw) * (y_rw @ w_up_rwkv)
    x = layer_norm(DEEPNORM_ALPHA * x + merged @ w_out, ln1_g, ln1_b)
    x = layer_norm(DEEPNORM_ALPHA * x + expert_choice_ffn(x, w_router, w1, w3, w2), ln2_g, ln2_b)
    return x


def setup_inputs(seed: int = 0) -> dict:
    key = jax.random.key(seed)
    ks = jax.random.split(key, 40)
    f32 = jnp.float32
    L, D, E, F = DEPTH, D_MODEL, N_EXPERTS, D_FF_EXPERT
    nrm = lambda i, shape, scale: jax.random.normal(ks[i], shape, f32) * scale
    return {
        'x': nrm(0, (BATCH, SEQ, D), 1.0),
        'w_in': nrm(1, (L, D, N_IN_COLS), D ** -0.5),
        'gla_a_up_f': nrm(2, (L, GLA_LR, GLA_KEY), GLA_LR ** -0.5),
        'gla_a_bias_f': nrm(3, (L, GLA_KEY), 0.5) + 1.0,
        'gla_a_up_b': nrm(4, (L, GLA_LR, GLA_KEY), GLA_LR ** -0.5),
        'gla_a_bias_b': nrm(5, (L, GLA_KEY), 0.5) + 1.0,
        'gla_norm_g': 1.0 + nrm(6, (L, GLA_VAL), 0.02),
        'rw_mu': jax.random.uniform(ks[7], (L, RW_COLS), f32, 0.0, 1.0),
        'rw_w0_f': nrm(8, (L, RW_WIDTH), 1.0) - 0.5,
        'rw_w_up_f': nrm(9, (L, RW_W_LR, RW_WIDTH), 0.5 * RW_W_LR ** -0.5),
        'rw_w0_b': nrm(10, (L, RW_WIDTH), 1.0) - 0.5,
        'rw_w_up_b': nrm(11, (L, RW_W_LR, RW_WIDTH), 0.5 * RW_W_LR ** -0.5),
        'rw_a0': nrm(12, (L, RW_WIDTH), 0.1),
        'rw_a_up': nrm(13, (L, RW_A_LR, RW_WIDTH), 0.5 * RW_A_LR ** -0.5),
        'rw_g_up': nrm(14, (L, RW_G_LR, RW_WIDTH), RW_G_LR ** -0.5),
        'rw_k_k': 0.85 + nrm(15, (L, RW_WIDTH), 0.02),
        'rw_k_a': 1.0 + nrm(16, (L, RW_WIDTH), 0.02),
        'rw_r_k': nrm(17, (L, RW_HEADS, RW_HEAD), 0.1),
        'rw_ln_g': 1.0 + nrm(18, (L, RW_WIDTH), 0.02),
        'rw_ln_b': nrm(19, (L, RW_WIDTH), 0.02),
        'w_up_gla': nrm(20, (L, GLA_VAL, D), GLA_VAL ** -0.5),
        'w_up_rwkv': nrm(21, (L, RW_WIDTH, D), RW_WIDTH ** -0.5),
        'w_out': nrm(22, (L, D, D), DEEPNORM_BETA * D ** -0.5),
        'ln1_g': 1.0 + nrm(23, (L, D), 0.02),
        'ln1_b': nrm(24, (L, D), 0.02),
        'w_router': nrm(25, (L, D, E), D ** -0.5),
        'w1': nrm(26, (L, E, D, F), D ** -0.5),
        'w3': nrm(27, (L, E, D, F), D ** -0.5),
        'w2': nrm(28, (L, E, F, D), DEEPNORM_BETA * F ** -0.5),
        'ln2_g': 1.0 + nrm(29, (L, D), 0.02),
        'ln2_b': nrm(30, (L, D), 0.02),
    }


def reference(x, w_in, gla_a_up_f, gla_a_bias_f, gla_a_up_b, gla_a_bias_b, gla_norm_g,
              rw_mu, rw_w0_f, rw_w_up_f, rw_w0_b, rw_w_up_b, rw_a0, rw_a_up, rw_g_up,
              rw_k_k, rw_k_a, rw_r_k, rw_ln_g, rw_ln_b, w_up_gla, w_up_rwkv, w_out,
              ln1_g, ln1_b, w_router, w1, w3, w2, ln2_g, ln2_b):
    h = x
    for l in range(DEPTH):
        h = hybrid_layer(h, w_in[l], gla_a_up_f[l], gla_a_bias_f[l], gla_a_up_b[l], gla_a_bias_b[l], gla_norm_g[l],
                         rw_mu[l], rw_w0_f[l], rw_w_up_f[l], rw_w0_b[l], rw_w_up_b[l], rw_a0[l], rw_a_up[l], rw_g_up[l],
                         rw_k_k[l], rw_k_a[l], rw_r_k[l], rw_ln_g[l], rw_ln_b[l], w_up_gla[l], w_up_rwkv[l], w_out[l],
                         ln1_g[l], ln1_b[l], w_router[l], w1[l], w3[l], w2[l], ln2_g[l], ln2_b[l])
    return h
```

```cpp
#include <hip/hip_runtime.h>
#include <hip/hip_cooperative_groups.h>
#include <cstdio>
namespace cg = cooperative_groups;

#ifndef MULTI
#define MULTI 0
#endif

typedef unsigned short u16;
typedef __bf16 bf2_t __attribute__((ext_vector_type(2)));
typedef float f2_t __attribute__((ext_vector_type(2)));
using bf16x8 = __attribute__((ext_vector_type(8))) short;
using s16x4 = __attribute__((ext_vector_type(4))) short;
using f32x4 = __attribute__((ext_vector_type(4))) float;
#define DEVINL __device__ __forceinline__

constexpr int T_ = 8192, S_ = 4096, D_ = 2048, NC = 10592, NCP = 10752;
constexpr int C_Q = 0, C_K = 512, C_V = 1024, C_G = 2048, C_AF = 3072, C_RW = 3104;
constexpr int C_GG = 6496, C_GR = 8544;
constexpr float ALPHA = 1.189207115f;

constexpr size_t MB = 1ull << 20;
constexpr size_t O_XBF = 0;
constexpr size_t O_WINT = 32 * MB;
constexpr size_t O_OSUM = 0;
constexpr size_t O_YSUM = 32 * MB;
constexpr size_t O_R1 = 0;
constexpr size_t O_COLS = 76 * MB;
constexpr size_t O_ACC2 = 76 * MB;
constexpr size_t O_W13T = 140 * MB;
constexpr size_t O_W2T = 268 * MB;
constexpr size_t O_HID = 332 * MB;
constexpr size_t O_REC = 244 * MB;
constexpr size_t O_YGLA = 244 * MB;
constexpr size_t O_YRW = 260 * MB;
constexpr size_t O_MERGED = 276 * MB;
constexpr size_t O_QT = 372 * MB;
constexpr size_t O_KT = 388 * MB;
constexpr size_t O_KDT = 404 * MB;
constexpr size_t O_VT = 420 * MB;
constexpr size_t O_DEC = 436 * MB;
constexpr size_t O_M1 = 372 * MB;
constexpr size_t O_HBF = 372 * MB;
constexpr size_t O_XE = 404 * MB;
constexpr size_t O_VSCAN = 437 * MB;
constexpr size_t O_GRW = 453 * MB;
constexpr size_t O_BONUS = 469 * MB;
constexpr size_t O_WUPGT = 485 * MB;
constexpr size_t O_WUPRT = 489 * MB;
constexpr size_t O_WOUTT = 493 * MB;
constexpr size_t O_LWF = 501 * MB;
constexpr size_t O_LWB = O_LWF + 128 * 1024;
constexpr size_t O_LA = O_LWB + 128 * 1024;
constexpr size_t O_LG = O_LA + 128 * 1024;
constexpr size_t O_AFF = 502 * MB;
constexpr size_t O_SELT = O_AFF + 512 * 1024;
constexpr size_t O_SELG = O_SELT + 64 * 1024;
constexpr size_t O_YB = 503 * MB;
constexpr size_t O_EO = 140 * MB;
constexpr size_t O_INV = 535 * MB;
constexpr size_t O_BAR = 535 * MB + 768 * 1024;
constexpr size_t WS_NEED = 536 * MB;

struct Params {
  const float *x, *w_in, *gla_a_up_f, *gla_a_bias_f, *gla_a_up_b, *gla_a_bias_b, *gla_norm_g;
  const float *rw_mu, *rw_w0_f, *rw_w_up_f, *rw_w0_b, *rw_w_up_b, *rw_a0, *rw_a_up, *rw_g_up;
  const float *rw_k_k, *rw_k_a, *rw_r_k, *rw_ln_g, *rw_ln_b, *w_up_gla, *w_up_rwkv, *w_out;
  const float *ln1_g, *ln1_b, *w_router, *w1, *w3, *w2, *ln2_g, *ln2_b;
  float* out;
  char* ws;
};

DEVINL unsigned pk2(float a, float b) {
  f2_t v = {a, b};
  bf2_t r = __builtin_convertvector(v, bf2_t);
  return *(unsigned*)&r;
}
DEVINL u16 f2bf(float a) { return (u16)(pk2(a, 0.f) & 0xffffu); }
DEVINL float bf2f(u16 h) { return __uint_as_float(((unsigned)h) << 16); }
DEVINL float bflo(unsigned u) { return __uint_as_float(u << 16); }
DEVINL float bfhi(unsigned u) { return __uint_as_float(u & 0xffff0000u); }
DEVINL float sigm(float x) { return 1.f / (1.f + __expf(-x)); }
DEVINL float tanh_(float x) { return 1.f - 2.f / (__expf(2.f * x) + 1.f); }
DEVINL float logsig(float z) { return fminf(z, 0.f) - __logf(1.f + __expf(-fabsf(z))); }
template <int CTRL> DEVINL float dppf(float x) {
  return __int_as_float(__builtin_amdgcn_update_dpp(0, __float_as_int(x), CTRL, 0xF, 0xF, true));
}
DEVINL float allred16(float x) {
  x += dppf<0xB1>(x); x += dppf<0x4E>(x); x += dppf<0x141>(x); x += dppf<0x140>(x);
  return x;
}
DEVINL void allred16x2(float& a, float& b) {
  a += dppf<0xB1>(a); b += dppf<0xB1>(b);
  a += dppf<0x4E>(a); b += dppf<0x4E>(b);
  a += dppf<0x141>(a); b += dppf<0x141>(b);
  a += dppf<0x140>(a); b += dppf<0x140>(b);
}
DEVINL float allred64(float x) {
  x = allred16(x);
  x += __shfl_xor(x, 16);
  x += __shfl_xor(x, 32);
  return x;
}
DEVINL bf16x8 mk8(s16x4 lo, s16x4 hi) {
  bf16x8 r;
  r[0] = lo[0]; r[1] = lo[1]; r[2] = lo[2]; r[3] = lo[3];
  r[4] = hi[0]; r[5] = hi[1]; r[6] = hi[2]; r[7] = hi[3];
  return r;
}
DEVINL bf16x8 pack8(f32x4 a, f32x4 b) {
  union { bf16x8 v; unsigned u[4]; } r;
  r.u[0] = pk2(a[0], a[1]); r.u[1] = pk2(a[2], a[3]);
  r.u[2] = pk2(b[0], b[1]); r.u[3] = pk2(b[2], b[3]);
  return r.v;
}
DEVINL bf16x8 ldfrag(const u16* base) {
  s16x4 lo = *(const s16x4*)base;
  s16x4 hi = *(const s16x4*)(base + 16);
  return mk8(lo, hi);
}
DEVINL float sel4(f32x4 v, int j) { return j == 0 ? v[0] : (j == 1 ? v[1] : (j == 2 ? v[2] : v[3])); }
DEVINL u16 f2h(float a) { _Float16 h = (_Float16)a; return __builtin_bit_cast(u16, h); }
DEVINL float fmix_lo(float s, unsigned h, float c) {
  float d; asm("v_fma_mix_f32 %0, %1, %2, %3 op_sel:[0,0,0] op_sel_hi:[0,1,0]" : "=v"(d) : "v"(s), "v"(h), "v"(c)); return d;
}
DEVINL float fmix_hi(float s, unsigned h, float c) {
  float d; asm("v_fma_mix_f32 %0, %1, %2, %3 op_sel:[0,1,0] op_sel_hi:[0,1,0]" : "=v"(d) : "v"(s), "v"(h), "v"(c)); return d;
}
DEVINL float fmixhh_lo(unsigned vh, unsigned h, float c) {
  float d; asm("v_fma_mix_f32 %0, %1, %2, %3 op_sel:[0,0,0] op_sel_hi:[1,1,0]" : "=v"(d) : "v"(vh), "v"(h), "v"(c)); return d;
}
DEVINL float fmixhh_hi(unsigned vh, unsigned h, float c) {
  float d; asm("v_fma_mix_f32 %0, %1, %2, %3 op_sel:[0,1,0] op_sel_hi:[1,1,0]" : "=v"(d) : "v"(vh), "v"(h), "v"(c)); return d;
}
DEVINL float fmul_hi(float s, unsigned h) {
  float d; asm("v_fma_mix_f32 %0, %1, %2, 0 op_sel:[0,1,0] op_sel_hi:[0,1,0]" : "=v"(d) : "v"(s), "v"(h)); return d;
}
DEVINL float fmul_lo(float s, unsigned h) {
  float d; asm("v_fma_mix_f32 %0, %1, %2, 0 op_sel:[0,0,0] op_sel_hi:[0,1,0]" : "=v"(d) : "v"(s), "v"(h)); return d;
}
#define MFMA16(a, b, c) __builtin_amdgcn_mfma_f32_16x16x32_bf16(a, b, c, 0, 0, 0)

extern __shared__ __attribute__((aligned(16))) char dynsmem[];
extern __shared__ __attribute__((aligned(16))) char dynsmem_rd[];
DEVINL int otid() { int t = threadIdx.x; asm volatile("" : "+v"(t)); return t; }

constexpr int BM = 256, BK = 64, HALF = 128, HT = HALF * BK;
DEVINL int lds_byte(int r, int c) {
  int st = (r >> 4) * 2 + (c >> 5), rr = r & 15, cc = c & 31, ob = rr * 64 + cc * 2;
  return st * 1024 + (ob ^ (((ob >> 9) & 1) << 5));
}
DEVINL void stage_rc(int b, int& R, int& C) {
  int st = b / 1024, sb = b % 1024, swz = sb ^ (((sb >> 9) & 1) << 5);
  R = (st >> 1) * 16 + swz / 64; C = (st & 1) * 32 + (swz % 64) / 2;
}

DEVINL void xchg_pairs(f32x4 v, bool odd, float (&lo)[2], float (&hi)[2]) {
  const float s0 = odd ? v[0] : v[2], s1 = odd ? v[1] : v[3];
  const float r0 = dppf<0xB1>(s0), r1 = dppf<0xB1>(s1);
  lo[0] = odd ? r0 : v[0]; hi[0] = odd ? v[2] : r0;
  lo[1] = odd ? r1 : v[1]; hi[1] = odd ? v[3] : r1;
}
enum { EPI_COLS = 0, EPI_M1, EPI_MERGED, EPI_R1, EPI_HID, EPI_MOE2 };

template <int EPI, bool GATHER>
DEVINL void gemm_tile(const Params& p, const u16* __restrict__ A, int lda, const int* __restrict__ rowidx,
                      const u16* __restrict__ Bt, int ldb, int K, int brow, int bcol, int orow, int ocol) {
  u16* shm = (u16*)dynsmem;
#define SA(b, h) (shm + ((b) * 2 + (h)) * HT)
#define SB(b, h) (shm + (4 + (b) * 2 + (h)) * HT)
  const int tid = otid();
  int offA[2][2], offB[2];
#pragma unroll
  for (int i = 0; i < 2; ++i) {
    int R, C; stage_rc(tid * 16 + i * 8192, R, C);
    offB[i] = R * ldb + C;
#pragma unroll
    for (int h = 0; h < 2; ++h) {
      if (GATHER) offA[h][i] = rowidx[brow + h * HALF + R] * lda + C;
      else offA[h][i] = R * lda + C;
    }
  }
  const u16* Ab[2]; const u16* Bb[2];
#pragma unroll
  for (int h = 0; h < 2; ++h) {
    Ab[h] = GATHER ? A : (A + (long)(brow + h * HALF) * lda);
    Bb[h] = Bt + (long)(bcol + h * HALF) * ldb;
  }
#define STAGE_A(b, h, kt) do { _Pragma("unroll") for (int _i = 0; _i < 2; ++_i) \
    __builtin_amdgcn_global_load_lds((const unsigned*)(Ab[h] + (kt) * BK + offA[GATHER ? h : 0][_i]), \
      (__attribute__((address_space(3))) unsigned*)((char*)SA(b, h) + tid * 16 + _i * 8192), 16, 0, 0); } while (0)
#define STAGE_B(b, h, kt) do { _Pragma("unroll") for (int _i = 0; _i < 2; ++_i) \
    __builtin_amdgcn_global_load_lds((const unsigned*)(Bb[h] + (kt) * BK + offB[_i]), \
      (__attribute__((address_space(3))) unsigned*)((char*)SB(b, h) + tid * 16 + _i * 8192), 16, 0, 0); } while (0)
#define LDA(dst, b, h) _Pragma("unroll") for (int m = 0; m < 4; ++m) _Pragma("unroll") for (int k = 0; k < 2; ++k) \
    dst[m][k] = *reinterpret_cast<const bf16x8*>((char*)SA(b, h) + lds_byte(wr * 64 + m * 16 + fr, k * 32 + fq * 8))
#define LDB(dst, b, h) _Pragma("unroll") for (int n = 0; n < 2; ++n) _Pragma("unroll") for (int k = 0; k < 2; ++k) \
    dst[n][k] = *reinterpret_cast<const bf16x8*>((char*)SB(b, h) + lds_byte(wc * 32 + n * 16 + fr, k * 32 + fq * 8))
#define MMA(ai, bj, At_, Bt_) do { __builtin_amdgcn_s_setprio(1); \
    _Pragma("unroll") for (int m = 0; m < 4; ++m) _Pragma("unroll") for (int n = 0; n < 2; ++n) _Pragma("unroll") for (int k = 0; k < 2; ++k) \
      acc[ai][bj][m][n] = MFMA16(At_[m][k], Bt_[n][k], acc[ai][bj][m][n]); \
    __builtin_amdgcn_s_setprio(0); } while (0)
#define WAIT_V(n) asm volatile("s_waitcnt vmcnt(" #n ")" ::: "memory")
#define WAIT_L(n) asm volatile("s_waitcnt lgkmcnt(" #n ")" ::: "memory")
#define BAR __builtin_amdgcn_s_barrier()
#define SCHED __builtin_amdgcn_sched_barrier(0)

  const int wid = tid >> 6, lane = tid & 63, wr = wid >> 2, wc = wid & 3, fr = lane & 15, fq = lane >> 4;
  f32x4 acc[2][2][4][2] = {};
  bf16x8 At[4][2], B0[2][2], B1[2][2];
  const int nt = K / BK;
  STAGE_B(0, 0, 0); STAGE_A(0, 0, 0);
  STAGE_B(0, 1, 0); STAGE_A(0, 1, 0);
  if (wr == 1) BAR;
  WAIT_V(4); BAR;
  STAGE_B(1, 0, 1); STAGE_A(1, 0, 1); STAGE_B(1, 1, 1);
  WAIT_V(6); BAR;
  for (int t = 0; t < nt - 2; t += 2) {
    LDB(B0, 0, 0); SCHED; LDA(At, 0, 0); STAGE_A(1, 1, t + 1);
    WAIT_L(8); BAR; WAIT_L(0); MMA(0, 0, At, B0); BAR; SCHED;
    LDB(B1, 0, 1); STAGE_B(0, 0, t + 2);
    BAR; WAIT_L(0); MMA(0, 1, At, B1); BAR;
    LDA(At, 0, 1); STAGE_A(0, 0, t + 2);
    BAR; WAIT_L(0); MMA(1, 0, At, B0); BAR; SCHED;
    STAGE_B(0, 1, t + 2);
    WAIT_V(6); BAR; MMA(1, 1, At, B1); BAR;
    LDB(B0, 1, 0); SCHED; LDA(At, 1, 0); STAGE_A(0, 1, t + 2);
    WAIT_L(8); BAR; WAIT_L(0); MMA(0, 0, At, B0); BAR; SCHED;
    LDB(B1, 1, 1); STAGE_B(1, 0, t + 3);
    BAR; WAIT_L(0); MMA(0, 1, At, B1); BAR;
    LDA(At, 1, 1); STAGE_A(1, 0, t + 3);
    BAR; WAIT_L(0); MMA(1, 0, At, B0); BAR; SCHED;
    STAGE_B(1, 1, t + 3);
    WAIT_V(6); BAR; MMA(1, 1, At, B1); BAR;
  }
  { LDB(B0, 0, 0); LDA(At, 0, 0); STAGE_A(1, 1, nt - 1);
    BAR; WAIT_L(0); MMA(0, 0, At, B0); BAR;
    LDB(B1, 0, 1); BAR; WAIT_L(0); MMA(0, 1, At, B1); BAR;
    LDA(At, 0, 1); WAIT_V(4); BAR; WAIT_L(0); MMA(1, 0, At, B0); MMA(1, 1, At, B1); BAR; }
  { LDB(B0, 1, 0); LDA(At, 1, 0); WAIT_V(2); BAR; WAIT_L(0); MMA(0, 0, At, B0); BAR;
    LDB(B1, 1, 1); WAIT_V(0); BAR; WAIT_L(0); MMA(0, 1, At, B1); BAR;
    LDA(At, 1, 1); BAR; WAIT_L(0); MMA(1, 0, At, B0); MMA(1, 1, At, B1); BAR; }
  if (wr == 0) BAR;

  char* ws = p.ws;
  const int row0 = orow + wr * 64 + fq * 4;
  const int col0 = ocol + wc * 32 + fr;
  const bool odd = (fr & 1) != 0;
  const int colp = col0 - (odd ? 1 : 0);
#pragma unroll
  for (int ai = 0; ai < 2; ++ai)
#pragma unroll
    for (int m = 0; m < 4; ++m) {
      const int rA = row0 + ai * HALF + m * 16 + (odd ? 2 : 0);
      float gate[2] = {0.f, 0.f};
      if (EPI == EPI_MOE2) { gate[0] = ((const float*)(ws + O_SELG))[rA]; gate[1] = ((const float*)(ws + O_SELG))[rA + 1]; }
#pragma unroll
      for (int bj = 0; bj < (EPI == EPI_HID ? 1 : 2); ++bj)
#pragma unroll
        for (int n = 0; n < 2; ++n) {
          const int cc = bj * HALF + n * 16;
          f32x4 v = acc[ai][bj][m][n];
          if (EPI == EPI_HID) {
#pragma unroll
            for (int j = 0; j < 4; ++j) { const float a1 = acc[ai][0][m][n][j], a3 = acc[ai][1][m][n][j]; v[j] = a1 * sigm(a1) * a3; }
          }
          float lo[2], hi[2];
          xchg_pairs(v, odd, lo, hi);
#pragma unroll
          for (int k = 0; k < 2; ++k) {
            const unsigned row = (unsigned)(rA + k);
            if (EPI == EPI_HID) {
              *(unsigned*)(ws + O_HID + (row * 1024u + (unsigned)(colp + cc)) * 2u) = pk2(lo[k], hi[k]);
            } else if (EPI == EPI_COLS) {
              *(unsigned*)(ws + O_COLS + (row * (unsigned)NCP + (unsigned)(colp + cc)) * 2u) = pk2(lo[k], hi[k]);
            } else if (EPI == EPI_MOE2) {
              *(unsigned*)(ws + O_EO + (row * 2048u + (unsigned)(colp + cc)) * 2u) = pk2(gate[k] * lo[k], gate[k] * hi[k]);
            } else if (EPI == EPI_M1) {
              const unsigned g2 = *(const unsigned*)(ws + O_COLS + (row * (unsigned)NCP + (unsigned)(C_GG + colp + cc)) * 2u);
              *(float2*)(ws + O_M1 + (row * 2048u + (unsigned)(colp + cc)) * 4u) = make_float2(sigm(bflo(g2)) * lo[k], sigm(bfhi(g2)) * hi[k]);
            } else if (EPI == EPI_MERGED) {
              const unsigned g2 = *(const unsigned*)(ws + O_COLS + (row * (unsigned)NCP + (unsigned)(C_GR + colp + cc)) * 2u);
              const float2 m1 = *(const float2*)(ws + O_M1 + (row * 2048u + (unsigned)(colp + cc)) * 4u);
              *(unsigned*)(ws + O_MERGED + (row * 2048u + (unsigned)(colp + cc)) * 2u) =
                  pk2(m1.x + sigm(bflo(g2)) * lo[k], m1.y + sigm(bfhi(g2)) * hi[k]);
            } else if (EPI == EPI_R1) {
              const unsigned o4 = (row * 2048u + (unsigned)(colp + cc)) * 4u;
              const float2 xv = *(const float2*)((const char*)p.x + o4);
              *(float2*)(ws + O_R1 + o4) = make_float2(ALPHA * xv.x + lo[k], ALPHA * xv.y + hi[k]);
            }
          }
        }
      __builtin_amdgcn_sched_barrier(0);
    }
  __syncthreads();
#undef SA
#undef SB
}

DEVINL void tr_tile(const float* __restrict__ src, int ldsrc, int nvalid, int k0, int n0,
                    u16* __restrict__ dst, int lddst, int grp, int gstride, int goff) {
  float* tile = (float*)dynsmem;
  const int tid = otid();
  float4 v[8];
#pragma unroll
  for (int i = 0; i < 8; ++i) {
    int f = tid + i * 512; int r = f >> 6, c4 = (f & 63) * 4;
    int n = n0 + c4;
    v[i] = make_float4(0.f, 0.f, 0.f, 0.f);
    if (n < nvalid) {
      const f32x4 q = __builtin_nontemporal_load((const f32x4*)(src + (long)(k0 + r) * ldsrc + n));
      v[i] = make_float4(q[0], q[1], q[2], q[3]);
    }
  }
#pragma unroll
  for (int i = 0; i < 8; ++i) {
    int f = tid + i * 512; int r = f >> 6, c4 = (f & 63) * 4;
    float* tp = tile + r * 257 + c4;
    tp[0] = v[i].x; tp[1] = v[i].y; tp[2] = v[i].z; tp[3] = v[i].w;
  }
  __syncthreads();
  {
    const int n = tid >> 1, kc = (tid & 1) * 32;
    const float* tp = tile + kc * 257 + n;
    const int nn = n0 + n;
    const long row = (long)(nn / grp) * gstride + (nn % grp) + goff;
    uint4* dp = (uint4*)(dst + row * lddst + k0 + kc);
#pragma unroll
    for (int q = 0; q < 4; ++q) {
      uint4 o;
      o.x = pk2(tp[(q * 8 + 0) * 257], tp[(q * 8 + 1) * 257]);
      o.y = pk2(tp[(q * 8 + 2) * 257], tp[(q * 8 + 3) * 257]);
      o.z = pk2(tp[(q * 8 + 4) * 257], tp[(q * 8 + 5) * 257]);
      o.w = pk2(tp[(q * 8 + 6) * 257], tp[(q * 8 + 7) * 257]);
      dp[q] = o;
    }
  }
  __syncthreads();
}
DEVINL void tr_job(const float* src, int K, int N, int Npad, u16* dst, int bid, int nb) {
  const int tk = K / 64, tn = Npad / 256;
  for (int t = bid; t < tk * tn; t += nb) {
    int kt = t % tk, ntile = t / tk;
    tr_tile(src, N, N, kt * 64, ntile * 256, dst, K, 1 << 30, 0, 0);
  }
}

DEVINL void phase0(const Params& p) {
  char* ws = p.ws;
  const int bid = blockIdx.x, nb = gridDim.x, tid = otid();
  {
    const float4* xs = (const float4*)p.x;
    uint2* xd = (uint2*)(ws + O_XBF);
    const long n4 = (long)T_ * D_ / 4;
    const long stride = (long)nb * 512;
    for (long i = (long)bid * 512 + tid; i < n4; i += 4 * stride) {
      float4 v0 = xs[i], v1 = xs[i + stride], v2 = xs[i + 2 * stride], v3 = xs[i + 3 * stride];
      xd[i] = make_uint2(pk2(v0.x, v0.y), pk2(v0.z, v0.w));
      xd[i + stride] = make_uint2(pk2(v1.x, v1.y), pk2(v1.z, v1.w));
      xd[i + 2 * stride] = make_uint2(pk2(v2.x, v2.y), pk2(v2.z, v2.w));
      xd[i + 3 * stride] = make_uint2(pk2(v3.x, v3.y), pk2(v3.z, v3.w));
    }
  }
  tr_job(p.w_in, 2048, NC, NCP, (u16*)(ws + O_WINT), bid, nb);
  tr_job(p.w_up_gla, 1024, 2048, 2048, (u16*)(ws + O_WUPGT), bid, nb);
  tr_job(p.w_up_rwkv, 1024, 2048, 2048, (u16*)(ws + O_WUPRT), bid, nb);
  tr_job(p.w_out, 2048, 2048, 2048, (u16*)(ws + O_WOUTT), bid, nb);
  tr_job(p.rw_w_up_f, 64, 1024, 1024, (u16*)(ws + O_LWF), bid, nb);
  tr_job(p.rw_w_up_b, 64, 1024, 1024, (u16*)(ws + O_LWB), bid, nb);
  tr_job(p.rw_a_up, 64, 1024, 1024, (u16*)(ws + O_LA), bid, nb);
  tr_job(p.rw_g_up, 128, 1024, 1024, (u16*)(ws + O_LG), bid, nb);
}

DEVINL void phase1(const Params& p) {
  const u16* A = (const u16*)(p.ws + O_XBF);
  const u16* Bt = (const u16*)(p.ws + O_WINT);
  const int ntiles = 32 * 42;
  for (int t = blockIdx.x; t < ntiles; t += gridDim.x) {
    int pm = t & 31, pn = t >> 5;
    gemm_tile<EPI_COLS, false>(p, A, 2048, nullptr, Bt, 2048, 2048, pm * 256, pn * 256, pm * 256, pn * 256);
  }
}

DEVINL void gla_prep_unit(const Params& p, int unit) {
  const int h = unit & 3, c = (unit >> 2) & 63, b = unit >> 8;
  char* ws = p.ws;
  const u16* cols = (const u16*)(ws + O_COLS);
  const int tid = otid();
  float* afab = (float*)dynsmem;
  float* G = (float*)(dynsmem + 8192);
  u16* KD = (u16*)(dynsmem + 8192 + 65536);
  u16* VL = (u16*)dynsmem;
  const long tok0 = (long)b * S_ + c * 64;
  for (int i = tid; i < 64 * 32; i += 512) {
    int r = i >> 5, cc = i & 31;
    afab[i] = bf2f(cols[(tok0 + r) * NCP + C_AF + cc]);
  }
  __syncthreads();
  if (tid < 256) {
    const int dir = tid >> 7, kk = tid & 127;
    const float* up = dir ? p.gla_a_up_b : p.gla_a_up_f;
    const float bias = (dir ? p.gla_a_bias_b : p.gla_a_bias_f)[h * 128 + kk];
    float u[16];
#pragma unroll
    for (int r = 0; r < 16; ++r) u[r] = up[r * 512 + h * 128 + kk];
    float* Gc = G + dir * 64 * 128 + kk;
    for (int i = 0; i < 64; ++i) {
      float z = bias;
#pragma unroll
      for (int r = 0; r < 16; ++r) z += afab[i * 32 + dir * 16 + r] * u[r];
      Gc[i * 128] = logsig(z) * (1.f / 16.f);
    }
    float run = 0.f;
    if (dir == 0) { for (int i = 0; i < 64; ++i) { run += Gc[i * 128]; Gc[i * 128] = run; } }
    else { for (int i = 63; i >= 0; --i) { run += Gc[i * 128]; Gc[i * 128] = run; } }
    const float bedge = run;
    const long hb = ((long)(dir * 2 + b) * 4 + h);
    u16* qt = (u16*)(ws + O_QT) + (hb * 4096 + c * 64) * 128 + kk;
    u16* kt = (u16*)(ws + O_KT) + (hb * 4096 + c * 64) * 128 + kk;
    ((float*)(ws + O_DEC))[(hb * 64 + c) * 128 + kk] = __expf(bedge);
    u16* KDr = KD + (dir * 128 + kk) * 72;
    const unsigned short* qsrc = cols + tok0 * NCP + C_Q + h * 128 + kk;
    const unsigned short* ksrc = cols + tok0 * NCP + C_K + h * 128 + kk;
#pragma unroll 1
    for (int i0 = 0; i0 < 64; i0 += 8) {
      u16 qv[8], kv[8];
#pragma unroll
      for (int j = 0; j < 8; ++j) { qv[j] = qsrc[(long)(i0 + j) * NCP]; kv[j] = ksrc[(long)(i0 + j) * NCP]; }
#pragma unroll
      for (int j = 0; j < 8; ++j) {
        const int i = i0 + j;
        float bb = Gc[i * 128];
        float q = bf2f(qv[j]);
        float k = bf2f(kv[j]);
        qt[i * 128] = f2bf(q * 0.08838834764831845f * __expf(bb));
        kt[i * 128] = f2bf(k * __expf(-bb));
        KDr[i] = f2bf(k * __expf(bedge - bb));
      }
    }
  }
  __syncthreads();
#pragma unroll 8
  for (int idx = tid; idx < 64 * 256; idx += 512) {
    int i = idx >> 8, vc = idx & 255;
    VL[vc * 72 + i] = cols[(tok0 + i) * NCP + C_V + h * 256 + vc];
  }
  __syncthreads();
  for (int pc = tid; pc < 4096; pc += 512) {
    int row = pc >> 3, ch = pc & 7;
    if (row < 256) {
      int dir = row >> 7, kk = row & 127;
      uint4 v = *(const uint4*)(KD + row * 72 + ch * 8);
      long hb = ((long)(dir * 2 + b) * 4 + h);
      *(uint4*)((u16*)(ws + O_KDT) + ((hb * 64 + c) * 128 + kk) * 64 + ch * 8) = v;
    } else {
      int vc = row - 256;
      uint4 v = *(const uint4*)(VL + vc * 72 + ch * 8);
      long hb = ((long)b * 4 + h);
      *(uint4*)((u16*)(ws + O_VT) + ((hb * 64 + c) * 256 + vc) * 64 + ch * 8) = v;
    }
  }
  __syncthreads();
}

DEVINL float rw_shift2(const char* colsb, float muv, unsigned o, int s) {
  const unsigned op = (s > 0) ? o - (unsigned)(NCP * 2) : o;
  const unsigned on = (s < S_ - 1) ? o + (unsigned)(NCP * 2) : o;
  float cur = bf2f(*(const u16*)(colsb + o));
  float prv = bf2f(*(const u16*)(colsb + op));
  float nxt = bf2f(*(const u16*)(colsb + on));
  if (s == 0) prv = 0.f;
  if (s == S_ - 1) nxt = 0.f;
  return cur + muv * (0.5f * (prv + nxt) - cur);
}

DEVINL void rw_shift4(const char* colsb, float4 mu, unsigned o, int s, float (&out)[4]) {
  const unsigned op = (s > 0) ? o - (unsigned)(NCP * 2) : o;
  const unsigned on = (s < S_ - 1) ? o + (unsigned)(NCP * 2) : o;
  const uint2 c = *(const uint2*)(colsb + o);
  uint2 pv = *(const uint2*)(colsb + op);
  uint2 nx = *(const uint2*)(colsb + on);
  if (s == 0) pv = make_uint2(0u, 0u);
  if (s == S_ - 1) nx = make_uint2(0u, 0u);
  const float cu[4] = {bflo(c.x), bfhi(c.x), bflo(c.y), bfhi(c.y)};
  const float pr[4] = {bflo(pv.x), bfhi(pv.x), bflo(pv.y), bfhi(pv.y)};
  const float nn[4] = {bflo(nx.x), bfhi(nx.x), bflo(nx.y), bfhi(nx.y)};
  const float m[4] = {mu.x, mu.y, mu.z, mu.w};
#pragma unroll
  for (int e = 0; e < 4; ++e) out[e] = cu[e] + m[e] * (0.5f * (pr[e] + nn[e]) - cu[e]);
}

DEVINL void rw_prep_unit(const Params& p, int unit) {
  char* ws = p.ws;
  const char* colsb = ws + O_COLS;
  const int tid = otid(), lane = tid & 63, wave = tid >> 6, l15 = lane & 15, g = lane >> 4;
  u16* AL = (u16*)dynsmem;
  const int tok0 = unit * 32;
#pragma unroll 5
  for (int idx = tid; idx < 32 * 320; idx += 512) {
    int i = idx / 320, j = idx % 320;
    int t = tok0 + i; int s = t & (S_ - 1);
    unsigned o = ((unsigned)t * (unsigned)NCP + (unsigned)(C_RW + 3072 + j)) * 2u;
    float v = rw_shift2(colsb, p.rw_mu[3072 + j], o, s);
    if (j < 128) v = tanh_(v);
    else if (j >= 192) v = sigm(v);
    AL[i * 328 + j] = f2bf(v);
  }
  __syncthreads();
  const u16* LWF = (const u16*)(ws + O_LWF);
  const u16* LWB = (const u16*)(ws + O_LWB);
  const u16* LA = (const u16*)(ws + O_LA);
  const u16* LG = (const u16*)(ws + O_LG);
#pragma unroll 1
  for (int hh = 0; hh < 2; ++hh) {
    const int head = wave * 2 + hh;
#pragma unroll 1
    for (int mt = 0; mt < 2; ++mt) {
      f32x4 awf[4], awb[4], aa[4], ag[4];
#pragma unroll
      for (int n = 0; n < 4; ++n) { awf[n] = f32x4{0, 0, 0, 0}; awb[n] = awf[n]; aa[n] = awf[n]; ag[n] = awf[n]; }
      const u16* arow = AL + (mt * 16 + l15) * 328 + 8 * g;
#pragma unroll
      for (int ks = 0; ks < 2; ++ks) {
        bf16x8 fwf = *(const bf16x8*)(arow + 32 * ks);
        bf16x8 fwb = *(const bf16x8*)(arow + 64 + 32 * ks);
        bf16x8 fa = *(const bf16x8*)(arow + 128 + 32 * ks);
#pragma unroll
        for (int n = 0; n < 4; ++n) {
          const unsigned bo = (unsigned)((head * 64 + l15 * 4 + n) * 64 + 32 * ks + 8 * g) * 2u;
          bf16x8 b1 = *(const bf16x8*)((const char*)LWF + bo);
          bf16x8 b2 = *(const bf16x8*)((const char*)LWB + bo);
          bf16x8 b3 = *(const bf16x8*)((const char*)LA + bo);
          awf[n] = MFMA16(fwf, b1, awf[n]);
          awb[n] = MFMA16(fwb, b2, awb[n]);
          aa[n] = MFMA16(fa, b3, aa[n]);
        }
        __builtin_amdgcn_sched_barrier(0);
      }
#pragma unroll
      for (int ks = 0; ks < 4; ++ks) {
        bf16x8 fg = *(const bf16x8*)(arow + 192 + 32 * ks);
#pragma unroll
        for (int n = 0; n < 4; ++n) {
          const unsigned bo = (unsigned)((head * 64 + l15 * 4 + n) * 128 + 32 * ks + 8 * g) * 2u;
          bf16x8 b4 = *(const bf16x8*)((const char*)LG + bo);
          ag[n] = MFMA16(fg, b4, ag[n]);
        }
        __builtin_amdgcn_sched_barrier(0);
      }
#pragma unroll 2
      for (int j = 0; j < 4; ++j) {
        int jo = j, zo = 0;
        asm volatile("" : "+v"(jo), "+v"(zo));
        const int t = tok0 + mt * 16 + 4 * g + jo;
        const int s = t & (S_ - 1), b = t >> 12;
        const unsigned c0 = (unsigned)(head * 64 + l15 * 4 + zo);
        const unsigned rowo = (unsigned)t * (unsigned)(NCP * 2) + (unsigned)(C_RW * 2) + c0 * 2u;
        float pr[4], pkr[4], pv[4];
        rw_shift4(colsb, *(const float4*)(p.rw_mu + c0), rowo, s, pr);
        rw_shift4(colsb, *(const float4*)(p.rw_mu + 1024u + c0), rowo + 2048u, s, pkr);
        rw_shift4(colsb, *(const float4*)(p.rw_mu + 2048u + c0), rowo + 4096u, s, pv);
        const float4 a0q = *(const float4*)(p.rw_a0 + c0), kkq = *(const float4*)(p.rw_k_k + c0);
        const float4 kaq = *(const float4*)(p.rw_k_a + c0), rkq = *(const float4*)(p.rw_r_k + c0);
        const float4 w0fq = *(const float4*)(p.rw_w0_f + c0), w0bq = *(const float4*)(p.rw_w0_b + c0);
        const float a0v[4] = {a0q.x, a0q.y, a0q.z, a0q.w}, kkp[4] = {kkq.x, kkq.y, kkq.z, kkq.w};
        const float kap[4] = {kaq.x, kaq.y, kaq.z, kaq.w}, rkp[4] = {rkq.x, rkq.y, rkq.z, rkq.w};
        const float w0f[4] = {w0fq.x, w0fq.y, w0fq.z, w0fq.w}, w0b[4] = {w0bq.x, w0bq.y, w0bq.z, w0bq.w};
        float pk[4], av[4], kkv[4];
        float n2 = 0.f, dot = 0.f;
#pragma unroll
        for (int n = 0; n < 4; ++n) {
          const float kraw = pkr[n];
          float a = sigm(a0v[n] + sel4(aa[n], j));
          av[n] = a;
          float kk = kraw * kkp[n];
          kkv[n] = kk;
          n2 += kk * kk;
          float k2 = kraw * (1.f + (a - 1.f) * kap[n]);
          pk[n] = k2;
          dot += pr[n] * k2 * rkp[n];
        }
        n2 = allred16(n2);
        dot = allred16(dot);
        const float inv = 1.f / fmaxf(sqrtf(n2), 1e-12f);
        const unsigned reco = ((unsigned)((b * 16 + head) * 4096 + s)) * 1024u;
        const unsigned tco = (unsigned)t * 2048u + c0 * 2u;
        unsigned hwf[4], hwb[4], ha[4], hb[4], hk[4], hr[4], hv[4], bg[4], bbn[4];
#pragma unroll
        for (int n = 0; n < 4; ++n) {
          float wf = __expf(-0.606531f * sigm(w0f[n] + sel4(awf[n], j)));
          float wb = __expf(-0.606531f * sigm(w0b[n] + sel4(awb[n], j)));
          float kkn = kkv[n] * inv;
          hwf[n] = f2h(wf); hwb[n] = f2h(wb); ha[n] = f2h(-kkn); hb[n] = f2h(kkn * av[n]);
          hk[n] = f2h(pk[n]); hr[n] = f2h(pr[n]); hv[n] = f2h(pv[n]);
          bg[n] = f2bf(sel4(ag[n], j)); bbn[n] = f2bf(dot * pv[n]);
        }
        char* rb = ws + O_REC + (reco + (unsigned)l15 * 64u);
        *(uint4*)(rb) = make_uint4(hwf[0] | (hwf[1] << 16), hwf[2] | (hwf[3] << 16), hwb[0] | (hwb[1] << 16), hwb[2] | (hwb[3] << 16));
        *(uint4*)(rb + 16) = make_uint4(ha[0] | (ha[1] << 16), ha[2] | (ha[3] << 16), hb[0] | (hb[1] << 16), hb[2] | (hb[3] << 16));
        *(uint4*)(rb + 32) = make_uint4(hk[0] | (hk[1] << 16), hk[2] | (hk[3] << 16), hr[0] | (hr[1] << 16), hr[2] | (hr[3] << 16));
        *(uint2*)(rb + 48) = make_uint2(hv[0] | (hv[1] << 16), hv[2] | (hv[3] << 16));
        *(uint2*)(ws + O_GRW + tco) = make_uint2(bg[0] | (bg[1] << 16), bg[2] | (bg[3] << 16));
        *(uint2*)(ws + O_BONUS + tco) = make_uint2(bbn[0] | (bbn[1] << 16), bbn[2] | (bbn[3] << 16));
      }
    }
  }
  __syncthreads();
}

DEVINL void phase2(const Params& p) {
  const int bid = blockIdx.x, nb = gridDim.x, tid = otid();
  for (int u = bid; u < 512; u += nb) gla_prep_unit(p, u);
  for (int u = bid; u < 256; u += nb) rw_prep_unit(p, u);
}

typedef unsigned u32x2 __attribute__((ext_vector_type(2)));
typedef unsigned u32x4 __attribute__((ext_vector_type(4)));
template <int DIR>
DEVINL void rwkv_scan_dir(const Params& p, int task, int lane, int wave) {
  const int b = (task >> 8) & 1, head = (task >> 4) & 15, rg = task & 15;
  const int seg = lane & 15, rl = lane >> 4, row = rg * 4 + rl;
  constexpr int DIST = 24;
  constexpr int WOFS = DIR ? 8 : 0;
  const char* recbase = p.ws + O_REC + ((long)(b * 16 + head) * 4096) * 1024 + lane * 16;
  const unsigned ring_lds = (unsigned)(unsigned long)(__attribute__((address_space(3))) char*)(dynsmem + wave * 32768);
  const unsigned ring_u = __builtin_amdgcn_readfirstlane(ring_lds);
  const unsigned a_seg = ring_lds + seg * 64;
  const unsigned a_v = ring_lds + (row >> 2) * 64 + 48 + (row & 3) * 2;
  float* yo = (float*)(p.ws + (DIR ? O_YB : O_YSUM)) + ((long)b * 4096) * 1024 + head * 64 + row;
  float s0 = 0.f, s1 = 0.f, s2 = 0.f, s3 = 0.f;
  float ykeep = 0.f;
  const char* recdir = recbase + (DIR ? (long)4095 * 1024 : 0);
#define RW_GPTR(q_, gp_) const char* gp_ = recdir + (DIR ? -(long)(q_) * 1024 : (long)(q_) * 1024);
#define RW_DMA_ONLY(q_) do { RW_GPTR(q_, gp_) unsigned keep_; const unsigned ld_ = ring_u + ((q_) & 31) * 1024; \
    asm volatile("s_mov_b32 %0, m0\n\ts_mov_b32 m0, %2\n\ts_nop 0\n\tglobal_load_lds_dwordx4 %1, off\n\ts_mov_b32 m0, %0" \
                 : "=&s"(keep_) : "v"(gp_), "s"(ld_) : "memory"); } while (0)
#define RW_READ(U1, WN, XN, KN, VN, VMC) do { \
    asm volatile("s_waitcnt vmcnt(" #VMC ")\n\t" \
                 "ds_read_b64 %0, %4 offset:%6\n\t" \
                 "ds_read_b128 %1, %4 offset:%7\n\t" \
                 "ds_read_b128 %2, %4 offset:%8\n\t" \
                 "ds_read_u16 %3, %5 offset:%9" \
                 : "=&v"(WN), "=&v"(XN), "=&v"(KN), "=&v"(VN) \
                 : "v"(a_seg), "v"(a_v), \
                   "i"(((U1) & 31) * 1024 + WOFS), "i"(((U1) & 31) * 1024 + 16), "i"(((U1) & 31) * 1024 + 32), "i"(((U1) & 31) * 1024) \
                 : "memory"); } while (0)
#define RW_LANDED(WN, XN, KN, VN) asm volatile("s_waitcnt lgkmcnt(0)" : "+v"(WN), "+v"(XN), "+v"(KN), "+v"(VN) :: "memory")
#define RW_STEP(U, WC, XC, KC, VC, WN, XN, KN, VN) do { \
    { RW_GPTR(st + (U) + DIST, gp_) \
      const unsigned ld_ = ring_u + (((U) + DIST) & 31) * 1024; unsigned keep_; \
      asm volatile("s_mov_b32 m0, %2\n\ts_nop 0\n\tglobal_load_lds_dwordx4 %1, off" \
                   : "=&s"(keep_) : "v"(gp_), "s"(ld_) : "memory"); } \
    RW_READ((U) + 1, WN, XN, KN, VN, 23); \
    float pa = fmul_lo(s0, XC.x); pa = fmix_hi(s1, XC.x, pa); \
    float pb = fmul_lo(s2, XC.y); pb = fmix_hi(s3, XC.y, pb); \
    float t0_ = fmul_lo(s0, WC.x), t1_ = fmul_hi(s1, WC.x), t2_ = fmul_lo(s2, WC.y), t3_ = fmul_hi(s3, WC.y); \
    t0_ = fmixhh_lo(VC, KC.x, t0_); t1_ = fmixhh_hi(VC, KC.x, t1_); \
    t2_ = fmixhh_lo(VC, KC.y, t2_); t3_ = fmixhh_hi(VC, KC.y, t3_); \
    float sa = pa + pb, yprev = ypart;            \
    allred16x2(sa, yprev); \
    ykeep = (seg == (((U) + 15) & 15)) ? yprev : ykeep; \
    s0 = fmix_lo(sa, XC.z, t0_); \
    s1 = fmix_hi(sa, XC.z, t1_); \
    s2 = fmix_lo(sa, XC.w, t2_); \
    s3 = fmix_hi(sa, XC.w, t3_); \
    float ya = fmul_lo(s0, KC.z); ya = fmix_hi(s1, KC.z, ya); \
    float yb = fmul_lo(s2, KC.w); yb = fmix_hi(s3, KC.w, yb); \
    ypart = ya + yb; \
    RW_LANDED(WN, XN, KN, VN); } while (0)
#define RW_STEP2(B) RW_STEP(B, WvA, XA, KrA, vhA, WvB, XB, KrB, vhB); RW_STEP((B) + 1, WvB, XB, KrB, vhB, WvA, XA, KrA, vhA)
#define RW_STEP4(B) RW_STEP2(B); RW_STEP2((B) + 2)
#define RW_DMA4(B) RW_DMA_ONLY(B); RW_DMA_ONLY((B) + 1); RW_DMA_ONLY((B) + 2); RW_DMA_ONLY((B) + 3)
  u32x2 WvA, WvB; u32x4 XA, XB, KrA, KrB; unsigned vhA, vhB;
  RW_DMA4(0); RW_DMA4(4); RW_DMA4(8); RW_DMA4(12); RW_DMA4(16); RW_DMA4(20);
  RW_READ(0, WvA, XA, KrA, vhA, 23);
  RW_LANDED(WvA, XA, KrA, vhA);
  float ypart = 0.f;
#pragma unroll 1
  for (int st = 0; st < 4096; st += 32) {
    RW_STEP(0, WvA, XA, KrA, vhA, WvB, XB, KrB, vhB);
    if (st > 0) { const int q0 = st - 16 + seg; yo[(long)(DIR ? (4095 - q0) : q0) * 1024] = ykeep; }
    RW_STEP(1, WvB, XB, KrB, vhB, WvA, XA, KrA, vhA);
    RW_STEP2(2); RW_STEP4(4); RW_STEP4(8); RW_STEP4(12);
    RW_STEP(16, WvA, XA, KrA, vhA, WvB, XB, KrB, vhB);
    { const int q0 = st + seg; yo[(long)(DIR ? (4095 - q0) : q0) * 1024] = ykeep; }
    RW_STEP(17, WvB, XB, KrB, vhB, WvA, XA, KrA, vhA);
    RW_STEP2(18); RW_STEP4(20); RW_STEP4(24); RW_STEP4(28);
  }
  {
    const float ylast = allred16(ypart);
    ykeep = (seg == 15) ? ylast : ykeep;
    const int q0 = 4096 - 16 + seg; yo[(long)(DIR ? (4095 - q0) : q0) * 1024] = ykeep;
  }
  asm volatile("s_waitcnt vmcnt(0)" ::: "memory");
#undef RW_READ
#undef RW_LANDED
#undef RW_STEP2
#undef RW_GPTR
#undef RW_DMA_ONLY
#undef RW_STEP
#undef RW_STEP4
#undef RW_DMA4
}
DEVINL void rwkv_scan_task(const Params& p, int task, int lane, int wave) {
  if (task >> 9) rwkv_scan_dir<1>(p, task, lane, wave);
  else rwkv_scan_dir<0>(p, task, lane, wave);
}

DEVINL void gla_scan_task(const Params& p, int task, int lane) {
  const int dir = task >> 7, b = (task >> 6) & 1, h = (task >> 4) & 3, vsl = task & 15;
  const int l15 = lane & 15, g = lane >> 4;
  const long hb = (long)(dir * 2 + b) * 4 + h;
  const u16* qt = (const u16*)(p.ws + O_QT) + hb * 4096 * 128 + l15 * 128 + 4 * g;
  const u16* kt = (const u16*)(p.ws + O_KT) + hb * 4096 * 128 + l15 * 128 + 4 * g;
  const u16* kdT = (const u16*)(p.ws + O_KDT) + hb * 64 * 128 * 64 + l15 * 64 + 4 * g;
  const u16* vT = (const u16*)(p.ws + O_VT) + ((long)b * 4 + h) * 64 * 256 * 64 + (16 * vsl + l15) * 64 + 4 * g;
  const float* dec = (const float*)(p.ws + O_DEC) + hb * 64 * 128 + 4 * g;
  u16* obuf = (u16*)(p.ws + O_OSUM) + (dir ? (long)T_ * 1024 : 0) + ((long)b * 4096) * 1024 + h * 256 + 16 * vsl + l15;
  f32x4 ST[8];
#pragma unroll
  for (int m = 0; m < 8; ++m) ST[m] = f32x4{0, 0, 0, 0};
  bf16x8 KF[4][4], VF[2], QF[4][4];
#define GL_LOAD_KV(KFx, VFx, c_) do { \
    _Pragma("unroll") for (int jt = 0; jt < 4; ++jt) _Pragma("unroll") for (int ks = 0; ks < 4; ++ks) \
      KFx[jt][ks] = ldfrag(kt + ((c_) * 64 + 16 * jt) * 128 + 32 * ks); \
    _Pragma("unroll") for (int s = 0; s < 2; ++s) VFx[s] = ldfrag(vT + (c_) * (256 * 64) + 32 * s); } while (0)
#define GL_LOAD_Q(it_, c_) do { \
    _Pragma("unroll") for (int ks = 0; ks < 4; ++ks) QF[it_][ks] = ldfrag(qt + ((c_) * 64 + 16 * (it_)) * 128 + 32 * ks); } while (0)
  {
    const int c0 = dir ? 63 : 0;
    GL_LOAD_KV(KF, VF, c0);
    GL_LOAD_Q(0, c0);
  }
  for (int cc = 0; cc < 64; ++cc) {
    const int c = dir ? 63 - cc : cc;
    const int tok0 = c * 64;
    GL_LOAD_Q(1, c); GL_LOAD_Q(2, c); GL_LOAD_Q(3, c);
    bf16x8 SBf[4];
#pragma unroll
    for (int ks = 0; ks < 4; ++ks) SBf[ks] = pack8(ST[2 * ks], ST[2 * ks + 1]);
    __builtin_amdgcn_sched_barrier(0);
#pragma unroll
    for (int it = 0; it < 4; ++it) {
      f32x4 X[4];
#pragma unroll
      for (int jt = 0; jt < 4; ++jt) {
        X[jt] = f32x4{0, 0, 0, 0};
        const bool need = dir ? (jt >= it) : (jt <= it);
        if (need) {
#pragma unroll
          for (int ks = 0; ks < 4; ++ks) X[jt] = MFMA16(KF[jt][ks], QF[it][ks], X[jt]);
          if (jt == it) {
#pragma unroll
            for (int r = 0; r < 4; ++r) {
              const int j = 4 * g + r;
              const bool keep = dir ? (j >= l15) : (j <= l15);
              if (!keep) X[jt][r] = 0.f;
            }
          }
        }
      }
      bf16x8 XA0 = pack8(X[0], X[1]), XA1 = pack8(X[2], X[3]);
      f32x4 O = f32x4{0, 0, 0, 0};
      O = MFMA16(XA0, VF[0], O);
      O = MFMA16(XA1, VF[1], O);
#pragma unroll
      for (int ks = 0; ks < 4; ++ks) O = MFMA16(QF[it][ks], SBf[ks], O);
#pragma unroll
      for (int r = 0; r < 4; ++r)
        obuf[(long)(tok0 + 16 * it + 4 * g + r) * 1024] = f2bf(O[r]);
    }
    __builtin_amdgcn_sched_barrier(0);
    bf16x8 KDF[8][2]; f32x4 Dv[8];
#pragma unroll
    for (int m = 0; m < 8; ++m) {
      Dv[m] = *(const f32x4*)(dec + c * 128 + 16 * m);
#pragma unroll
      for (int s = 0; s < 2; ++s) KDF[m][s] = ldfrag(kdT + (c * 128 + 16 * m) * 64 + 32 * s);
    }
    __builtin_amdgcn_sched_barrier(0);
#pragma unroll
    for (int m = 0; m < 4; ++m) {
      ST[m] = ST[m] * Dv[m];
      ST[m] = MFMA16(KDF[m][0], VF[0], ST[m]);
      ST[m] = MFMA16(KDF[m][1], VF[1], ST[m]);
    }
    __builtin_amdgcn_sched_barrier(0);
    const int cn = (cc < 63) ? (dir ? c - 1 : c + 1) : c;
    bf16x8 VFn[2];
    GL_LOAD_KV(KF, VFn, cn);
    GL_LOAD_Q(0, cn);
    __builtin_amdgcn_sched_barrier(0);
#pragma unroll
    for (int m = 4; m < 8; ++m) {
      ST[m] = ST[m] * Dv[m];
      ST[m] = MFMA16(KDF[m][0], VF[0], ST[m]);
      ST[m] = MFMA16(KDF[m][1], VF[1], ST[m]);
    }
    VF[0] = VFn[0]; VF[1] = VFn[1];
  }
#undef GL_LOAD_KV
#undef GL_LOAD_Q
}

DEVINL void phase3(const Params& p) {
  const int tid = otid(); const int wave = tid >> 6, lane = tid & 63;
  const int nb = gridDim.x;
  int vb = blockIdx.x;
  if ((nb & 7) == 0) vb = (blockIdx.x & 7) * (nb >> 3) + (blockIdx.x >> 3);
  if (wave < 4) {
    for (int task = vb * 4 + wave; task < 1024; task += nb * 4) rwkv_scan_task(p, task, lane, wave);
  } else if (wave == 4) {
    for (int task = vb; task < 256; task += nb) gla_scan_task(p, task, lane);
  }
}

DEVINL void phase4(const Params& p) {
  char* ws = p.ws;
  const int tid = otid();
  const int lane = tid & 63;
  const int gw = blockIdx.x * 8 + (tid >> 6), nw = gridDim.x * 8;
  const u16* cols = (const u16*)(ws + O_COLS);
  for (int u = gw; u < T_ * 4; u += nw) {
    const long t = u >> 2; const int h = u & 3;
    const int c = h * 256 + lane * 4;
    float4 o;
    {
      uint2 of = *(const uint2*)((const u16*)(ws + O_OSUM) + t * 1024 + c);
      uint2 ob = *(const uint2*)((const u16*)(ws + O_OSUM) + (long)T_ * 1024 + t * 1024 + c);
      o.x = bflo(of.x) + bflo(ob.x); o.y = bfhi(of.x) + bfhi(ob.x);
      o.z = bflo(of.y) + bflo(ob.y); o.w = bfhi(of.y) + bfhi(ob.y);
    }
    float ss = o.x * o.x + o.y * o.y + o.z * o.z + o.w * o.w;
    ss = allred64(ss);
    const float rstd = rsqrtf(ss * (1.f / 256.f) + 1e-5f);
    float4 ng = *(const float4*)(p.gla_norm_g + c);
    uint2 gg = *(const uint2*)(cols + t * NCP + C_G + c);
    float g0 = bflo(gg.x), g1 = bfhi(gg.x), g2 = bflo(gg.y), g3 = bfhi(gg.y);
    float y0 = o.x * rstd * ng.x * (g0 * sigm(g0));
    float y1 = o.y * rstd * ng.y * (g1 * sigm(g1));
    float y2 = o.z * rstd * ng.z * (g2 * sigm(g2));
    float y3 = o.w * rstd * ng.w * (g3 * sigm(g3));
    *(uint2*)((u16*)(ws + O_YGLA) + t * 1024 + c) = make_uint2(pk2(y0, y1), pk2(y2, y3));
  }
  for (int u = gw; u < T_ * 4; u += nw) {
    const long t = u >> 2; const int hq = u & 3;
    const int c = (hq * 4 + (lane >> 4)) * 64 + (lane & 15) * 4;
    float4 y = *(const float4*)((const float*)(ws + O_YSUM) + t * 1024 + c);
    {
      float4 y2 = *(const float4*)((const float*)(ws + O_YB) + t * 1024 + c);
      y.x += y2.x; y.y += y2.y; y.z += y2.z; y.w += y2.w;
    }
    float mu = allred16(y.x + y.y + y.z + y.w) * (1.f / 64.f);
    float d0 = y.x - mu, d1 = y.y - mu, d2 = y.z - mu, d3 = y.w - mu;
    float var = allred16(d0 * d0 + d1 * d1 + d2 * d2 + d3 * d3) * (1.f / 64.f);
    const float rstd = rsqrtf(var + 64e-5f);
    float4 lg = *(const float4*)(p.rw_ln_g + c);
    float4 lb = *(const float4*)(p.rw_ln_b + c);
    uint2 bo = *(const uint2*)((const u16*)(ws + O_BONUS) + t * 1024 + c);
    uint2 gg = *(const uint2*)((const u16*)(ws + O_GRW) + t * 1024 + c);
    float r0 = (d0 * rstd * lg.x + lb.x + bflo(bo.x)) * bflo(gg.x);
    float r1 = (d1 * rstd * lg.y + lb.y + bfhi(bo.x)) * bfhi(gg.x);
    float r2 = (d2 * rstd * lg.z + lb.z + bflo(bo.y)) * bflo(gg.y);
    float r3 = (d3 * rstd * lg.w + lb.w + bfhi(bo.y)) * bfhi(gg.y);
    *(uint2*)((u16*)(ws + O_YRW) + t * 1024 + c) = make_uint2(pk2(r0, r1), pk2(r2, r3));
  }
}

DEVINL void phase5(const Params& p) {
  const u16* A1 = (const u16*)(p.ws + O_YGLA);
  const u16* A2 = (const u16*)(p.ws + O_YRW);
  const u16* B1 = (const u16*)(p.ws + O_WUPGT);
  const u16* B2 = (const u16*)(p.ws + O_WUPRT);
  for (int t = blockIdx.x; t < 256; t += gridDim.x) {
    int pm = t & 31, pn = t >> 5;
    gemm_tile<EPI_M1, false>(p, A1, 1024, nullptr, B1, 1024, 1024, pm * 256, pn * 256, pm * 256, pn * 256);
  }
  for (int t = blockIdx.x; t < 256; t += gridDim.x) {
    int pm = t & 31, pn = t >> 5;
    gemm_tile<EPI_MERGED, false>(p, A2, 1024, nullptr, B2, 1024, 1024, pm * 256, pn * 256, pm * 256, pn * 256);
  }
}
DEVINL void phase6(const Params& p) {
  const u16* A = (const u16*)(p.ws + O_MERGED);
  const u16* Bt = (const u16*)(p.ws + O_WOUTT);
  for (int t = blockIdx.x; t < 256; t += gridDim.x) {
    int pm = t & 31, pn = t >> 5;
    gemm_tile<EPI_R1, false>(p, A, 2048, nullptr, Bt, 2048, 2048, pm * 256, pn * 256, pm * 256, pn * 256);
  }
}

DEVINL void phase7(const Params& p) {
  char* ws = p.ws;
  const int tid = otid();
  const int lane = tid & 63;
  const int gw = blockIdx.x * 8 + (tid >> 6), nw = gridDim.x * 8;
  for (int row = gw; row < T_; row += nw) {
    const float* r1 = (const float*)(ws + O_R1) + (long)row * 2048;
    float4 v[8];
    float sum = 0.f;
#pragma unroll
    for (int i = 0; i < 8; ++i) { v[i] = *(const float4*)(r1 + i * 256 + lane * 4); sum += v[i].x + v[i].y + v[i].z + v[i].w; }
    const float mu = allred64(sum) * (1.f / 2048.f);
    float sq = 0.f;
#pragma unroll
    for (int i = 0; i < 8; ++i) {
      v[i].x -= mu; v[i].y -= mu; v[i].z -= mu; v[i].w -= mu;
      sq += v[i].x * v[i].x + v[i].y * v[i].y + v[i].z * v[i].z + v[i].w * v[i].w;
    }
    const float rstd = rsqrtf(allred64(sq) * (1.f / 2048.f) + 1e-5f);
    float lg[16];
#pragma unroll
    for (int e = 0; e < 16; ++e) lg[e] = 0.f;
#pragma unroll
    for (int i = 0; i < 8; ++i) {
      const int c = i * 256 + lane * 4;
      float4 gq = *(const float4*)(p.ln1_g + c);
      float4 bq = *(const float4*)(p.ln1_b + c);
      float h0 = v[i].x * rstd * gq.x + bq.x, h1 = v[i].y * rstd * gq.y + bq.y;
      float h2 = v[i].z * rstd * gq.z + bq.z, h3 = v[i].w * rstd * gq.w + bq.w;
      *(uint2*)((u16*)(ws + O_HBF) + (long)row * 2048 + c) = make_uint2(pk2(h0, h1), pk2(h2, h3));
      *(float4*)((float*)(ws + O_ACC2) + (long)row * 2048 + c) = make_float4(ALPHA * h0, ALPHA * h1, ALPHA * h2, ALPHA * h3);
      const float hh[4] = {h0, h1, h2, h3};
#pragma unroll
      for (int q = 0; q < 4; ++q) {
        const float4* wr = (const float4*)(p.w_router + (long)(c + q) * 16);
#pragma unroll
        for (int e4 = 0; e4 < 4; ++e4) {
          float4 w = wr[e4];
          lg[e4 * 4 + 0] += hh[q] * w.x; lg[e4 * 4 + 1] += hh[q] * w.y;
          lg[e4 * 4 + 2] += hh[q] * w.z; lg[e4 * 4 + 3] += hh[q] * w.w;
        }
      }
    }
    float mx = -1e30f;
#pragma unroll
    for (int e = 0; e < 16; ++e) { lg[e] = allred64(lg[e]); mx = fmaxf(mx, lg[e]); }
    float den = 0.f;
#pragma unroll
    for (int e = 0; e < 16; ++e) { lg[e] = __expf(lg[e] - mx); den += lg[e]; }
    const float inv = 1.f / den;
    float mine = 0.f;
#pragma unroll
    for (int e = 0; e < 16; ++e) if (lane == e) mine = lg[e] * inv;
    if (lane < 16) {
      const int b = row >> 12, s = row & 4095;
      ((float*)(ws + O_AFF))[((long)(b * 16 + lane)) * 4096 + s] = mine;
      ((int*)(ws + O_INV))[row * 16 + lane] = -1;
    }
  }
}

DEVINL void phase8(const Params& p) {
  char* ws = p.ws;
  const int bid = blockIdx.x, nb = gridDim.x, tid = otid();
  for (int pr = bid; pr < 32; pr += nb) {
    const int b = pr >> 4, e = pr & 15;
    unsigned* cnt = (unsigned*)dynsmem;
    const float* aff = (const float*)(ws + O_AFF) + (long)pr * 4096;
    const int lane = tid & 63;
    unsigned key[8];
#pragma unroll
    for (int i = 0; i < 8; ++i) key[i] = __float_as_uint(aff[tid + 512 * i]);
    if (tid < 40) cnt[tid] = 0u;
    __syncthreads();
    unsigned T = 0u;
    for (int bit = 30; bit >= 0; --bit) {
      const unsigned cand = T | (1u << bit);
      int c = 0;
#pragma unroll
      for (int i = 0; i < 8; ++i) c += (key[i] >= cand) ? 1 : 0;
      const float cf = allred64((float)c);
      if (lane == 0) atomicAdd(&cnt[bit], (unsigned)cf);
      __syncthreads();
      if (cnt[bit] >= 512u) T = cand;
    }
    {
      int c = 0;
#pragma unroll
      for (int i = 0; i < 8; ++i) c += (key[i] > T) ? 1 : 0;
      const float cf = allred64((float)c);
      if (lane == 0) atomicAdd(&cnt[31], (unsigned)cf);
      __syncthreads();
    }
    const unsigned ngt = cnt[31];
#pragma unroll
    for (int i = 0; i < 8; ++i) {
      int slot = -1;
      if (key[i] > T) slot = (int)atomicAdd(&cnt[32], 1u);
      else if (key[i] == T) { unsigned s2 = atomicAdd(&cnt[33], 1u); if (ngt + s2 < 512u) slot = (int)(ngt + s2); }
      if (slot >= 0) {
        ((int*)(ws + O_SELT))[e * 1024 + b * 512 + slot] = b * 4096 + tid + 512 * i;
        ((float*)(ws + O_SELG))[e * 1024 + b * 512 + slot] = __uint_as_float(key[i]);
        ((int*)(ws + O_INV))[(b * 4096 + tid + 512 * i) * 16 + e] = e * 1024 + b * 512 + slot;
      }
    }
    __syncthreads();
  }
  for (int t = bid; t < 16 * 128 * 3; t += nb) {
    const int which = t / (16 * 128), r = t % (16 * 128), e = r >> 7, tt = r & 127;
    if (which < 2) {
      const float* src = (which ? p.w3 : p.w1) + (long)e * 2048 * 1024;
      int kt = tt & 31, ntile = tt >> 5;
      tr_tile(src, 1024, 1024, kt * 64, ntile * 256, (u16*)(ws + O_W13T) + (long)e * 2048 * 2048, 2048, 128, 256, which * 128);
    } else {
      const float* src = p.w2 + (long)e * 1024 * 2048;
      int kt = tt & 15, ntile = tt >> 4;
      tr_tile(src, 2048, 2048, kt * 64, ntile * 256, (u16*)(ws + O_W2T) + (long)e * 2048 * 1024, 1024, 1 << 30, 0, 0);
    }
  }
}

DEVINL void phase9(const Params& p) {
  const u16* A = (const u16*)(p.ws + O_XE);
  for (int t = blockIdx.x; t < 512; t += gridDim.x) {
    const int e = t >> 5, pm = t & 3, pn = (t >> 2) & 7;
    const u16* Bt = (const u16*)(p.ws + O_W13T) + (long)e * 2048 * 2048;
    gemm_tile<EPI_HID, true>(p, (const u16*)(p.ws + O_HBF), 2048, (const int*)(p.ws + O_SELT), Bt, 2048, 2048, e * 1024 + pm * 256, pn * 256, e * 1024 + pm * 256, pn * 128);
  }
}
DEVINL void phase10(const Params& p) {
  const u16* A = (const u16*)(p.ws + O_HID);
  for (int t = blockIdx.x; t < 512; t += gridDim.x) {
    const int e = t >> 5, pm = t & 3, pn = (t >> 2) & 7;
    const u16* Bt = (const u16*)(p.ws + O_W2T) + (long)e * 2048 * 1024;
    gemm_tile<EPI_MOE2, false>(p, A, 1024, nullptr, Bt, 1024, 1024, e * 1024 + pm * 256, pn * 256, e * 1024 + pm * 256, pn * 256);
  }
}

DEVINL void phase11(const Params& p) {
  const int tid = otid();
  const int lane = tid & 63;
  const int gw = blockIdx.x * 8 + (tid >> 6), nw = gridDim.x * 8;
  for (int row = gw; row < T_; row += nw) {
    const float* r2 = (const float*)(p.ws + O_ACC2) + (long)row * 2048;
    float4 v[8];
    float sum = 0.f;
#pragma unroll
    for (int i = 0; i < 8; ++i) v[i] = *(const float4*)(r2 + i * 256 + lane * 4);
    {
      const int* inv = (const int*)(p.ws + O_INV) + row * 16;
      const int myinv = inv[lane & 15];
#pragma unroll 1
      for (int e = 0; e < 16; ++e) {
        const int er = __shfl(myinv, e);
        if (er >= 0) {
          const u16* eo = (const u16*)(p.ws + O_EO) + (long)er * 2048 + lane * 4;
#pragma unroll
          for (int i = 0; i < 8; ++i) {
            uint2 q = *(const uint2*)(eo + i * 256);
            v[i].x += bflo(q.x); v[i].y += bfhi(q.x); v[i].z += bflo(q.y); v[i].w += bfhi(q.y);
          }
        }
      }
    }
#pragma unroll
    for (int i = 0; i < 8; ++i) sum += v[i].x + v[i].y + v[i].z + v[i].w;
    const float mu = allred64(sum) * (1.f / 2048.f);
    float sq = 0.f;
#pragma unroll
    for (int i = 0; i < 8; ++i) {
      v[i].x -= mu; v[i].y -= mu; v[i].z -= mu; v[i].w -= mu;
      sq += v[i].x * v[i].x + v[i].y * v[i].y + v[i].z * v[i].z + v[i].w * v[i].w;
    }
    const float rstd = rsqrtf(allred64(sq) * (1.f / 2048.f) + 1e-5f);
#pragma unroll
    for (int i = 0; i < 8; ++i) {
      const int c = i * 256 + lane * 4;
      float4 gq = *(const float4*)(p.ln2_g + c);
      float4 bq = *(const float4*)(p.ln2_b + c);
      *(float4*)(p.out + (long)row * 2048 + c) = make_float4(v[i].x * rstd * gq.x + bq.x, v[i].y * rstd * gq.y + bq.y,
                                                             v[i].z * rstd * gq.z + bq.z, v[i].w * rstd * gq.w + bq.w);
    }
  }
}

#define XB_TMO      128
#define XB_XCNT(j)  (256  + 64 * (j))
#define XB_XSUB(j)  (1280 + 64 * (j))
#define XB_XGEN(j)  (2304 + 64 * (j))
#define XB_TOP      3328
#define XB_TOPGEN   3392
#define XCD_BAR_WORDS 3456
#define XB_SPIN_CAP (1u << 20)
#define LAS __attribute__((address_space(3)))
DEVINL unsigned xb_ld(unsigned* p_) { return __hip_atomic_load(p_, __ATOMIC_RELAXED, __HIP_MEMORY_SCOPE_AGENT); }
DEVINL unsigned xb_add(unsigned* p_, unsigned v) { return __hip_atomic_fetch_add(p_, v, __ATOMIC_RELAXED, __HIP_MEMORY_SCOPE_AGENT); }
DEVINL unsigned xb_xcc_id() { return (unsigned)__builtin_amdgcn_s_getreg((3 << 11) | 20) & 0xFu; }
#define XB_SPIN(cond, bar) do { unsigned _sp = 0; while (cond) { __builtin_amdgcn_s_sleep(1); \
    if ((++_sp & 255u) == 0u) { if (xb_ld(&(bar)[XB_TMO])) break; if (_sp > XB_SPIN_CAP) { atomicAdd(&(bar)[XB_TMO], 1u); break; } } } } while (0)
struct XcdBarrier { unsigned* bar; unsigned x; volatile LAS unsigned* st; };
DEVINL XcdBarrier xcd_barrier_post(unsigned* bar, volatile LAS unsigned* st) {
  XcdBarrier b; b.bar = bar; b.x = xb_xcc_id(); b.st = st;
  if (threadIdx.x == 0) (void)xb_add(&bar[XB_XCNT(b.x)], 1u);
  return b;
}
DEVINL void xcd_barrier_complete(unsigned* bar, unsigned x, unsigned& nloc, unsigned& nx) {
  const unsigned G = gridDim.x * gridDim.y * gridDim.z;
  unsigned sum, cnt, mine, sp = 0u;
  for (;;) {
    sum = 0u; cnt = 0u; mine = 0u;
#pragma unroll
    for (unsigned j = 0; j < 16; ++j) { const unsigned c = xb_ld(&bar[XB_XCNT(j)]); sum += c; cnt += (c > 0u) ? 1u : 0u; mine = (j == x) ? c : mine; }
    if (sum == G) break;
    __builtin_amdgcn_s_sleep(1);
    if ((++sp & 255u) == 0u) { if (xb_ld(&bar[XB_TMO])) break; if (sp > XB_SPIN_CAP) { atomicAdd(&bar[XB_TMO], 1u); break; } }
  }
  nloc = mine > 0u ? mine : 1u; nx = cnt > 0u ? cnt : 1u;
}
DEVINL void xcd_barrier(const XcdBarrier& b) {
  asm volatile("s_waitcnt vmcnt(0)" ::: "memory");
  __syncthreads();
  if (threadIdx.x == 0) {
    unsigned* bar = b.bar;
    __builtin_amdgcn_s_waitcnt(0);
    unsigned nloc = b.st[0], nx = b.st[1];
    if (nloc == 0u) { xcd_barrier_complete(bar, b.x, nloc, nx); b.st[0] = nloc; b.st[1] = nx; }
    const unsigned old = xb_add(&bar[XB_XSUB(b.x)], 1u);
    const unsigned gen = old / nloc;
    if (old + 1u == (gen + 1u) * nloc) {
      __builtin_amdgcn_fence(__ATOMIC_RELEASE, "agent");
      asm volatile("s_waitcnt vmcnt(0)" ::: "memory");
      const unsigned og = xb_add(&bar[XB_TOP], 1u);
      const unsigned tg = og / nx;
      if (og + 1u == (tg + 1u) * nx) xb_add(&bar[XB_TOPGEN], 1u);
      else XB_SPIN(xb_ld(&bar[XB_TOPGEN]) == tg, bar);
      __builtin_amdgcn_fence(__ATOMIC_ACQUIRE, "agent");
      xb_add(&bar[XB_XGEN(b.x)], 1u);
      asm volatile("s_waitcnt vmcnt(0)" ::: "memory");
    } else {
      XB_SPIN(xb_ld(&bar[XB_XGEN(b.x)]) == gen, bar);
      __builtin_amdgcn_fence(__ATOMIC_ACQUIRE, "agent");
      asm volatile("s_waitcnt vmcnt(0)" ::: "memory");
    }
  }
  __syncthreads();
}

template <int PH> DEVINL void run_phase(const Params& p) {
  if (PH == 0) phase0(p);
  else if (PH == 1) phase1(p);
  else if (PH == 2) phase2(p);
  else if (PH == 3) phase3(p);
  else if (PH == 4) phase4(p);
  else if (PH == 5) phase5(p);
  else if (PH == 6) phase6(p);
  else if (PH == 7) phase7(p);
  else if (PH == 8) phase8(p);
  else if (PH == 9) phase9(p);
  else if (PH == 10) phase10(p);
  else if (PH == 11) phase11(p);
}

constexpr int SHM_BYTES = 131072;

#if MULTI
template <int PH> __global__ void __launch_bounds__(512, 2) k_phase(Params p) { run_phase<PH>(p); }
template <int PH> static void launch_phase(const Params& p, hipStream_t stream) {
  hipFuncSetAttribute((const void*)k_phase<PH>, hipFuncAttributeMaxDynamicSharedMemorySize, SHM_BYTES);
  k_phase<PH><<<256, 512, SHM_BYTES, stream>>>(p);
}
#else
__global__ void __launch_bounds__(512, 2) k_mega(Params p) {
  cg::grid_group grid = cg::this_grid();
  __shared__ uint4 xb_words;
  unsigned* bar = (unsigned*)(p.ws + O_BAR);
  if (threadIdx.x == 0) xb_words = make_uint4(0u, 0u, 0u, 0u);
  __syncthreads();
  XcdBarrier xb = xcd_barrier_post(bar, (volatile LAS unsigned*)&xb_words);
  if (p.out == nullptr) grid.sync();
  run_phase<0>(p); xcd_barrier(xb);
  run_phase<1>(p); xcd_barrier(xb);
  run_phase<2>(p); xcd_barrier(xb);
  run_phase<3>(p); xcd_barrier(xb);
  run_phase<4>(p); xcd_barrier(xb);
  run_phase<5>(p); xcd_barrier(xb);
  run_phase<6>(p); xcd_barrier(xb);
  run_phase<7>(p); xcd_barrier(xb);
  run_phase<8>(p); xcd_barrier(xb);
  run_phase<9>(p); xcd_barrier(xb);
  run_phase<10>(p); xcd_barrier(xb);
  run_phase<11>(p);
}
#endif

extern "C" void kernel_launch(void* const* d_in, const int* in_sizes, int n_in, void* d_out, int out_size,
                              void* d_ws, size_t ws_size, hipStream_t stream) {
  Params p{};
  const float** f = (const float**)&p;
  for (int i = 0; i < 31; ++i) f[i] = (const float*)d_in[i];
  p.out = (float*)d_out;
  p.ws = (char*)d_ws;
  if (ws_size < WS_NEED) { fprintf(stderr, "workspace too small: %zu < %zu\n", ws_size, (size_t)WS_NEED); return; }
#if MULTI
  launch_phase<0>(p, stream); launch_phase<1>(p, stream); launch_phase<2>(p, stream); launch_phase<3>(p, stream);
  launch_phase<4>(p, stream); launch_phase<5>(p, stream); launch_phase<6>(p, stream); launch_phase<7>(p, stream);
  launch_phase<8>(p, stream); launch_phase<9>(p, stream); launch_phase<10>(p, stream); launch_phase<11>(p, stream);
#else
  static int grid_blocks = 0;
  if (!grid_blocks) {
    int dev = 0, cus = 0, per_cu = 0;
    hipGetDevice(&dev);
    hipDeviceGetAttribute(&cus, hipDeviceAttributeMultiprocessorCount, dev);
    hipFuncSetAttribute((const void*)k_mega, hipFuncAttributeMaxDynamicSharedMemorySize, SHM_BYTES);
    hipOccupancyMaxActiveBlocksPerMultiprocessor(&per_cu, k_mega, 512, SHM_BYTES);
    if (per_cu < 1) per_cu = 1;
    grid_blocks = cus * per_cu;
    if (grid_blocks > 256) grid_blocks = 256;
  }
  hipMemsetAsync((char*)d_ws + O_BAR, 0, XCD_BAR_WORDS * sizeof(unsigned), stream);
  void* args[] = {&p};
  hipError_t e = hipLaunchCooperativeKernel((void*)k_mega, dim3(grid_blocks), dim3(512), args, SHM_BYTES, stream);
  if (e != hipSuccess) fprintf(stderr, "cooperative launch failed: %s (grid %d)\n", hipGetErrorString(e), grid_blocks);
#endif
}
```

```cpp
#include <hip/hip_runtime.h>
#include <hip/hip_cooperative_groups.h>
#include <cstdio>
namespace cg = cooperative_groups;

#ifndef MULTI
#define MULTI 0
#endif

typedef unsigned short u16;
typedef __bf16 bf2_t __attribute__((ext_vector_type(2)));
typedef float f2_t __attribute__((ext_vector_type(2)));
using bf16x8 = __attribute__((ext_vector_type(8))) short;
using s16x4 = __attribute__((ext_vector_type(4))) short;
using f32x4 = __attribute__((ext_vector_type(4))) float;
#define DEVINL __device__ __forceinline__

constexpr int T_ = 8192, S_ = 4096, D_ = 2048, NC = 10592, NCP = 10752;
constexpr int C_Q = 0, C_K = 512, C_V = 1024, C_G = 2048, C_AF = 3072, C_RW = 3104;
constexpr int C_GG = 6496, C_GR = 8544;
constexpr float ALPHA = 1.189207115f;

constexpr size_t MB = 1ull << 20;
constexpr size_t O_XBF = 0;
constexpr size_t O_WINT = 32 * MB;
constexpr size_t O_OSUM = 0;
constexpr size_t O_YSUM = 32 * MB;
constexpr size_t O_R1 = 0;
constexpr size_t O_COLS = 76 * MB;
constexpr size_t O_ACC2 = 76 * MB;
constexpr size_t O_W13T = 140 * MB;
constexpr size_t O_W2T = 268 * MB;
constexpr size_t O_HID = 332 * MB;
constexpr size_t O_REC = 244 * MB;
constexpr size_t O_YGLA = 244 * MB;
constexpr size_t O_YRW = 260 * MB;
constexpr size_t O_MERGED = 276 * MB;
constexpr size_t O_QT = 372 * MB;
constexpr size_t O_KT = 388 * MB;
constexpr size_t O_KDT = 404 * MB;
constexpr size_t O_VT = 420 * MB;
constexpr size_t O_DEC = 436 * MB;
constexpr size_t O_M1 = 372 * MB;
constexpr size_t O_HBF = 372 * MB;
constexpr size_t O_XE = 404 * MB;
constexpr size_t O_VSCAN = 437 * MB;
constexpr size_t O_GRW = 453 * MB;
constexpr size_t O_BONUS = 469 * MB;
constexpr size_t O_WUPGT = 485 * MB;
constexpr size_t O_WUPRT = 489 * MB;
constexpr size_t O_WOUTT = 493 * MB;
constexpr size_t O_LWF = 501 * MB;
constexpr size_t O_LWB = O_LWF + 128 * 1024;
constexpr size_t O_LA = O_LWB + 128 * 1024;
constexpr size_t O_LG = O_LA + 128 * 1024;
constexpr size_t O_AFF = 502 * MB;
constexpr size_t O_SELT = O_AFF + 512 * 1024;
constexpr size_t O_SELG = O_SELT + 64 * 1024;
constexpr size_t O_YB = 503 * MB;
constexpr size_t O_EO = 140 * MB;
constexpr size_t O_INV = 535 * MB;
constexpr size_t O_BAR = 535 * MB + 768 * 1024;
constexpr size_t WS_NEED = 536 * MB;

struct Params {
  const float *x, *w_in, *gla_a_up_f, *gla_a_bias_f, *gla_a_up_b, *gla_a_bias_b, *gla_norm_g;
  const float *rw_mu, *rw_w0_f, *rw_w_up_f, *rw_w0_b, *rw_w_up_b, *rw_a0, *rw_a_up, *rw_g_up;
  const float *rw_k_k, *rw_k_a, *rw_r_k, *rw_ln_g, *rw_ln_b, *w_up_gla, *w_up_rwkv, *w_out;
  const float *ln1_g, *ln1_b, *w_router, *w1, *w3, *w2, *ln2_g, *ln2_b;
  float* out;
  char* ws;
};

DEVINL unsigned pk2(float a, float b) {
  f2_t v = {a, b};
  bf2_t r = __builtin_convertvector(v, bf2_t);
  return *(unsigned*)&r;
}
DEVINL u16 f2bf(float a) { return (u16)(pk2(a, 0.f) & 0xffffu); }
DEVINL float bf2f(u16 h) { return __uint_as_float(((unsigned)h) << 16); }
DEVINL float bflo(unsigned u) { return __uint_as_float(u << 16); }
DEVINL float bfhi(unsigned u) { return __uint_as_float(u & 0xffff0000u); }
DEVINL float sigm(float x) { return 1.f / (1.f + __expf(-x)); }
DEVINL float tanh_(float x) { return 1.f - 2.f / (__expf(2.f * x) + 1.f); }
DEVINL float logsig(float z) { return fminf(z, 0.f) - __logf(1.f + __expf(-fabsf(z))); }
template <int CTRL> DEVINL float dppf(float x) {
  return __int_as_float(__builtin_amdgcn_update_dpp(0, __float_as_int(x), CTRL, 0xF, 0xF, true));
}
DEVINL float allred16(float x) {
  x += dppf<0xB1>(x); x += dppf<0x4E>(x); x += dppf<0x141>(x); x += dppf<0x140>(x);
  return x;
}
DEVINL void allred16x2(float& a, float& b) {
  a += dppf<0xB1>(a); b += dppf<0xB1>(b);
  a += dppf<0x4E>(a); b += dppf<0x4E>(b);
  a += dppf<0x141>(a); b += dppf<0x141>(b);
  a += dppf<0x140>(a); b += dppf<0x140>(b);
}
DEVINL float allred64(float x) {
  x = allred16(x);
  x += __shfl_xor(x, 16);
  x += __shfl_xor(x, 32);
  return x;
}
DEVINL bf16x8 mk8(s16x4 lo, s16x4 hi) {
  bf16x8 r;
  r[0] = lo[0]; r[1] = lo[1]; r[2] = lo[2]; r[3] = lo[3];
  r[4] = hi[0]; r[5] = hi[1]; r[6] = hi[2]; r[7] = hi[3];
  return r;
}
DEVINL bf16x8 pack8(f32x4 a, f32x4 b) {
  union { bf16x8 v; unsigned u[4]; } r;
  r.u[0] = pk2(a[0], a[1]); r.u[1] = pk2(a[2], a[3]);
  r.u[2] = pk2(b[0], b[1]); r.u[3] = pk2(b[2], b[3]);
  return r.v;
}
DEVINL bf16x8 ldfrag(const u16* base) {
  s16x4 lo = *(const s16x4*)base;
  s16x4 hi = *(const s16x4*)(base + 16);
  return mk8(lo, hi);
}
DEVINL float sel4(f32x4 v, int j) { return j == 0 ? v[0] : (j == 1 ? v[1] : (j == 2 ? v[2] : v[3])); }
DEVINL u16 f2h(float a) { _Float16 h = (_Float16)a; return __builtin_bit_cast(u16, h); }
DEVINL float fmix_lo(float s, unsigned h, float c) {
  float d; asm("v_fma_mix_f32 %0, %1, %2, %3 op_sel:[0,0,0] op_sel_hi:[0,1,0]" : "=v"(d) : "v"(s), "v"(h), "v"(c)); return d;
}
DEVINL float fmix_hi(float s, unsigned h, float c) {
  float d; asm("v_fma_mix_f32 %0, %1, %2, %3 op_sel:[0,1,0] op_sel_hi:[0,1,0]" : "=v"(d) : "v"(s), "v"(h), "v"(c)); return d;
}
DEVINL float fmixhh_lo(unsigned vh, unsigned h, float c) {
  float d; asm("v_fma_mix_f32 %0, %1, %2, %3 op_sel:[0,0,0] op_sel_hi:[1,1,0]" : "=v"(d) : "v"(vh), "v"(h), "v"(c)); return d;
}
DEVINL float fmixhh_hi(unsigned vh, unsigned h, float c) {
  float d; asm("v_fma_mix_f32 %0, %1, %2, %3 op_sel:[0,1,0] op_sel_hi:[1,1,0]" : "=v"(d) : "v"(vh), "v"(h), "v"(c)); return d;
}
DEVINL float fmul_hi(float s, unsigned h) {
  float d; asm("v_fma_mix_f32 %0, %1, %2, 0 op_sel:[0,1,0] op_sel_hi:[0,1,0]" : "=v"(d) : "v"(s), "v"(h)); return d;
}
DEVINL float fmul_lo(float s, unsigned h) {
  float d; asm("v_fma_mix_f32 %0, %1, %2, 0 op_sel:[0,0,0] op_sel_hi:[0,1,0]" : "=v"(d) : "v"(s), "v"(h)); return d;
}
#define MFMA16(a, b, c) __builtin_amdgcn_mfma_f32_16x16x32_bf16(a, b, c, 0, 0, 0)

extern __shared__ __attribute__((aligned(16))) char dynsmem[];
extern __shared__ __attribute__((aligned(16))) char dynsmem_rd[];
DEVINL int otid() { int t = threadIdx.x; asm volatile("" : "+v"(t)); return t; }

constexpr int BM = 256, BK = 64, HALF = 128, HT = HALF * BK;
DEVINL int lds_byte(int r, int c) {
  int st = (r >> 4) * 2 + (c >> 5), rr = r & 15, cc = c & 31, ob = rr * 64 + cc * 2;
  return st * 1024 + (ob ^ (((ob >> 9) & 1) << 5));
}
DEVINL void stage_rc(int b, int& R, int& C) {
  int st = b / 1024, sb = b % 1024, swz = sb ^ (((sb >> 9) & 1) << 5);
  R = (st >> 1) * 16 + swz / 64; C = (st & 1) * 32 + (swz % 64) / 2;
}

DEVINL void xchg_pairs(f32x4 v, bool odd, float (&lo)[2], float (&hi)[2]) {
  const float s0 = odd ? v[0] : v[2], s1 = odd ? v[1] : v[3];
  const float r0 = dppf<0xB1>(s0), r1 = dppf<0xB1>(s1);
  lo[0] = odd ? r0 : v[0]; hi[0] = odd ? v[2] : r0;
  lo[1] = odd ? r1 : v[1]; hi[1] = odd ? v[3] : r1;
}
enum { EPI_COLS = 0, EPI_M1, EPI_MERGED, EPI_R1, EPI_HID, EPI_MOE2 };

template <int EPI, bool GATHER>
DEVINL void gemm_tile(const Params& p, const u16* __restrict__ A, int lda, const int* __restrict__ rowidx,
                      const u16* __restrict__ Bt, int ldb, int K, int brow, int bcol, int orow, int ocol) {
  u16* shm = (u16*)dynsmem;
#define SA(b, h) (shm + ((b) * 2 + (h)) * HT)
#define SB(b, h) (shm + (4 + (b) * 2 + (h)) * HT)
  const int tid = otid();
  int offA[2][2], offB[2];
#pragma unroll
  for (int i = 0; i < 2; ++i) {
    int R, C; stage_rc(tid * 16 + i * 8192, R, C);
    offB[i] = R * ldb + C;
#pragma unroll
    for (int h = 0; h < 2; ++h) {
      if (GATHER) offA[h][i] = rowidx[brow + h * HALF + R] * lda + C;
      else offA[h][i] = R * lda + C;
    }
  }
  const u16* Ab[2]; const u16* Bb[2];
#pragma unroll
  for (int h = 0; h < 2; ++h) {
    Ab[h] = GATHER ? A : (A + (long)(brow + h * HALF) * lda);
    Bb[h] = Bt + (long)(bcol + h * HALF) * ldb;
  }
#define STAGE_A(b, h, kt) do { _Pragma("unroll") for (int _i = 0; _i < 2; ++_i) \
    __builtin_amdgcn_global_load_lds((const unsigned*)(Ab[h] + (kt) * BK + offA[GATHER ? h : 0][_i]), \
      (__attribute__((address_space(3))) unsigned*)((char*)SA(b, h) + tid * 16 + _i * 8192), 16, 0, 0); } while (0)
#define STAGE_B(b, h, kt) do { _Pragma("unroll") for (int _i = 0; _i < 2; ++_i) \
    __builtin_amdgcn_global_load_lds((const unsigned*)(Bb[h] + (kt) * BK + offB[_i]), \
      (__attribute__((address_space(3))) unsigned*)((char*)SB(b, h) + tid * 16 + _i * 8192), 16, 0, 0); } while (0)
#define LDA(dst, b, h) _Pragma("unroll") for (int m = 0; m < 4; ++m) _Pragma("unroll") for (int k = 0; k < 2; ++k) \
    dst[m][k] = *reinterpret_cast<const bf16x8*>((char*)SA(b, h) + lds_byte(wr * 64 + m * 16 + fr, k * 32 + fq * 8))
#define LDB(dst, b, h) _Pragma("unroll") for (int n = 0; n < 2; ++n) _Pragma("unroll") for (int k = 0; k < 2; ++k) \
    dst[n][k] = *reinterpret_cast<const bf16x8*>((char*)SB(b, h) + lds_byte(wc * 32 + n * 16 + fr, k * 32 + fq * 8))
#define MMA(ai, bj, At_, Bt_) do { __builtin_amdgcn_s_setprio(1); \
    _Pragma("unroll") for (int m = 0; m < 4; ++m) _Pragma("unroll") for (int n = 0; n < 2; ++n) _Pragma("unroll") for (int k = 0; k < 2; ++k) \
      acc[ai][bj][m][n] = MFMA16(At_[m][k], Bt_[n][k], acc[ai][bj][m][n]); \
    __builtin_amdgcn_s_setprio(0); } while (0)
#define WAIT_V(n) asm volatile("s_waitcnt vmcnt(" #n ")" ::: "memory")
#define WAIT_L(n) asm volatile("s_waitcnt lgkmcnt(" #n ")" ::: "memory")
#define BAR __builtin_amdgcn_s_barrier()
#define SCHED __builtin_amdgcn_sched_barrier(0)

  const int wid = tid >> 6, lane = tid & 63, wr = wid >> 2, wc = wid & 3, fr = lane & 15, fq = lane >> 4;
  f32x4 acc[2][2][4][2] = {};
  bf16x8 At[4][2], B0[2][2], B1[2][2];
  const int nt = K / BK;
  STAGE_B(0, 0, 0); STAGE_A(0, 0, 0);
  STAGE_B(0, 1, 0); STAGE_A(0, 1, 0);
  if (wr == 1) BAR;
  WAIT_V(4); BAR;
  STAGE_B(1, 0, 1); STAGE_A(1, 0, 1); STAGE_B(1, 1, 1);
  WAIT_V(6); BAR;
  for (int t = 0; t < nt - 2; t += 2) {
    LDB(B0, 0, 0); SCHED; LDA(At, 0, 0); STAGE_A(1, 1, t + 1);
    WAIT_L(8); BAR; WAIT_L(0); MMA(0, 0, At, B0); BAR; SCHED;
    LDB(B1, 0, 1); STAGE_B(0, 0, t + 2);
    BAR; WAIT_L(0); MMA(0, 1, At, B1); BAR;
    LDA(At, 0, 1); STAGE_A(0, 0, t + 2);
    BAR; WAIT_L(0); MMA(1, 0, At, B0); BAR; SCHED;
    STAGE_B(0, 1, t + 2);
    WAIT_V(6); BAR; MMA(1, 1, At, B1); BAR;
    LDB(B0, 1, 0); SCHED; LDA(At, 1, 0); STAGE_A(0, 1, t + 2);
    WAIT_L(8); BAR; WAIT_L(0); MMA(0, 0, At, B0); BAR; SCHED;
    LDB(B1, 1, 1); STAGE_B(1, 0, t + 3);
    BAR; WAIT_L(0); MMA(0, 1, At, B1); BAR;
    LDA(At, 1, 1); STAGE_A(1, 0, t + 3);
    BAR; WAIT_L(0); MMA(1, 0, At, B0); BAR; SCHED;
    STAGE_B(1, 1, t + 3);
    WAIT_V(6); BAR; MMA(1, 1, At, B1); BAR;
  }
  { LDB(B0, 0, 0); LDA(At, 0, 0); STAGE_A(1, 1, nt - 1);
    BAR; WAIT_L(0); MMA(0, 0, At, B0); BAR;
    LDB(B1, 0, 1); BAR; WAIT_L(0); MMA(0, 1, At, B1); BAR;
    LDA(At, 0, 1); WAIT_V(4); BAR; WAIT_L(0); MMA(1, 0, At, B0); MMA(1, 1, At, B1); BAR; }
  { LDB(B0, 1, 0); LDA(At, 1, 0); WAIT_V(2); BAR; WAIT_L(0); MMA(0, 0, At, B0); BAR;
    LDB(B1, 1, 1); WAIT_V(0); BAR; WAIT_L(0); MMA(0, 1, At, B1); BAR;
    LDA(At, 1, 1); BAR; WAIT_L(0); MMA(1, 0, At, B0); MMA(1, 1, At, B1); BAR; }
  if (wr == 0) BAR;

  char* ws = p.ws;
  const int row0 = orow + wr * 64 + fq * 4;
  const int col0 = ocol + wc * 32 + fr;
  const bool odd = (fr & 1) != 0;
  const int colp = col0 - (odd ? 1 : 0);
#pragma unroll
  for (int ai = 0; ai < 2; ++ai)
#pragma unroll
    for (int m = 0; m < 4; ++m) {
      const int rA = row0 + ai * HALF + m * 16 + (odd ? 2 : 0);
      float gate[2] = {0.f, 0.f};
      if (EPI == EPI_MOE2) { gate[0] = ((const float*)(ws + O_SELG))[rA]; gate[1] = ((const float*)(ws + O_SELG))[rA + 1]; }
#pragma unroll
      for (int bj = 0; bj < (EPI == EPI_HID ? 1 : 2); ++bj)
#pragma unroll
        for (int n = 0; n < 2; ++n) {
          const int cc = bj * HALF + n * 16;
          f32x4 v = acc[ai][bj][m][n];
          if (EPI == EPI_HID) {
#pragma unroll
            for (int j = 0; j < 4; ++j) { const float a1 = acc[ai][0][m][n][j], a3 = acc[ai][1][m][n][j]; v[j] = a1 * sigm(a1) * a3; }
          }
          float lo[2], hi[2];
          xchg_pairs(v, odd, lo, hi);
#pragma unroll
          for (int k = 0; k < 2; ++k) {
            const unsigned row = (unsigned)(rA + k);
            if (EPI == EPI_HID) {
              *(unsigned*)(ws + O_HID + (row * 1024u + (unsigned)(colp + cc)) * 2u) = pk2(lo[k], hi[k]);
            } else if (EPI == EPI_COLS) {
              *(unsigned*)(ws + O_COLS + (row * (unsigned)NCP + (unsigned)(colp + cc)) * 2u) = pk2(lo[k], hi[k]);
            } else if (EPI == EPI_MOE2) {
              *(unsigned*)(ws + O_EO + (row * 2048u + (unsigned)(colp + cc)) * 2u) = pk2(gate[k] * lo[k], gate[k] * hi[k]);
            } else if (EPI == EPI_M1) {
              const unsigned g2 = *(const unsigned*)(ws + O_COLS + (row * (unsigned)NCP + (unsigned)(C_GG + colp + cc)) * 2u);
              *(float2*)(ws + O_M1 + (row * 2048u + (unsigned)(colp + cc)) * 4u) = make_float2(sigm(bflo(g2)) * lo[k], sigm(bfhi(g2)) * hi[k]);
            } else if (EPI == EPI_MERGED) {
              const unsigned g2 = *(const unsigned*)(ws + O_COLS + (row * (unsigned)NCP + (unsigned)(C_GR + colp + cc)) * 2u);
              const float2 m1 = *(const float2*)(ws + O_M1 + (row * 2048u + (unsigned)(colp + cc)) * 4u);
              *(unsigned*)(ws + O_MERGED + (row * 2048u + (unsigned)(colp + cc)) * 2u) =
                  pk2(m1.x + sigm(bflo(g2)) * lo[k], m1.y + sigm(bfhi(g2)) * hi[k]);
            } else if (EPI == EPI_R1) {
              const unsigned o4 = (row * 2048u + (unsigned)(colp + cc)) * 4u;
              const float2 xv = *(const float2*)((const char*)p.x + o4);
              *(unsigned*)(ws + O_R1 + (o4 >> 1)) = pk2(ALPHA * xv.x + lo[k], ALPHA * xv.y + hi[k]);
            }
          }
        }
      __builtin_amdgcn_sched_barrier(0);
    }
  __syncthreads();
#undef SA
#undef SB
}

DEVINL void tr_tile(const float* __restrict__ src, int ldsrc, int nvalid, int k0, int n0,
                    u16* __restrict__ dst, int lddst, int grp, int gstride, int goff) {
  float* tile = (float*)dynsmem;
  const int tid = otid();
  float4 v[8];
#pragma unroll
  for (int i = 0; i < 8; ++i) {
    int f = tid + i * 512; int r = f >> 6, c4 = (f & 63) * 4;
    int n = n0 + c4;
    v[i] = make_float4(0.f, 0.f, 0.f, 0.f);
    if (n < nvalid) {
      const f32x4 q = __builtin_nontemporal_load((const f32x4*)(src + (long)(k0 + r) * ldsrc + n));
      v[i] = make_float4(q[0], q[1], q[2], q[3]);
    }
  }
#pragma unroll
  for (int i = 0; i < 8; ++i) {
    int f = tid + i * 512; int r = f >> 6, c4 = (f & 63) * 4;
    float* tp = tile + r * 257 + c4;
    tp[0] = v[i].x; tp[1] = v[i].y; tp[2] = v[i].z; tp[3] = v[i].w;
  }
  __syncthreads();
  {
    const int n = tid >> 1, kc = (tid & 1) * 32;
    const float* tp = tile + kc * 257 + n;
    const int nn = n0 + n;
    const long row = (long)(nn / grp) * gstride + (nn % grp) + goff;
    uint4* dp = (uint4*)(dst + row * lddst + k0 + kc);
#pragma unroll
    for (int q = 0; q < 4; ++q) {
      uint4 o;
      o.x = pk2(tp[(q * 8 + 0) * 257], tp[(q * 8 + 1) * 257]);
      o.y = pk2(tp[(q * 8 + 2) * 257], tp[(q * 8 + 3) * 257]);
      o.z = pk2(tp[(q * 8 + 4) * 257], tp[(q * 8 + 5) * 257]);
      o.w = pk2(tp[(q * 8 + 6) * 257], tp[(q * 8 + 7) * 257]);
      dp[q] = o;
    }
  }
  __syncthreads();
}
DEVINL void tr_job(const float* src, int K, int N, int Npad, u16* dst, int bid, int nb) {
  const int tk = K / 64, tn = Npad / 256;
  for (int t = bid; t < tk * tn; t += nb) {
    int kt = t % tk, ntile = t / tk;
    tr_tile(src, N, N, kt * 64, ntile * 256, dst, K, 1 << 30, 0, 0);
  }
}

DEVINL void phase0(const Params& p) {
  char* ws = p.ws;
  const int bid = blockIdx.x, nb = gridDim.x, tid = otid();
  {
    const float4* xs = (const float4*)p.x;
    uint2* xd = (uint2*)(ws + O_XBF);
    const long n4 = (long)T_ * D_ / 4;
    const long stride = (long)nb * 512;
    for (long i = (long)bid * 512 + tid; i < n4; i += 4 * stride) {
      float4 v0 = xs[i], v1 = xs[i + stride], v2 = xs[i + 2 * stride], v3 = xs[i + 3 * stride];
      xd[i] = make_uint2(pk2(v0.x, v0.y), pk2(v0.z, v0.w));
      xd[i + stride] = make_uint2(pk2(v1.x, v1.y), pk2(v1.z, v1.w));
      xd[i + 2 * stride] = make_uint2(pk2(v2.x, v2.y), pk2(v2.z, v2.w));
      xd[i + 3 * stride] = make_uint2(pk2(v3.x, v3.y), pk2(v3.z, v3.w));
    }
  }
  tr_job(p.w_in, 2048, NC, NCP, (u16*)(ws + O_WINT), bid, nb);
  tr_job(p.w_up_gla, 1024, 2048, 2048, (u16*)(ws + O_WUPGT), bid, nb);
  tr_job(p.w_up_rwkv, 1024, 2048, 2048, (u16*)(ws + O_WUPRT), bid, nb);
  tr_job(p.w_out, 2048, 2048, 2048, (u16*)(ws + O_WOUTT), bid, nb);
  tr_job(p.rw_w_up_f, 64, 1024, 1024, (u16*)(ws + O_LWF), bid, nb);
  tr_job(p.rw_w_up_b, 64, 1024, 1024, (u16*)(ws + O_LWB), bid, nb);
  tr_job(p.rw_a_up, 64, 1024, 1024, (u16*)(ws + O_LA), bid, nb);
  tr_job(p.rw_g_up, 128, 1024, 1024, (u16*)(ws + O_LG), bid, nb);
}

DEVINL void phase1(const Params& p) {
  const u16* A = (const u16*)(p.ws + O_XBF);
  const u16* Bt = (const u16*)(p.ws + O_WINT);
  const int ntiles = 32 * 42;
  for (int t = blockIdx.x; t < ntiles; t += gridDim.x) {
    int pm = t & 31, pn = t >> 5;
    gemm_tile<EPI_COLS, false>(p, A, 2048, nullptr, Bt, 2048, 2048, pm * 256, pn * 256, pm * 256, pn * 256);
  }
}

DEVINL void gla_prep_unit(const Params& p, int unit) {
  const int h = unit & 3, c = (unit >> 2) & 63, b = unit >> 8;
  char* ws = p.ws;
  const u16* cols = (const u16*)(ws + O_COLS);
  const int tid = otid();
  float* afab = (float*)dynsmem;
  float* G = (float*)(dynsmem + 8192);
  u16* KD = (u16*)(dynsmem + 8192 + 65536);
  u16* VL = (u16*)dynsmem;
  const long tok0 = (long)b * S_ + c * 64;
  for (int i = tid; i < 64 * 32; i += 512) {
    int r = i >> 5, cc = i & 31;
    afab[i] = bf2f(cols[(tok0 + r) * NCP + C_AF + cc]);
  }
  __syncthreads();
  if (tid < 256) {
    const int dir = tid >> 7, kk = tid & 127;
    const float* up = dir ? p.gla_a_up_b : p.gla_a_up_f;
    const float bias = (dir ? p.gla_a_bias_b : p.gla_a_bias_f)[h * 128 + kk];
    float u[16];
#pragma unroll
    for (int r = 0; r < 16; ++r) u[r] = up[r * 512 + h * 128 + kk];
    float* Gc = G + dir * 64 * 128 + kk;
    for (int i = 0; i < 64; ++i) {
      float z = bias;
#pragma unroll
      for (int r = 0; r < 16; ++r) z += afab[i * 32 + dir * 16 + r] * u[r];
      Gc[i * 128] = logsig(z) * (1.f / 16.f);
    }
    float run = 0.f;
    if (dir == 0) { for (int i = 0; i < 64; ++i) { run += Gc[i * 128]; Gc[i * 128] = run; } }
    else { for (int i = 63; i >= 0; --i) { run += Gc[i * 128]; Gc[i * 128] = run; } }
    const float bedge = run;
    const long hb = ((long)(dir * 2 + b) * 4 + h);
    u16* qt = (u16*)(ws + O_QT) + (hb * 4096 + c * 64) * 128 + kk;
    u16* kt = (u16*)(ws + O_KT) + (hb * 4096 + c * 64) * 128 + kk;
    ((float*)(ws + O_DEC))[(hb * 64 + c) * 128 + kk] = __expf(bedge);
    u16* KDr = KD + (dir * 128 + kk) * 72;
    const unsigned short* qsrc = cols + tok0 * NCP + C_Q + h * 128 + kk;
    const unsigned short* ksrc = cols + tok0 * NCP + C_K + h * 128 + kk;
#pragma unroll 1
    for (int i0 = 0; i0 < 64; i0 += 8) {
      u16 qv[8], kv[8];
#pragma unroll
      for (int j = 0; j < 8; ++j) { qv[j] = qsrc[(long)(i0 + j) * NCP]; kv[j] = ksrc[(long)(i0 + j) * NCP]; }
#pragma unroll
      for (int j = 0; j < 8; ++j) {
        const int i = i0 + j;
        float bb = Gc[i * 128];
        float q = bf2f(qv[j]);
        float k = bf2f(kv[j]);
        qt[i * 128] = f2bf(q * 0.08838834764831845f * __expf(bb));
        kt[i * 128] = f2bf(k * __expf(-bb));
        KDr[i] = f2bf(k * __expf(bedge - bb));
      }
    }
  }
  __syncthreads();
#pragma unroll 8
  for (int idx = tid; idx < 64 * 256; idx += 512) {
    int i = idx >> 8, vc = idx & 255;
    VL[vc * 72 + i] = cols[(tok0 + i) * NCP + C_V + h * 256 + vc];
  }
  __syncthreads();
  for (int pc = tid; pc < 4096; pc += 512) {
    int row = pc >> 3, ch = pc & 7;
    if (row < 256) {
      int dir = row >> 7, kk = row & 127;
      uint4 v = *(const uint4*)(KD + row * 72 + ch * 8);
      long hb = ((long)(dir * 2 + b) * 4 + h);
      *(uint4*)((u16*)(ws + O_KDT) + ((hb * 64 + c) * 128 + kk) * 64 + ch * 8) = v;
    } else {
      int vc = row - 256;
      uint4 v = *(const uint4*)(VL + vc * 72 + ch * 8);
      long hb = ((long)b * 4 + h);
      *(uint4*)((u16*)(ws + O_VT) + ((hb * 64 + c) * 256 + vc) * 64 + ch * 8) = v;
    }
  }
  __syncthreads();
}

DEVINL float rw_shift2(const char* colsb, float muv, unsigned o, int s) {
  const unsigned op = (s > 0) ? o - (unsigned)(NCP * 2) : o;
  const unsigned on = (s < S_ - 1) ? o + (unsigned)(NCP * 2) : o;
  float cur = bf2f(*(const u16*)(colsb + o));
  float prv = bf2f(*(const u16*)(colsb + op));
  float nxt = bf2f(*(const u16*)(colsb + on));
  if (s == 0) prv = 0.f;
  if (s == S_ - 1) nxt = 0.f;
  return cur + muv * (0.5f * (prv + nxt) - cur);
}

DEVINL void rw_shift4(const char* colsb, float4 mu, unsigned o, int s, float (&out)[4]) {
  const unsigned op = (s > 0) ? o - (unsigned)(NCP * 2) : o;
  const unsigned on = (s < S_ - 1) ? o + (unsigned)(NCP * 2) : o;
  const uint2 c = *(const uint2*)(colsb + o);
  uint2 pv = *(const uint2*)(colsb + op);
  uint2 nx = *(const uint2*)(colsb + on);
  if (s == 0) pv = make_uint2(0u, 0u);
  if (s == S_ - 1) nx = make_uint2(0u, 0u);
  const float cu[4] = {bflo(c.x), bfhi(c.x), bflo(c.y), bfhi(c.y)};
  const float pr[4] = {bflo(pv.x), bfhi(pv.x), bflo(pv.y), bfhi(pv.y)};
  const float nn[4] = {bflo(nx.x), bfhi(nx.x), bflo(nx.y), bfhi(nx.y)};
  const float m[4] = {mu.x, mu.y, mu.z, mu.w};
#pragma unroll
  for (int e = 0; e < 4; ++e) out[e] = cu[e] + m[e] * (0.5f * (pr[e] + nn[e]) - cu[e]);
}

DEVINL void rw_prep_unit(const Params& p, int unit) {
  char* ws = p.ws;
  const char* colsb = ws + O_COLS;
  const int tid = otid(), lane = tid & 63, wave = tid >> 6, l15 = lane & 15, g = lane >> 4;
  u16* AL = (u16*)dynsmem;
  const int tok0 = unit * 32;
#pragma unroll 5
  for (int idx = tid; idx < 32 * 320; idx += 512) {
    int i = idx / 320, j = idx % 320;
    int t = tok0 + i; int s = t & (S_ - 1);
    unsigned o = ((unsigned)t * (unsigned)NCP + (unsigned)(C_RW + 3072 + j)) * 2u;
    float v = rw_shift2(colsb, p.rw_mu[3072 + j], o, s);
    if (j < 128) v = tanh_(v);
    else if (j >= 192) v = sigm(v);
    AL[i * 328 + j] = f2bf(v);
  }
  __syncthreads();
  const u16* LWF = (const u16*)(ws + O_LWF);
  const u16* LWB = (const u16*)(ws + O_LWB);
  const u16* LA = (const u16*)(ws + O_LA);
  const u16* LG = (const u16*)(ws + O_LG);
#pragma unroll 1
  for (int hh = 0; hh < 2; ++hh) {
    const int head = wave * 2 + hh;
#pragma unroll 1
    for (int mt = 0; mt < 2; ++mt) {
      f32x4 awf[4], awb[4], aa[4], ag[4];
#pragma unroll
      for (int n = 0; n < 4; ++n) { awf[n] = f32x4{0, 0, 0, 0}; awb[n] = awf[n]; aa[n] = awf[n]; ag[n] = awf[n]; }
      const u16* arow = AL + (mt * 16 + l15) * 328 + 8 * g;
#pragma unroll
      for (int ks = 0; ks < 2; ++ks) {
        bf16x8 fwf = *(const bf16x8*)(arow + 32 * ks);
        bf16x8 fwb = *(const bf16x8*)(arow + 64 + 32 * ks);
        bf16x8 fa = *(const bf16x8*)(arow + 128 + 32 * ks);
#pragma unroll
        for (int n = 0; n < 4; ++n) {
          const unsigned bo = (unsigned)((head * 64 + l15 * 4 + n) * 64 + 32 * ks + 8 * g) * 2u;
          bf16x8 b1 = *(const bf16x8*)((const char*)LWF + bo);
          bf16x8 b2 = *(const bf16x8*)((const char*)LWB + bo);
          bf16x8 b3 = *(const bf16x8*)((const char*)LA + bo);
          awf[n] = MFMA16(fwf, b1, awf[n]);
          awb[n] = MFMA16(fwb, b2, awb[n]);
          aa[n] = MFMA16(fa, b3, aa[n]);
        }
        __builtin_amdgcn_sched_barrier(0);
      }
#pragma unroll
      for (int ks = 0; ks < 4; ++ks) {
        bf16x8 fg = *(const bf16x8*)(arow + 192 + 32 * ks);
#pragma unroll
        for (int n = 0; n < 4; ++n) {
          const unsigned bo = (unsigned)((head * 64 + l15 * 4 + n) * 128 + 32 * ks + 8 * g) * 2u;
          bf16x8 b4 = *(const bf16x8*)((const char*)LG + bo);
          ag[n] = MFMA16(fg, b4, ag[n]);
        }
        __builtin_amdgcn_sched_barrier(0);
      }
#pragma unroll 2
      for (int j = 0; j < 4; ++j) {
        int jo = j, zo = 0;
        asm volatile("" : "+v"(jo), "+v"(zo));
        const int t = tok0 + mt * 16 + 4 * g + jo;
        const int s = t & (S_ - 1), b = t >> 12;
        const unsigned c0 = (unsigned)(head * 64 + l15 * 4 + zo);
        const unsigned rowo = (unsigned)t * (unsigned)(NCP * 2) + (unsigned)(C_RW * 2) + c0 * 2u;
        float pr[4], pkr[4], pv[4];
        rw_shift4(colsb, *(const float4*)(p.rw_mu + c0), rowo, s, pr);
        rw_shift4(colsb, *(const float4*)(p.rw_mu + 1024u + c0), rowo + 2048u, s, pkr);
        rw_shift4(colsb, *(const float4*)(p.rw_mu + 2048u + c0), rowo + 4096u, s, pv);
        const float4 a0q = *(const float4*)(p.rw_a0 + c0), kkq = *(const float4*)(p.rw_k_k + c0);
        const float4 kaq = *(const float4*)(p.rw_k_a + c0), rkq = *(const float4*)(p.rw_r_k + c0);
        const float4 w0fq = *(const float4*)(p.rw_w0_f + c0), w0bq = *(const float4*)(p.rw_w0_b + c0);
        const float a0v[4] = {a0q.x, a0q.y, a0q.z, a0q.w}, kkp[4] = {kkq.x, kkq.y, kkq.z, kkq.w};
        const float kap[4] = {kaq.x, kaq.y, kaq.z, kaq.w}, rkp[4] = {rkq.x, rkq.y, rkq.z, rkq.w};
        const float w0f[4] = {w0fq.x, w0fq.y, w0fq.z, w0fq.w}, w0b[4] = {w0bq.x, w0bq.y, w0bq.z, w0bq.w};
        float pk[4], av[4], kkv[4];
        float n2 = 0.f, dot = 0.f;
#pragma unroll
        for (int n = 0; n < 4; ++n) {
          const float kraw = pkr[n];
          float a = sigm(a0v[n] + sel4(aa[n], j));
          av[n] = a;
          float kk = kraw * kkp[n];
          kkv[n] = kk;
          n2 += kk * kk;
          float k2 = kraw * (1.f + (a - 1.f) * kap[n]);
          pk[n] = k2;
          dot += pr[n] * k2 * rkp[n];
        }
        n2 = allred16(n2);
        dot = allred16(dot);
        const float inv = 1.f / fmaxf(sqrtf(n2), 1e-12f);
        const unsigned reco = ((unsigned)((b * 16 + head) * 4096 + s)) * 1024u;
        const unsigned tco = (unsigned)t * 2048u + c0 * 2u;
        unsigned hwf[4], hwb[4], ha[4], hb[4], hk[4], hr[4], hv[4], bg[4], bbn[4];
#pragma unroll
        for (int n = 0; n < 4; ++n) {
          float wf = __expf(-0.606531f * sigm(w0f[n] + sel4(awf[n], j)));
          float wb = __expf(-0.606531f * sigm(w0b[n] + sel4(awb[n], j)));
          float kkn = kkv[n] * inv;
          hwf[n] = f2h(wf); hwb[n] = f2h(wb); ha[n] = f2h(-kkn); hb[n] = f2h(kkn * av[n]);
          hk[n] = f2h(pk[n]); hr[n] = f2h(pr[n]); hv[n] = f2h(pv[n]);
          bg[n] = f2bf(sel4(ag[n], j)); bbn[n] = f2bf(dot * pv[n]);
        }
        char* rb = ws + O_REC + (reco + (unsigned)l15 * 64u);
        *(uint4*)(rb) = make_uint4(hwf[0] | (hwf[1] << 16), hwf[2] | (hwf[3] << 16), hwb[0] | (hwb[1] << 16), hwb[2] | (hwb[3] << 16));
        *(uint4*)(rb + 16) = make_uint4(ha[0] | (ha[1] << 16), ha[2] | (ha[3] << 16), hb[0] | (hb[1] << 16), hb[2] | (hb[3] << 16));
        *(uint4*)(rb + 32) = make_uint4(hk[0] | (hk[1] << 16), hk[2] | (hk[3] << 16), hr[0] | (hr[1] << 16), hr[2] | (hr[3] << 16));
        *(uint2*)(rb + 48) = make_uint2(hv[0] | (hv[1] << 16), hv[2] | (hv[3] << 16));
        *(uint2*)(ws + O_GRW + tco) = make_uint2(bg[0] | (bg[1] << 16), bg[2] | (bg[3] << 16));
        *(uint2*)(ws + O_BONUS + tco) = make_uint2(bbn[0] | (bbn[1] << 16), bbn[2] | (bbn[3] << 16));
      }
    }
  }
  __syncthreads();
}

DEVINL void phase2(const Params& p) {
  const int bid = blockIdx.x, nb = gridDim.x, tid = otid();
  for (int u = bid; u < 512; u += nb) gla_prep_unit(p, u);
  for (int u = bid; u < 256; u += nb) rw_prep_unit(p, u);
}

typedef unsigned u32x2 __attribute__((ext_vector_type(2)));
typedef unsigned u32x4 __attribute__((ext_vector_type(4)));
template <int DIR>
DEVINL void rwkv_scan_dir(const Params& p, int task, int lane, int wave) {
  const int b = (task >> 8) & 1, head = (task >> 4) & 15, rg = task & 15;
  const int seg = lane & 15, rl = lane >> 4, row = rg * 4 + rl;
  constexpr int DIST = 24;
  constexpr int WOFS = DIR ? 8 : 0;
  const char* recbase = p.ws + O_REC + ((long)(b * 16 + head) * 4096) * 1024 + lane * 16;
  const unsigned ring_lds = (unsigned)(unsigned long)(__attribute__((address_space(3))) char*)(dynsmem + wave * 32768);
  const unsigned ring_u = __builtin_amdgcn_readfirstlane(ring_lds);
  const unsigned a_seg = ring_lds + seg * 64;
  const unsigned a_v = ring_lds + (row >> 2) * 64 + 48 + (row & 3) * 2;
  float* yo = (float*)(p.ws + (DIR ? O_YB : O_YSUM)) + ((long)b * 4096) * 1024 + head * 64 + row;
  float s0 = 0.f, s1 = 0.f, s2 = 0.f, s3 = 0.f;
  float ykeep = 0.f;
  const char* recdir = recbase + (DIR ? (long)4095 * 1024 : 0);
#define RW_GPTR(q_, gp_) const char* gp_ = recdir + (DIR ? -(long)(q_) * 1024 : (long)(q_) * 1024);
#define RW_DMA_ONLY(q_) do { RW_GPTR(q_, gp_) unsigned keep_; const unsigned ld_ = ring_u + ((q_) & 31) * 1024; \
    asm volatile("s_mov_b32 %0, m0\n\ts_mov_b32 m0, %2\n\ts_nop 0\n\tglobal_load_lds_dwordx4 %1, off\n\ts_mov_b32 m0, %0" \
                 : "=&s"(keep_) : "v"(gp_), "s"(ld_) : "memory"); } while (0)
#define RW_READ(U1, WN, XN, KN, VN, VMC) do { \
    asm volatile("s_waitcnt vmcnt(" #VMC ")\n\t" \
                 "ds_read_b64 %0, %4 offset:%6\n\t" \
                 "ds_read_b128 %1, %4 offset:%7\n\t" \
                 "ds_read_b128 %2, %4 offset:%8\n\t" \
                 "ds_read_u16 %3, %5 offset:%9" \
                 : "=&v"(WN), "=&v"(XN), "=&v"(KN), "=&v"(VN) \
                 : "v"(a_seg), "v"(a_v), \
                   "i"(((U1) & 31) * 1024 + WOFS), "i"(((U1) & 31) * 1024 + 16), "i"(((U1) & 31) * 1024 + 32), "i"(((U1) & 31) * 1024) \
                 : "memory"); } while (0)
#define RW_LANDED(WN, XN, KN, VN) asm volatile("s_waitcnt lgkmcnt(0)" : "+v"(WN), "+v"(XN), "+v"(KN), "+v"(VN) :: "memory")
#define RW_STEP(U, WC, XC, KC, VC, WN, XN, KN, VN) do { \
    { RW_GPTR(st + (U) + DIST, gp_) \
      const unsigned ld_ = ring_u + (((U) + DIST) & 31) * 1024; unsigned keep_; \
      asm volatile("s_mov_b32 m0, %2\n\ts_nop 0\n\tglobal_load_lds_dwordx4 %1, off" \
                   : "=&s"(keep_) : "v"(gp_), "s"(ld_) : "memory"); } \
    RW_READ((U) + 1, WN, XN, KN, VN, 23); \
    float pa = fmul_lo(s0, XC.x); pa = fmix_hi(s1, XC.x, pa); \
    float pb = fmul_lo(s2, XC.y); pb = fmix_hi(s3, XC.y, pb); \
    float t0_ = fmul_lo(s0, WC.x), t1_ = fmul_hi(s1, WC.x), t2_ = fmul_lo(s2, WC.y), t3_ = fmul_hi(s3, WC.y); \
    t0_ = fmixhh_lo(VC, KC.x, t0_); t1_ = fmixhh_hi(VC, KC.x, t1_); \
    t2_ = fmixhh_lo(VC, KC.y, t2_); t3_ = fmixhh_hi(VC, KC.y, t3_); \
    float sa = pa + pb, yprev = ypart;            \
    allred16x2(sa, yprev); \
    ykeep = (seg == (((U) + 15) & 15)) ? yprev : ykeep; \
    s0 = fmix_lo(sa, XC.z, t0_); \
    s1 = fmix_hi(sa, XC.z, t1_); \
    s2 = fmix_lo(sa, XC.w, t2_); \
    s3 = fmix_hi(sa, XC.w, t3_); \
    float ya = fmul_lo(s0, KC.z); ya = fmix_hi(s1, KC.z, ya); \
    float yb = fmul_lo(s2, KC.w); yb = fmix_hi(s3, KC.w, yb); \
    ypart = ya + yb; \
    RW_LANDED(WN, XN, KN, VN); } while (0)
#define RW_STEP2(B) RW_STEP(B, WvA, XA, KrA, vhA, WvB, XB, KrB, vhB); RW_STEP((B) + 1, WvB, XB, KrB, vhB, WvA, XA, KrA, vhA)
#define RW_STEP4(B) RW_STEP2(B); RW_STEP2((B) + 2)
#define RW_DMA4(B) RW_DMA_ONLY(B); RW_DMA_ONLY((B) + 1); RW_DMA_ONLY((B) + 2); RW_DMA_ONLY((B) + 3)
  u32x2 WvA, WvB; u32x4 XA, XB, KrA, KrB; unsigned vhA, vhB;
  RW_DMA4(0); RW_DMA4(4); RW_DMA4(8); RW_DMA4(12); RW_DMA4(16); RW_DMA4(20);
  RW_READ(0, WvA, XA, KrA, vhA, 23);
  RW_LANDED(WvA, XA, KrA, vhA);
  float ypart = 0.f;
#pragma unroll 1
  for (int st = 0; st < 4096; st += 32) {
    RW_STEP(0, WvA, XA, KrA, vhA, WvB, XB, KrB, vhB);
    if (st > 0) { const int q0 = st - 16 + seg; yo[(long)(DIR ? (4095 - q0) : q0) * 1024] = ykeep; }
    RW_STEP(1, WvB, XB, KrB, vhB, WvA, XA, KrA, vhA);
    RW_STEP2(2); RW_STEP4(4); RW_STEP4(8); RW_STEP4(12);
    RW_STEP(16, WvA, XA, KrA, vhA, WvB, XB, KrB, vhB);
    { const int q0 = st + seg; yo[(long)(DIR ? (4095 - q0) : q0) * 1024] = ykeep; }
    RW_STEP(17, WvB, XB, KrB, vhB, WvA, XA, KrA, vhA);
    RW_STEP2(18); RW_STEP4(20); RW_STEP4(24); RW_STEP4(28);
  }
  {
    const float ylast = allred16(ypart);
    ykeep = (seg == 15) ? ylast : ykeep;
    const int q0 = 4096 - 16 + seg; yo[(long)(DIR ? (4095 - q0) : q0) * 1024] = ykeep;
  }
  asm volatile("s_waitcnt vmcnt(0)" ::: "memory");
#undef RW_READ
#undef RW_LANDED
#undef RW_STEP2
#undef RW_GPTR
#undef RW_DMA_ONLY
#undef RW_STEP
#undef RW_STEP4
#undef RW_DMA4
}
DEVINL void rwkv_scan_task(const Params& p, int task, int lane, int wave) {
  if (task >> 9) rwkv_scan_dir<1>(p, task, lane, wave);
  else rwkv_scan_dir<0>(p, task, lane, wave);
}

DEVINL void gla_scan_task(const Params& p, int task, int lane) {
  const int dir = task >> 7, b = (task >> 6) & 1, h = (task >> 4) & 3, vsl = task & 15;
  const int l15 = lane & 15, g = lane >> 4;
  const long hb = (long)(dir * 2 + b) * 4 + h;
  const u16* qt = (const u16*)(p.ws + O_QT) + hb * 4096 * 128 + l15 * 128 + 4 * g;
  const u16* kt = (const u16*)(p.ws + O_KT) + hb * 4096 * 128 + l15 * 128 + 4 * g;
  const u16* kdT = (const u16*)(p.ws + O_KDT) + hb * 64 * 128 * 64 + l15 * 64 + 4 * g;
  const u16* vT = (const u16*)(p.ws + O_VT) + ((long)b * 4 + h) * 64 * 256 * 64 + (16 * vsl + l15) * 64 + 4 * g;
  const float* dec = (const float*)(p.ws + O_DEC) + hb * 64 * 128 + 4 * g;
  u16* obuf = (u16*)(p.ws + O_OSUM) + (dir ? (long)T_ * 1024 : 0) + ((long)b * 4096) * 1024 + h * 256 + 16 * vsl + l15;
  f32x4 ST[8];
#pragma unroll
  for (int m = 0; m < 8; ++m) ST[m] = f32x4{0, 0, 0, 0};
  bf16x8 KF[4][4], VF[2], QF[4][4];
#define GL_LOAD_KV(KFx, VFx, c_) do { \
    _Pragma("unroll") for (int jt = 0; jt < 4; ++jt) _Pragma("unroll") for (int ks = 0; ks < 4; ++ks) \
      KFx[jt][ks] = ldfrag(kt + ((c_) * 64 + 16 * jt) * 128 + 32 * ks); \
    _Pragma("unroll") for (int s = 0; s < 2; ++s) VFx[s] = ldfrag(vT + (c_) * (256 * 64) + 32 * s); } while (0)
#define GL_LOAD_Q(it_, c_) do { \
    _Pragma("unroll") for (int ks = 0; ks < 4; ++ks) QF[it_][ks] = ldfrag(qt + ((c_) * 64 + 16 * (it_)) * 128 + 32 * ks); } while (0)
  {
    const int c0 = dir ? 63 : 0;
    GL_LOAD_KV(KF, VF, c0);
    GL_LOAD_Q(0, c0);
  }
  for (int cc = 0; cc < 64; ++cc) {
    const int c = dir ? 63 - cc : cc;
    const int tok0 = c * 64;
    GL_LOAD_Q(1, c); GL_LOAD_Q(2, c); GL_LOAD_Q(3, c);
    bf16x8 SBf[4];
#pragma unroll
    for (int ks = 0; ks < 4; ++ks) SBf[ks] = pack8(ST[2 * ks], ST[2 * ks + 1]);
    __builtin_amdgcn_sched_barrier(0);
#pragma unroll
    for (int it = 0; it < 4; ++it) {
      f32x4 X[4];
#pragma unroll
      for (int jt = 0; jt < 4; ++jt) {
        X[jt] = f32x4{0, 0, 0, 0};
        const bool need = dir ? (jt >= it) : (jt <= it);
        if (need) {
#pragma unroll
          for (int ks = 0; ks < 4; ++ks) X[jt] = MFMA16(KF[jt][ks], QF[it][ks], X[jt]);
          if (jt == it) {
#pragma unroll
            for (int r = 0; r < 4; ++r) {
              const int j = 4 * g + r;
              const bool keep = dir ? (j >= l15) : (j <= l15);
              if (!keep) X[jt][r] = 0.f;
            }
          }
        }
      }
      bf16x8 XA0 = pack8(X[0], X[1]), XA1 = pack8(X[2], X[3]);
      f32x4 O = f32x4{0, 0, 0, 0};
      O = MFMA16(XA0, VF[0], O);
      O = MFMA16(XA1, VF[1], O);
#pragma unroll
      for (int ks = 0; ks < 4; ++ks) O = MFMA16(QF[it][ks], SBf[ks], O);
#pragma unroll
      for (int r = 0; r < 4; ++r)
        obuf[(long)(tok0 + 16 * it + 4 * g + r) * 1024] = f2bf(O[r]);
    }
    __builtin_amdgcn_sched_barrier(0);
    bf16x8 KDF[8][2]; f32x4 Dv[8];
#pragma unroll
    for (int m = 0; m < 8; ++m) {
      Dv[m] = *(const f32x4*)(dec + c * 128 + 16 * m);
#pragma unroll
      for (int s = 0; s < 2; ++s) KDF[m][s] = ldfrag(kdT + (c * 128 + 16 * m) * 64 + 32 * s);
    }
    __builtin_amdgcn_sched_barrier(0);
#pragma unroll
    for (int m = 0; m < 4; ++m) {
      ST[m] = ST[m] * Dv[m];
      ST[m] = MFMA16(KDF[m][0], VF[0], ST[m]);
      ST[m] = MFMA16(KDF[m][1], VF[1], ST[m]);
    }
    __builtin_amdgcn_sched_barrier(0);
    const int cn = (cc < 63) ? (dir ? c - 1 : c + 1) : c;
    bf16x8 VFn[2];
    GL_LOAD_KV(KF, VFn, cn);
    GL_LOAD_Q(0, cn);
    __builtin_amdgcn_sched_barrier(0);
#pragma unroll
    for (int m = 4; m < 8; ++m) {
      ST[m] = ST[m] * Dv[m];
      ST[m] = MFMA16(KDF[m][0], VF[0], ST[m]);
      ST[m] = MFMA16(KDF[m][1], VF[1], ST[m]);
    }
    VF[0] = VFn[0]; VF[1] = VFn[1];
  }
#undef GL_LOAD_KV
#undef GL_LOAD_Q
}

DEVINL void phase3(const Params& p) {
  const int tid = otid(); const int wave = tid >> 6, lane = tid & 63;
  const int nb = gridDim.x;
  int vb = blockIdx.x;
  if ((nb & 7) == 0) vb = (blockIdx.x & 7) * (nb >> 3) + (blockIdx.x >> 3);
  if (wave < 4) {
    for (int task = vb * 4 + wave; task < 1024; task += nb * 4) rwkv_scan_task(p, task, lane, wave);
  } else if (wave == 4) {
    for (int task = vb; task < 256; task += nb) gla_scan_task(p, task, lane);
  }
}

DEVINL void phase4(const Params& p) {
  char* ws = p.ws;
  const int tid = otid();
  const int lane = tid & 63;
  const int gw = blockIdx.x * 8 + (tid >> 6), nw = gridDim.x * 8;
  const u16* cols = (const u16*)(ws + O_COLS);
  for (int u = gw; u < T_ * 4; u += nw) {
    const long t = u >> 2; const int h = u & 3;
    const int c = h * 256 + lane * 4;
    float4 o;
    {
      uint2 of = *(const uint2*)((const u16*)(ws + O_OSUM) + t * 1024 + c);
      uint2 ob = *(const uint2*)((const u16*)(ws + O_OSUM) + (long)T_ * 1024 + t * 1024 + c);
      o.x = bflo(of.x) + bflo(ob.x); o.y = bfhi(of.x) + bfhi(ob.x);
      o.z = bflo(of.y) + bflo(ob.y); o.w = bfhi(of.y) + bfhi(ob.y);
    }
    float ss = o.x * o.x + o.y * o.y + o.z * o.z + o.w * o.w;
    ss = allred64(ss);
    const float rstd = rsqrtf(ss * (1.f / 256.f) + 1e-5f);
    float4 ng = *(const float4*)(p.gla_norm_g + c);
    uint2 gg = *(const uint2*)(cols + t * NCP + C_G + c);
    float g0 = bflo(gg.x), g1 = bfhi(gg.x), g2 = bflo(gg.y), g3 = bfhi(gg.y);
    float y0 = o.x * rstd * ng.x * (g0 * sigm(g0));
    float y1 = o.y * rstd * ng.y * (g1 * sigm(g1));
    float y2 = o.z * rstd * ng.z * (g2 * sigm(g2));
    float y3 = o.w * rstd * ng.w * (g3 * sigm(g3));
    *(uint2*)((u16*)(ws + O_YGLA) + t * 1024 + c) = make_uint2(pk2(y0, y1), pk2(y2, y3));
  }
  for (int u = gw; u < T_ * 4; u += nw) {
    const long t = u >> 2; const int hq = u & 3;
    const int c = (hq * 4 + (lane >> 4)) * 64 + (lane & 15) * 4;
    float4 y = *(const float4*)((const float*)(ws + O_YSUM) + t * 1024 + c);
    {
      float4 y2 = *(const float4*)((const float*)(ws + O_YB) + t * 1024 + c);
      y.x += y2.x; y.y += y2.y; y.z += y2.z; y.w += y2.w;
    }
    float mu = allred16(y.x + y.y + y.z + y.w) * (1.f / 64.f);
    float d0 = y.x - mu, d1 = y.y - mu, d2 = y.z - mu, d3 = y.w - mu;
    float var = allred16(d0 * d0 + d1 * d1 + d2 * d2 + d3 * d3) * (1.f / 64.f);
    const float rstd = rsqrtf(var + 64e-5f);
    float4 lg = *(const float4*)(p.rw_ln_g + c);
    float4 lb = *(const float4*)(p.rw_ln_b + c);
    uint2 bo = *(const uint2*)((const u16*)(ws + O_BONUS) + t * 1024 + c);
    uint2 gg = *(const uint2*)((const u16*)(ws + O_GRW) + t * 1024 + c);
    float r0 = (d0 * rstd * lg.x + lb.x + bflo(bo.x)) * bflo(gg.x);
    float r1 = (d1 * rstd * lg.y + lb.y + bfhi(bo.x)) * bfhi(gg.x);
    float r2 = (d2 * rstd * lg.z + lb.z + bflo(bo.y)) * bflo(gg.y);
    float r3 = (d3 * rstd * lg.w + lb.w + bfhi(bo.y)) * bfhi(gg.y);
    *(uint2*)((u16*)(ws + O_YRW) + t * 1024 + c) = make_uint2(pk2(r0, r1), pk2(r2, r3));
  }
}

DEVINL void phase5(const Params& p) {
  const u16* A1 = (const u16*)(p.ws + O_YGLA);
  const u16* A2 = (const u16*)(p.ws + O_YRW);
  const u16* B1 = (const u16*)(p.ws + O_WUPGT);
  const u16* B2 = (const u16*)(p.ws + O_WUPRT);
  for (int t = blockIdx.x; t < 256; t += gridDim.x) {
    int pm = t & 31, pn = t >> 5;
    gemm_tile<EPI_M1, false>(p, A1, 1024, nullptr, B1, 1024, 1024, pm * 256, pn * 256, pm * 256, pn * 256);
  }
  for (int t = blockIdx.x; t < 256; t += gridDim.x) {
    int pm = t & 31, pn = t >> 5;
    gemm_tile<EPI_MERGED, false>(p, A2, 1024, nullptr, B2, 1024, 1024, pm * 256, pn * 256, pm * 256, pn * 256);
  }
}
DEVINL void phase6(const Params& p) {
  const u16* A = (const u16*)(p.ws + O_MERGED);
  const u16* Bt = (const u16*)(p.ws + O_WOUTT);
  for (int t = blockIdx.x; t < 256; t += gridDim.x) {
    int pm = t & 31, pn = t >> 5;
    gemm_tile<EPI_R1, false>(p, A, 2048, nullptr, Bt, 2048, 2048, pm * 256, pn * 256, pm * 256, pn * 256);
  }
}

DEVINL void phase7(const Params& p) {
  char* ws = p.ws;
  const int tid = otid();
  const int lane = tid & 63;
  const int gw = blockIdx.x * 8 + (tid >> 6), nw = gridDim.x * 8;
  for (int row = gw; row < T_; row += nw) {
    const u16* r1 = (const u16*)(ws + O_R1) + (long)row * 2048;
    float4 v[8];
    float sum = 0.f;
#pragma unroll
    for (int i = 0; i < 8; ++i) {
      const uint2 q = *(const uint2*)(r1 + i * 256 + lane * 4);
      v[i] = make_float4(bflo(q.x), bfhi(q.x), bflo(q.y), bfhi(q.y));
      sum += v[i].x + v[i].y + v[i].z + v[i].w;
    }
    const float mu = allred64(sum) * (1.f / 2048.f);
    float sq = 0.f;
#pragma unroll
    for (int i = 0; i < 8; ++i) {
      v[i].x -= mu; v[i].y -= mu; v[i].z -= mu; v[i].w -= mu;
      sq += v[i].x * v[i].x + v[i].y * v[i].y + v[i].z * v[i].z + v[i].w * v[i].w;
    }
    const float rstd = rsqrtf(allred64(sq) * (1.f / 2048.f) + 1e-5f);
    float lg[16];
#pragma unroll
    for (int e = 0; e < 16; ++e) lg[e] = 0.f;
#pragma unroll
    for (int i = 0; i < 8; ++i) {
      const int c = i * 256 + lane * 4;
      float4 gq = *(const float4*)(p.ln1_g + c);
      float4 bq = *(const float4*)(p.ln1_b + c);
      float h0 = v[i].x * rstd * gq.x + bq.x, h1 = v[i].y * rstd * gq.y + bq.y;
      float h2 = v[i].z * rstd * gq.z + bq.z, h3 = v[i].w * rstd * gq.w + bq.w;
      *(uint2*)((u16*)(ws + O_HBF) + (long)row * 2048 + c) = make_uint2(pk2(h0, h1), pk2(h2, h3));
      const float hh[4] = {h0, h1, h2, h3};
#pragma unroll
      for (int q = 0; q < 4; ++q) {
        const float4* wr = (const float4*)(p.w_router + (long)(c + q) * 16);
#pragma unroll
        for (int e4 = 0; e4 < 4; ++e4) {
          float4 w = wr[e4];
          lg[e4 * 4 + 0] += hh[q] * w.x; lg[e4 * 4 + 1] += hh[q] * w.y;
          lg[e4 * 4 + 2] += hh[q] * w.z; lg[e4 * 4 + 3] += hh[q] * w.w;
        }
      }
    }
    float mx = -1e30f;
#pragma unroll
    for (int e = 0; e < 16; ++e) { lg[e] = allred64(lg[e]); mx = fmaxf(mx, lg[e]); }
    float den = 0.f;
#pragma unroll
    for (int e = 0; e < 16; ++e) { lg[e] = __expf(lg[e] - mx); den += lg[e]; }
    const float inv = 1.f / den;
    float mine = 0.f;
#pragma unroll
    for (int e = 0; e < 16; ++e) if (lane == e) mine = lg[e] * inv;
    if (lane < 16) {
      const int b = row >> 12, s = row & 4095;
      ((float*)(ws + O_AFF))[((long)(b * 16 + lane)) * 4096 + s] = mine;
      ((int*)(ws + O_INV))[row * 16 + lane] = -1;
    }
  }
}

DEVINL void phase8(const Params& p) {
  char* ws = p.ws;
  const int bid = blockIdx.x, nb = gridDim.x, tid = otid();
  for (int pr = bid; pr < 32; pr += nb) {
    const int b = pr >> 4, e = pr & 15;
    unsigned* cnt = (unsigned*)dynsmem;
    const float* aff = (const float*)(ws + O_AFF) + (long)pr * 4096;
    const int lane = tid & 63;
    unsigned key[8];
#pragma unroll
    for (int i = 0; i < 8; ++i) key[i] = __float_as_uint(aff[tid + 512 * i]);
    if (tid < 40) cnt[tid] = 0u;
    __syncthreads();
    unsigned T = 0u;
    for (int bit = 30; bit >= 0; --bit) {
      const unsigned cand = T | (1u << bit);
      int c = 0;
#pragma unroll
      for (int i = 0; i < 8; ++i) c += (key[i] >= cand) ? 1 : 0;
      const float cf = allred64((float)c);
      if (lane == 0) atomicAdd(&cnt[bit], (unsigned)cf);
      __syncthreads();
      if (cnt[bit] >= 512u) T = cand;
    }
    {
      int c = 0;
#pragma unroll
      for (int i = 0; i < 8; ++i) c += (key[i] > T) ? 1 : 0;
      const float cf = allred64((float)c);
      if (lane == 0) atomicAdd(&cnt[31], (unsigned)cf);
      __syncthreads();
    }
    const unsigned ngt = cnt[31];
#pragma unroll
    for (int i = 0; i < 8; ++i) {
      int slot = -1;
      if (key[i] > T) slot = (int)atomicAdd(&cnt[32], 1u);
      else if (key[i] == T) { unsigned s2 = atomicAdd(&cnt[33], 1u); if (ngt + s2 < 512u) slot = (int)(ngt + s2); }
      if (slot >= 0) {
        ((int*)(ws + O_SELT))[e * 1024 + b * 512 + slot] = b * 4096 + tid + 512 * i;
        ((float*)(ws + O_SELG))[e * 1024 + b * 512 + slot] = __uint_as_float(key[i]);
        ((int*)(ws + O_INV))[(b * 4096 + tid + 512 * i) * 16 + e] = e * 1024 + b * 512 + slot;
      }
    }
    __syncthreads();
  }
  for (int t = bid; t < 16 * 128 * 3; t += nb) {
    const int which = t / (16 * 128), r = t % (16 * 128), e = r >> 7, tt = r & 127;
    if (which < 2) {
      const float* src = (which ? p.w3 : p.w1) + (long)e * 2048 * 1024;
      int kt = tt & 31, ntile = tt >> 5;
      tr_tile(src, 1024, 1024, kt * 64, ntile * 256, (u16*)(ws + O_W13T) + (long)e * 2048 * 2048, 2048, 128, 256, which * 128);
    } else {
      const float* src = p.w2 + (long)e * 1024 * 2048;
      int kt = tt & 15, ntile = tt >> 4;
      tr_tile(src, 2048, 2048, kt * 64, ntile * 256, (u16*)(ws + O_W2T) + (long)e * 2048 * 1024, 1024, 1 << 30, 0, 0);
    }
  }
}

DEVINL void phase9(const Params& p) {
  const u16* A = (const u16*)(p.ws + O_XE);
  for (int t = blockIdx.x; t < 512; t += gridDim.x) {
    const int e = t >> 5, pm = t & 3, pn = (t >> 2) & 7;
    const u16* Bt = (const u16*)(p.ws + O_W13T) + (long)e * 2048 * 2048;
    gemm_tile<EPI_HID, true>(p, (const u16*)(p.ws + O_HBF), 2048, (const int*)(p.ws + O_SELT), Bt, 2048, 2048, e * 1024 + pm * 256, pn * 256, e * 1024 + pm * 256, pn * 128);
  }
}
DEVINL void phase10(const Params& p) {
  const u16* A = (const u16*)(p.ws + O_HID);
  for (int t = blockIdx.x; t < 512; t += gridDim.x) {
    const int e = t >> 5, pm = t & 3, pn = (t >> 2) & 7;
    const u16* Bt = (const u16*)(p.ws + O_W2T) + (long)e * 2048 * 1024;
    gemm_tile<EPI_MOE2, false>(p, A, 1024, nullptr, Bt, 1024, 1024, e * 1024 + pm * 256, pn * 256, e * 1024 + pm * 256, pn * 256);
  }
}

DEVINL void phase11(const Params& p) {
  const int tid = otid();
  const int lane = tid & 63;
  const int gw = blockIdx.x * 8 + (tid >> 6), nw = gridDim.x * 8;
  for (int row = gw; row < T_; row += nw) {
    const u16* hb = (const u16*)(p.ws + O_HBF) + (long)row * 2048;
    float4 v[8];
    float sum = 0.f;
#pragma unroll
    for (int i = 0; i < 8; ++i) {
      const uint2 q = *(const uint2*)(hb + i * 256 + lane * 4);
      v[i] = make_float4(ALPHA * bflo(q.x), ALPHA * bfhi(q.x), ALPHA * bflo(q.y), ALPHA * bfhi(q.y));
    }
    {
      const int* inv = (const int*)(p.ws + O_INV) + row * 16;
      const int myinv = inv[lane & 15];
#pragma unroll 1
      for (int e = 0; e < 16; ++e) {
        const int er = __shfl(myinv, e);
        if (er >= 0) {
          const u16* eo = (const u16*)(p.ws + O_EO) + (long)er * 2048 + lane * 4;
#pragma unroll
          for (int i = 0; i < 8; ++i) {
            uint2 q = *(const uint2*)(eo + i * 256);
            v[i].x += bflo(q.x); v[i].y += bfhi(q.x); v[i].z += bflo(q.y); v[i].w += bfhi(q.y);
          }
        }
      }
    }
#pragma unroll
    for (int i = 0; i < 8; ++i) sum += v[i].x + v[i].y + v[i].z + v[i].w;
    const float mu = allred64(sum) * (1.f / 2048.f);
    float sq = 0.f;
#pragma unroll
    for (int i = 0; i < 8; ++i) {
      v[i].x -= mu; v[i].y -= mu; v[i].z -= mu; v[i].w -= mu;
      sq += v[i].x * v[i].x + v[i].y * v[i].y + v[i].z * v[i].z + v[i].w * v[i].w;
    }
    const float rstd = rsqrtf(allred64(sq) * (1.f / 2048.f) + 1e-5f);
#pragma unroll
    for (int i = 0; i < 8; ++i) {
      const int c = i * 256 + lane * 4;
      float4 gq = *(const float4*)(p.ln2_g + c);
      float4 bq = *(const float4*)(p.ln2_b + c);
      *(float4*)(p.out + (long)row * 2048 + c) = make_float4(v[i].x * rstd * gq.x + bq.x, v[i].y * rstd * gq.y + bq.y,
                                                             v[i].z * rstd * gq.z + bq.z, v[i].w * rstd * gq.w + bq.w);
    }
  }
}

#define XB_TMO      128
#define XB_XCNT(j)  (256  + 64 * (j))
#define XB_XSUB(j)  (1280 + 64 * (j))
#define XB_XGEN(j)  (2304 + 64 * (j))
#define XB_TOP      3328
#define XB_TOPGEN   3392
#define XCD_BAR_WORDS 3456
#define XB_SPIN_CAP (1u << 20)
#define LAS __attribute__((address_space(3)))
DEVINL unsigned xb_ld(unsigned* p_) { return __hip_atomic_load(p_, __ATOMIC_RELAXED, __HIP_MEMORY_SCOPE_AGENT); }
DEVINL unsigned xb_add(unsigned* p_, unsigned v) { return __hip_atomic_fetch_add(p_, v, __ATOMIC_RELAXED, __HIP_MEMORY_SCOPE_AGENT); }
DEVINL unsigned xb_xcc_id() { return (unsigned)__builtin_amdgcn_s_getreg((3 << 11) | 20) & 0xFu; }
#define XB_SPIN(cond, bar) do { unsigned _sp = 0; while (cond) { __builtin_amdgcn_s_sleep(1); \
    if ((++_sp & 255u) == 0u) { if (xb_ld(&(bar)[XB_TMO])) break; if (_sp > XB_SPIN_CAP) { atomicAdd(&(bar)[XB_TMO], 1u); break; } } } } while (0)
struct XcdBarrier { unsigned* bar; unsigned x; volatile LAS unsigned* st; };
DEVINL XcdBarrier xcd_barrier_post(unsigned* bar, volatile LAS unsigned* st) {
  XcdBarrier b; b.bar = bar; b.x = xb_xcc_id(); b.st = st;
  if (threadIdx.x == 0) (void)xb_add(&bar[XB_XCNT(b.x)], 1u);
  return b;
}
DEVINL void xcd_barrier_complete(unsigned* bar, unsigned x, unsigned& nloc, unsigned& nx) {
  const unsigned G = gridDim.x * gridDim.y * gridDim.z;
  unsigned sum, cnt, mine, sp = 0u;
  for (;;) {
    sum = 0u; cnt = 0u; mine = 0u;
#pragma unroll
    for (unsigned j = 0; j < 16; ++j) { const unsigned c = xb_ld(&bar[XB_XCNT(j)]); sum += c; cnt += (c > 0u) ? 1u : 0u; mine = (j == x) ? c : mine; }
    if (sum == G) break;
    __builtin_amdgcn_s_sleep(1);
    if ((++sp & 255u) == 0u) { if (xb_ld(&bar[XB_TMO])) break; if (sp > XB_SPIN_CAP) { atomicAdd(&bar[XB_TMO], 1u); break; } }
  }
  nloc = mine > 0u ? mine : 1u; nx = cnt > 0u ? cnt : 1u;
}
DEVINL void xcd_barrier(const XcdBarrier& b) {
  asm volatile("s_waitcnt vmcnt(0)" ::: "memory");
  __syncthreads();
  if (threadIdx.x == 0) {
    unsigned* bar = b.bar;
    __builtin_amdgcn_s_waitcnt(0);
    unsigned nloc = b.st[0], nx = b.st[1];
    if (nloc == 0u) { xcd_barrier_complete(bar, b.x, nloc, nx); b.st[0] = nloc; b.st[1] = nx; }
    const unsigned old = xb_add(&bar[XB_XSUB(b.x)], 1u);
    const unsigned gen = old / nloc;
    if (old + 1u == (gen + 1u) * nloc) {
      __builtin_amdgcn_fence(__ATOMIC_RELEASE, "agent");
      asm volatile("s_waitcnt vmcnt(0)" ::: "memory");
      const unsigned og = xb_add(&bar[XB_TOP], 1u);
      const unsigned tg = og / nx;
      if (og + 1u == (tg + 1u) * nx) xb_add(&bar[XB_TOPGEN], 1u);
      else XB_SPIN(xb_ld(&bar[XB_TOPGEN]) == tg, bar);
      __builtin_amdgcn_fence(__ATOMIC_ACQUIRE, "agent");
      xb_add(&bar[XB_XGEN(b.x)], 1u);
      asm volatile("s_waitcnt vmcnt(0)" ::: "memory");
    } else {
      XB_SPIN(xb_ld(&bar[XB_XGEN(b.x)]) == gen, bar);
      __builtin_amdgcn_fence(__ATOMIC_ACQUIRE, "agent");
      asm volatile("s_waitcnt vmcnt(0)" ::: "memory");
    }
  }
  __syncthreads();
}

template <int PH> DEVINL void run_phase(const Params& p) {
  if (PH == 0) phase0(p);
  else if (PH == 1) phase1(p);
  else if (PH == 2) phase2(p);
  else if (PH == 3) phase3(p);
  else if (PH == 4) phase4(p);
  else if (PH == 5) phase5(p);
  else if (PH == 6) phase6(p);
  else if (PH == 7) phase7(p);
  else if (PH == 8) phase8(p);
  else if (PH == 9) phase9(p);
  else if (PH == 10) phase10(p);
  else if (PH == 11) phase11(p);
}

constexpr int SHM_BYTES = 131072;

#if MULTI
template <int PH> __global__ void __launch_bounds__(512, 2) k_phase(Params p) { run_phase<PH>(p); }
template <int PH> static void launch_phase(const Params& p, hipStream_t stream) {
  hipFuncSetAttribute((const void*)k_phase<PH>, hipFuncAttributeMaxDynamicSharedMemorySize, SHM_BYTES);
  k_phase<PH><<<256, 512, SHM_BYTES, stream>>>(p);
}
#else
__global__ void __launch_bounds__(512, 2) k_mega(Params p) {
  cg::grid_group grid = cg::this_grid();
  __shared__ uint4 xb_words;
  unsigned* bar = (unsigned*)(p.ws + O_BAR);
  if (threadIdx.x == 0) xb_words = make_uint4(0u, 0u, 0u, 0u);
  __syncthreads();
  XcdBarrier xb = xcd_barrier_post(bar, (volatile LAS unsigned*)&xb_words);
  if (p.out == nullptr) grid.sync();
  run_phase<0>(p); xcd_barrier(xb);
  run_phase<1>(p); xcd_barrier(xb);
  run_phase<2>(p); xcd_barrier(xb);
  run_phase<3>(p); xcd_barrier(xb);
  run_phase<4>(p); xcd_barrier(xb);
  run_phase<5>(p); xcd_barrier(xb);
  run_phase<6>(p); xcd_barrier(xb);
  run_phase<7>(p); xcd_barrier(xb);
  run_phase<8>(p); xcd_barrier(xb);
  run_phase<9>(p); xcd_barrier(xb);
  run_phase<10>(p); xcd_barrier(xb);
  run_phase<11>(p);
}
#endif

extern "C" void kernel_launch(void* const* d_in, const int* in_sizes, int n_in, void* d_out, int out_size,
                              void* d_ws, size_t ws_size, hipStream_t stream) {
  Params p{};
  const float** f = (const float**)&p;
  for (int i = 0; i < 31; ++i) f[i] = (const float*)d_in[i];
  p.out = (float*)d_out;
  p.ws = (char*)d_ws;
  if (ws_size < WS_NEED) { fprintf(stderr, "workspace too small: %zu < %zu\n", ws_size, (size_t)WS_NEED); return; }
#if MULTI
  launch_phase<0>(p, stream); launch_phase<1>(p, stream); launch_phase<2>(p, stream); launch_phase<3>(p, stream);
  launch_phase<4>(p, stream); launch_phase<5>(p, stream); launch_phase<6>(p, stream); launch_phase<7>(p, stream);
  launch_phase<8>(p, stream); launch_phase<9>(p, stream); launch_phase<10>(p, stream); launch_phase<11>(p, stream);
#else
  static int grid_blocks = 0;
  if (!grid_blocks) {
    int dev = 0, cus = 0, per_cu = 0;
    hipGetDevice(&dev);
    hipDeviceGetAttribute(&cus, hipDeviceAttributeMultiprocessorCount, dev);
    hipFuncSetAttribute((const void*)k_mega, hipFuncAttributeMaxDynamicSharedMemorySize, SHM_BYTES);
    hipOccupancyMaxActiveBlocksPerMultiprocessor(&per_cu, k_mega, 512, SHM_BYTES);
    if (per_cu < 1) per_cu = 1;
    grid_blocks = cus * per_cu;
    if (grid_blocks > 256) grid_blocks = 256;
  }
  hipMemsetAsync((char*)d_ws + O_BAR, 0, XCD_BAR_WORDS * sizeof(unsigned), stream);
  void* args[] = {&p};
  hipError_t e = hipLaunchCooperativeKernel((void*)k_mega, dim3(grid_blocks), dim3(512), args, SHM_BYTES, stream);
  if (e != hipSuccess) fprintf(stderr, "cooperative launch failed: %s (grid %d)\n", hipGetErrorString(e), grid_blocks);
#endif
}
```

```cpp
#include <hip/hip_runtime.h>
#include <hip/hip_cooperative_groups.h>
#include <cstdio>
namespace cg = cooperative_groups;

#ifndef MULTI
#define MULTI 0
#endif

typedef unsigned short u16;
typedef __bf16 bf2_t __attribute__((ext_vector_type(2)));
typedef float f2_t __attribute__((ext_vector_type(2)));
using bf16x8 = __attribute__((ext_vector_type(8))) short;
using s16x4 = __attribute__((ext_vector_type(4))) short;
using f32x4 = __attribute__((ext_vector_type(4))) float;
#define DEVINL __device__ __forceinline__

constexpr int T_ = 8192, S_ = 4096, D_ = 2048, NC = 10592, NCP = 10752;
constexpr int C_Q = 0, C_K = 512, C_V = 1024, C_G = 2048, C_AF = 3072, C_RW = 3104;
constexpr int C_GG = 6496, C_GR = 8544;
constexpr float ALPHA = 1.189207115f;

constexpr size_t MB = 1ull << 20;
constexpr size_t O_XBF = 0;
constexpr size_t O_WINT = 32 * MB;
constexpr size_t O_OSUM = 0;
constexpr size_t O_YSUM = 32 * MB;
constexpr size_t O_R1 = 0;
constexpr size_t O_COLS = 76 * MB;
constexpr size_t O_ACC2 = 76 * MB;
constexpr size_t O_W13T = 140 * MB;
constexpr size_t O_W2T = 268 * MB;
constexpr size_t O_HID = 332 * MB;
constexpr size_t O_REC = 244 * MB;
constexpr size_t O_YGLA = 244 * MB;
constexpr size_t O_YRW = 260 * MB;
constexpr size_t O_MERGED = 276 * MB;
constexpr size_t O_QT = 372 * MB;
constexpr size_t O_KT = 388 * MB;
constexpr size_t O_KDT = 404 * MB;
constexpr size_t O_VT = 420 * MB;
constexpr size_t O_DEC = 436 * MB;
constexpr size_t O_M1 = 372 * MB;
constexpr size_t O_HBF = 372 * MB;
constexpr size_t O_XE = 404 * MB;
constexpr size_t O_VSCAN = 437 * MB;
constexpr size_t O_GRW = 453 * MB;
constexpr size_t O_BONUS = 469 * MB;
constexpr size_t O_WUPGT = 485 * MB;
constexpr size_t O_WUPRT = 489 * MB;
constexpr size_t O_WOUTT = 493 * MB;
constexpr size_t O_LWF = 501 * MB;
constexpr size_t O_LWB = O_LWF + 128 * 1024;
constexpr size_t O_LA = O_LWB + 128 * 1024;
constexpr size_t O_LG = O_LA + 128 * 1024;
constexpr size_t O_AFF = 502 * MB;
constexpr size_t O_SELT = O_AFF + 512 * 1024;
constexpr size_t O_SELG = O_SELT + 64 * 1024;
constexpr size_t O_YB = 503 * MB;
constexpr size_t O_EO = 140 * MB;
constexpr size_t O_INV = 535 * MB;
constexpr size_t O_BAR = 535 * MB + 768 * 1024;
constexpr size_t WS_NEED = 536 * MB;

struct Params {
  const float *x, *w_in, *gla_a_up_f, *gla_a_bias_f, *gla_a_up_b, *gla_a_bias_b, *gla_norm_g;
  const float *rw_mu, *rw_w0_f, *rw_w_up_f, *rw_w0_b, *rw_w_up_b, *rw_a0, *rw_a_up, *rw_g_up;
  const float *rw_k_k, *rw_k_a, *rw_r_k, *rw_ln_g, *rw_ln_b, *w_up_gla, *w_up_rwkv, *w_out;
  const float *ln1_g, *ln1_b, *w_router, *w1, *w3, *w2, *ln2_g, *ln2_b;
  float* out;
  char* ws;
};

DEVINL unsigned pk2(float a, float b) {
  f2_t v = {a, b};
  bf2_t r = __builtin_convertvector(v, bf2_t);
  return *(unsigned*)&r;
}
DEVINL u16 f2bf(float a) { return (u16)(pk2(a, 0.f) & 0xffffu); }
DEVINL float bf2f(u16 h) { return __uint_as_float(((unsigned)h) << 16); }
DEVINL float bflo(unsigned u) { return __uint_as_float(u << 16); }
DEVINL float bfhi(unsigned u) { return __uint_as_float(u & 0xffff0000u); }
DEVINL float sigm(float x) { return 1.f / (1.f + __expf(-x)); }
DEVINL float tanh_(float x) { return 1.f - 2.f / (__expf(2.f * x) + 1.f); }
DEVINL float logsig(float z) { return fminf(z, 0.f) - __logf(1.f + __expf(-fabsf(z))); }
template <int CTRL> DEVINL float dppf(float x) {
  return __int_as_float(__builtin_amdgcn_update_dpp(0, __float_as_int(x), CTRL, 0xF, 0xF, true));
}
DEVINL float allred16(float x) {
  x += dppf<0xB1>(x); x += dppf<0x4E>(x); x += dppf<0x141>(x); x += dppf<0x140>(x);
  return x;
}
DEVINL void allred16x2(float& a, float& b) {
  a += dppf<0xB1>(a); b += dppf<0xB1>(b);
  a += dppf<0x4E>(a); b += dppf<0x4E>(b);
  a += dppf<0x141>(a); b += dppf<0x141>(b);
  a += dppf<0x140>(a); b += dppf<0x140>(b);
}
DEVINL float allred64(float x) {
  x = allred16(x);
  x += __shfl_xor(x, 16);
  x += __shfl_xor(x, 32);
  return x;
}
DEVINL bf16x8 mk8(s16x4 lo, s16x4 hi) {
  bf16x8 r;
  r[0] = lo[0]; r[1] = lo[1]; r[2] = lo[2]; r[3] = lo[3];
  r[4] = hi[0]; r[5] = hi[1]; r[6] = hi[2]; r[7] = hi[3];
  return r;
}
DEVINL bf16x8 pack8(f32x4 a, f32x4 b) {
  union { bf16x8 v; unsigned u[4]; } r;
  r.u[0] = pk2(a[0], a[1]); r.u[1] = pk2(a[2], a[3]);
  r.u[2] = pk2(b[0], b[1]); r.u[3] = pk2(b[2], b[3]);
  return r.v;
}
DEVINL bf16x8 ldfrag(const u16* base) {
  s16x4 lo = *(const s16x4*)base;
  s16x4 hi = *(const s16x4*)(base + 16);
  return mk8(lo, hi);
}
DEVINL float sel4(f32x4 v, int j) { return j == 0 ? v[0] : (j == 1 ? v[1] : (j == 2 ? v[2] : v[3])); }
DEVINL u16 f2h(float a) { _Float16 h = (_Float16)a; return __builtin_bit_cast(u16, h); }
DEVINL float fmix_lo(float s, unsigned h, float c) {
  float d; asm("v_fma_mix_f32 %0, %1, %2, %3 op_sel:[0,0,0] op_sel_hi:[0,1,0]" : "=v"(d) : "v"(s), "v"(h), "v"(c)); return d;
}
DEVINL float fmix_hi(float s, unsigned h, float c) {
  float d; asm("v_fma_mix_f32 %0, %1, %2, %3 op_sel:[0,1,0] op_sel_hi:[0,1,0]" : "=v"(d) : "v"(s), "v"(h), "v"(c)); return d;
}
DEVINL float fmixhh_lo(unsigned vh, unsigned h, float c) {
  float d; asm("v_fma_mix_f32 %0, %1, %2, %3 op_sel:[0,0,0] op_sel_hi:[1,1,0]" : "=v"(d) : "v"(vh), "v"(h), "v"(c)); return d;
}
DEVINL float fmixhh_hi(unsigned vh, unsigned h, float c) {
  float d; asm("v_fma_mix_f32 %0, %1, %2, %3 op_sel:[0,1,0] op_sel_hi:[1,1,0]" : "=v"(d) : "v"(vh), "v"(h), "v"(c)); return d;
}
DEVINL float fmul_hi(float s, unsigned h) {
  float d; asm("v_fma_mix_f32 %0, %1, %2, 0 op_sel:[0,1,0] op_sel_hi:[0,1,0]" : "=v"(d) : "v"(s), "v"(h)); return d;
}
DEVINL float fmul_lo(float s, unsigned h) {
  float d; asm("v_fma_mix_f32 %0, %1, %2, 0 op_sel:[0,0,0] op_sel_hi:[0,1,0]" : "=v"(d) : "v"(s), "v"(h)); return d;
}
#define MFMA16(a, b, c) __builtin_amdgcn_mfma_f32_16x16x32_bf16(a, b, c, 0, 0, 0)

extern __shared__ __attribute__((aligned(16))) char dynsmem[];
extern __shared__ __attribute__((aligned(16))) char dynsmem_rd[];
DEVINL int otid() { int t = threadIdx.x; asm volatile("" : "+v"(t)); return t; }

constexpr int BM = 256, BK = 64, HALF = 128, HT = HALF * BK;
DEVINL int lds_byte(int r, int c) {
  int st = (r >> 4) * 2 + (c >> 5), rr = r & 15, cc = c & 31, ob = rr * 64 + cc * 2;
  return st * 1024 + (ob ^ (((ob >> 9) & 1) << 5));
}
DEVINL void stage_rc(int b, int& R, int& C) {
  int st = b / 1024, sb = b % 1024, swz = sb ^ (((sb >> 9) & 1) << 5);
  R = (st >> 1) * 16 + swz / 64; C = (st & 1) * 32 + (swz % 64) / 2;
}

DEVINL void xchg_pairs(f32x4 v, bool odd, float (&lo)[2], float (&hi)[2]) {
  const float s0 = odd ? v[0] : v[2], s1 = odd ? v[1] : v[3];
  const float r0 = dppf<0xB1>(s0), r1 = dppf<0xB1>(s1);
  lo[0] = odd ? r0 : v[0]; hi[0] = odd ? v[2] : r0;
  lo[1] = odd ? r1 : v[1]; hi[1] = odd ? v[3] : r1;
}
enum { EPI_COLS = 0, EPI_M1, EPI_MERGED, EPI_R1, EPI_HID, EPI_MOE2 };

template <int EPI, bool GATHER>
DEVINL void gemm_tile(const Params& p, const u16* __restrict__ A, int lda, const int* __restrict__ rowidx,
                      const u16* __restrict__ Bt, int ldb, int K, int brow, int bcol, int orow, int ocol) {
  u16* shm = (u16*)dynsmem;
#define SA(b, h) (shm + ((b) * 2 + (h)) * HT)
#define SB(b, h) (shm + (4 + (b) * 2 + (h)) * HT)
  const int tid = otid();
  int offA[2][2], offB[2];
#pragma unroll
  for (int i = 0; i < 2; ++i) {
    int R, C; stage_rc(tid * 16 + i * 8192, R, C);
    offB[i] = R * ldb + C;
#pragma unroll
    for (int h = 0; h < 2; ++h) {
      if (GATHER) offA[h][i] = rowidx[brow + h * HALF + R] * lda + C;
      else offA[h][i] = R * lda + C;
    }
  }
  const u16* Ab[2]; const u16* Bb[2];
#pragma unroll
  for (int h = 0; h < 2; ++h) {
    Ab[h] = GATHER ? A : (A + (long)(brow + h * HALF) * lda);
    Bb[h] = Bt + (long)(bcol + h * HALF) * ldb;
  }
#define STAGE_A(b, h, kt) do { _Pragma("unroll") for (int _i = 0; _i < 2; ++_i) \
    __builtin_amdgcn_global_load_lds((const unsigned*)(Ab[h] + (kt) * BK + offA[GATHER ? h : 0][_i]), \
      (__attribute__((address_space(3))) unsigned*)((char*)SA(b, h) + tid * 16 + _i * 8192), 16, 0, 0); } while (0)
#define STAGE_B(b, h, kt) do { _Pragma("unroll") for (int _i = 0; _i < 2; ++_i) \
    __builtin_amdgcn_global_load_lds((const unsigned*)(Bb[h] + (kt) * BK + offB[_i]), \
      (__attribute__((address_space(3))) unsigned*)((char*)SB(b, h) + tid * 16 + _i * 8192), 16, 0, 0); } while (0)
#define LDA(dst, b, h) _Pragma("unroll") for (int m = 0; m < 4; ++m) _Pragma("unroll") for (int k = 0; k < 2; ++k) \
    dst[m][k] = *reinterpret_cast<const bf16x8*>((char*)SA(b, h) + lds_byte(wr * 64 + m * 16 + fr, k * 32 + fq * 8))
#define LDB(dst, b, h) _Pragma("unroll") for (int n = 0; n < 2; ++n) _Pragma("unroll") for (int k = 0; k < 2; ++k) \
    dst[n][k] = *reinterpret_cast<const bf16x8*>((char*)SB(b, h) + lds_byte(wc * 32 + n * 16 + fr, k * 32 + fq * 8))
#define MMA(ai, bj, At_, Bt_) do { __builtin_amdgcn_s_setprio(1); \
    _Pragma("unroll") for (int m = 0; m < 4; ++m) _Pragma("unroll") for (int n = 0; n < 2; ++n) _Pragma("unroll") for (int k = 0; k < 2; ++k) \
      acc[ai][bj][m][n] = MFMA16(At_[m][k], Bt_[n][k], acc[ai][bj][m][n]); \
    __builtin_amdgcn_s_setprio(0); } while (0)
#define WAIT_V(n) asm volatile("s_waitcnt vmcnt(" #n ")" ::: "memory")
#define WAIT_L(n) asm volatile("s_waitcnt lgkmcnt(" #n ")" ::: "memory")
#define BAR __builtin_amdgcn_s_barrier()
#define SCHED __builtin_amdgcn_sched_barrier(0)

  const int wid = tid >> 6, lane = tid & 63, wr = wid >> 2, wc = wid & 3, fr = lane & 15, fq = lane >> 4;
  f32x4 acc[2][2][4][2] = {};
  bf16x8 At[4][2], B0[2][2], B1[2][2];
  const int nt = K / BK;
  STAGE_B(0, 0, 0); STAGE_A(0, 0, 0);
  STAGE_B(0, 1, 0); STAGE_A(0, 1, 0);
  if (wr == 1) BAR;
  WAIT_V(4); BAR;
  STAGE_B(1, 0, 1); STAGE_A(1, 0, 1); STAGE_B(1, 1, 1);
  WAIT_V(6); BAR;
  for (int t = 0; t < nt - 2; t += 2) {
    LDB(B0, 0, 0); SCHED; LDA(At, 0, 0); STAGE_A(1, 1, t + 1);
    WAIT_L(8); BAR; WAIT_L(0); MMA(0, 0, At, B0); BAR; SCHED;
    LDB(B1, 0, 1); STAGE_B(0, 0, t + 2);
    BAR; WAIT_L(0); MMA(0, 1, At, B1); BAR;
    LDA(At, 0, 1); STAGE_A(0, 0, t + 2);
    BAR; WAIT_L(0); MMA(1, 0, At, B0); BAR; SCHED;
    STAGE_B(0, 1, t + 2);
    WAIT_V(6); BAR; MMA(1, 1, At, B1); BAR;
    LDB(B0, 1, 0); SCHED; LDA(At, 1, 0); STAGE_A(0, 1, t + 2);
    WAIT_L(8); BAR; WAIT_L(0); MMA(0, 0, At, B0); BAR; SCHED;
    LDB(B1, 1, 1); STAGE_B(1, 0, t + 3);
    BAR; WAIT_L(0); MMA(0, 1, At, B1); BAR;
    LDA(At, 1, 1); STAGE_A(1, 0, t + 3);
    BAR; WAIT_L(0); MMA(1, 0, At, B0); BAR; SCHED;
    STAGE_B(1, 1, t + 3);
    WAIT_V(6); BAR; MMA(1, 1, At, B1); BAR;
  }
  { LDB(B0, 0, 0); LDA(At, 0, 0); STAGE_A(1, 1, nt - 1);
    BAR; WAIT_L(0); MMA(0, 0, At, B0); BAR;
    LDB(B1, 0, 1); BAR; WAIT_L(0); MMA(0, 1, At, B1); BAR;
    LDA(At, 0, 1); WAIT_V(4); BAR; WAIT_L(0); MMA(1, 0, At, B0); MMA(1, 1, At, B1); BAR; }
  { LDB(B0, 1, 0); LDA(At, 1, 0); WAIT_V(2); BAR; WAIT_L(0); MMA(0, 0, At, B0); BAR;
    LDB(B1, 1, 1); WAIT_V(0); BAR; WAIT_L(0); MMA(0, 1, At, B1); BAR;
    LDA(At, 1, 1); BAR; WAIT_L(0); MMA(1, 0, At, B0); MMA(1, 1, At, B1); BAR; }
  if (wr == 0) BAR;

  char* ws = p.ws;
  const int row0 = orow + wr * 64 + fq * 4;
  const int col0 = ocol + wc * 32 + fr;
  const bool odd = (fr & 1) != 0;
  const int colp = col0 - (odd ? 1 : 0);
#pragma unroll
  for (int ai = 0; ai < 2; ++ai)
#pragma unroll
    for (int m = 0; m < 4; ++m) {
      const int rA = row0 + ai * HALF + m * 16 + (odd ? 2 : 0);
      float gate[2] = {0.f, 0.f};
      if (EPI == EPI_MOE2) { gate[0] = ((const float*)(ws + O_SELG))[rA]; gate[1] = ((const float*)(ws + O_SELG))[rA + 1]; }
#pragma unroll
      for (int bj = 0; bj < (EPI == EPI_HID ? 1 : 2); ++bj)
#pragma unroll
        for (int n = 0; n < 2; ++n) {
          const int cc = bj * HALF + n * 16;
          f32x4 v = acc[ai][bj][m][n];
          if (EPI == EPI_HID) {
#pragma unroll
            for (int j = 0; j < 4; ++j) { const float a1 = acc[ai][0][m][n][j], a3 = acc[ai][1][m][n][j]; v[j] = a1 * sigm(a1) * a3; }
          }
          float lo[2], hi[2];
          xchg_pairs(v, odd, lo, hi);
#pragma unroll
          for (int k = 0; k < 2; ++k) {
            const unsigned row = (unsigned)(rA + k);
            if (EPI == EPI_HID) {
              *(unsigned*)(ws + O_HID + (row * 1024u + (unsigned)(colp + cc)) * 2u) = pk2(lo[k], hi[k]);
            } else if (EPI == EPI_COLS) {
              *(unsigned*)(ws + O_COLS + (row * (unsigned)NCP + (unsigned)(colp + cc)) * 2u) = pk2(lo[k], hi[k]);
            } else if (EPI == EPI_MOE2) {
              *(unsigned*)(ws + O_EO + (row * 2048u + (unsigned)(colp + cc)) * 2u) = pk2(gate[k] * lo[k], gate[k] * hi[k]);
            } else if (EPI == EPI_M1) {
              const unsigned g2 = *(const unsigned*)(ws + O_COLS + (row * (unsigned)NCP + (unsigned)(C_GG + colp + cc)) * 2u);
              *(unsigned*)(ws + O_M1 + (row * 2048u + (unsigned)(colp + cc)) * 2u) = pk2(sigm(bflo(g2)) * lo[k], sigm(bfhi(g2)) * hi[k]);
            } else if (EPI == EPI_MERGED) {
              const unsigned g2 = *(const unsigned*)(ws + O_COLS + (row * (unsigned)NCP + (unsigned)(C_GR + colp + cc)) * 2u);
              const unsigned m1 = *(const unsigned*)(ws + O_M1 + (row * 2048u + (unsigned)(colp + cc)) * 2u);
              *(unsigned*)(ws + O_MERGED + (row * 2048u + (unsigned)(colp + cc)) * 2u) =
                  pk2(bflo(m1) + sigm(bflo(g2)) * lo[k], bfhi(m1) + sigm(bfhi(g2)) * hi[k]);
            } else if (EPI == EPI_R1) {
              const unsigned o4 = (row * 2048u + (unsigned)(colp + cc)) * 4u;
              const float2 xv = *(const float2*)((const char*)p.x + o4);
              *(unsigned*)(ws + O_R1 + (o4 >> 1)) = pk2(ALPHA * xv.x + lo[k], ALPHA * xv.y + hi[k]);
            }
          }
        }
      __builtin_amdgcn_sched_barrier(0);
    }
  __syncthreads();
#undef SA
#undef SB
}

DEVINL void tr_tile(const float* __restrict__ src, int ldsrc, int nvalid, int k0, int n0,
                    u16* __restrict__ dst, int lddst, int grp, int gstride, int goff) {
  float* tile = (float*)dynsmem;
  const int tid = otid();
  float4 v[8];
#pragma unroll
  for (int i = 0; i < 8; ++i) {
    int f = tid + i * 512; int r = f >> 6, c4 = (f & 63) * 4;
    int n = n0 + c4;
    v[i] = make_float4(0.f, 0.f, 0.f, 0.f);
    if (n < nvalid) {
      const f32x4 q = __builtin_nontemporal_load((const f32x4*)(src + (long)(k0 + r) * ldsrc + n));
      v[i] = make_float4(q[0], q[1], q[2], q[3]);
    }
  }
#pragma unroll
  for (int i = 0; i < 8; ++i) {
    int f = tid + i * 512; int r = f >> 6, c4 = (f & 63) * 4;
    float* tp = tile + r * 257 + c4;
    tp[0] = v[i].x; tp[1] = v[i].y; tp[2] = v[i].z; tp[3] = v[i].w;
  }
  __syncthreads();
  {
    const int n = tid >> 1, kc = (tid & 1) * 32;
    const float* tp = tile + kc * 257 + n;
    const int nn = n0 + n;
    const long row = (long)(nn / grp) * gstride + (nn % grp) + goff;
    uint4* dp = (uint4*)(dst + row * lddst + k0 + kc);
#pragma unroll
    for (int q = 0; q < 4; ++q) {
      uint4 o;
      o.x = pk2(tp[(q * 8 + 0) * 257], tp[(q * 8 + 1) * 257]);
      o.y = pk2(tp[(q * 8 + 2) * 257], tp[(q * 8 + 3) * 257]);
      o.z = pk2(tp[(q * 8 + 4) * 257], tp[(q * 8 + 5) * 257]);
      o.w = pk2(tp[(q * 8 + 6) * 257], tp[(q * 8 + 7) * 257]);
      dp[q] = o;
    }
  }
  __syncthreads();
}
DEVINL void tr_job(const float* src, int K, int N, int Npad, u16* dst, int bid, int nb) {
  const int tk = K / 64, tn = Npad / 256;
  for (int t = bid; t < tk * tn; t += nb) {
    int kt = t % tk, ntile = t / tk;
    tr_tile(src, N, N, kt * 64, ntile * 256, dst, K, 1 << 30, 0, 0);
  }
}

DEVINL void phase0(const Params& p) {
  char* ws = p.ws;
  const int bid = blockIdx.x, nb = gridDim.x, tid = otid();
  {
    const float4* xs = (const float4*)p.x;
    uint2* xd = (uint2*)(ws + O_XBF);
    const long n4 = (long)T_ * D_ / 4;
    const long stride = (long)nb * 512;
    for (long i = (long)bid * 512 + tid; i < n4; i += 4 * stride) {
      float4 v0 = xs[i], v1 = xs[i + stride], v2 = xs[i + 2 * stride], v3 = xs[i + 3 * stride];
      xd[i] = make_uint2(pk2(v0.x, v0.y), pk2(v0.z, v0.w));
      xd[i + stride] = make_uint2(pk2(v1.x, v1.y), pk2(v1.z, v1.w));
      xd[i + 2 * stride] = make_uint2(pk2(v2.x, v2.y), pk2(v2.z, v2.w));
      xd[i + 3 * stride] = make_uint2(pk2(v3.x, v3.y), pk2(v3.z, v3.w));
    }
  }
  tr_job(p.w_in, 2048, NC, NCP, (u16*)(ws + O_WINT), bid, nb);
  tr_job(p.w_up_gla, 1024, 2048, 2048, (u16*)(ws + O_WUPGT), bid, nb);
  tr_job(p.w_up_rwkv, 1024, 2048, 2048, (u16*)(ws + O_WUPRT), bid, nb);
  tr_job(p.w_out, 2048, 2048, 2048, (u16*)(ws + O_WOUTT), bid, nb);
  tr_job(p.rw_w_up_f, 64, 1024, 1024, (u16*)(ws + O_LWF), bid, nb);
  tr_job(p.rw_w_up_b, 64, 1024, 1024, (u16*)(ws + O_LWB), bid, nb);
  tr_job(p.rw_a_up, 64, 1024, 1024, (u16*)(ws + O_LA), bid, nb);
  tr_job(p.rw_g_up, 128, 1024, 1024, (u16*)(ws + O_LG), bid, nb);
}

DEVINL void phase1(const Params& p) {
  const u16* A = (const u16*)(p.ws + O_XBF);
  const u16* Bt = (const u16*)(p.ws + O_WINT);
  const int ntiles = 32 * 42;
  for (int t = blockIdx.x; t < ntiles; t += gridDim.x) {
    int pm = t & 31, pn = t >> 5;
    gemm_tile<EPI_COLS, false>(p, A, 2048, nullptr, Bt, 2048, 2048, pm * 256, pn * 256, pm * 256, pn * 256);
  }
}

DEVINL void gla_prep_unit(const Params& p, int unit) {
  const int h = unit & 3, c = (unit >> 2) & 63, b = unit >> 8;
  char* ws = p.ws;
  const u16* cols = (const u16*)(ws + O_COLS);
  const int tid = otid();
  float* afab = (float*)dynsmem;
  float* G = (float*)(dynsmem + 8192);
  u16* KD = (u16*)(dynsmem + 8192 + 65536);
  u16* VL = (u16*)dynsmem;
  const long tok0 = (long)b * S_ + c * 64;
  for (int i = tid; i < 64 * 32; i += 512) {
    int r = i >> 5, cc = i & 31;
    afab[i] = bf2f(cols[(tok0 + r) * NCP + C_AF + cc]);
  }
  __syncthreads();
  if (tid < 256) {
    const int dir = tid >> 7, kk = tid & 127;
    const float* up = dir ? p.gla_a_up_b : p.gla_a_up_f;
    const float bias = (dir ? p.gla_a_bias_b : p.gla_a_bias_f)[h * 128 + kk];
    float u[16];
#pragma unroll
    for (int r = 0; r < 16; ++r) u[r] = up[r * 512 + h * 128 + kk];
    float* Gc = G + dir * 64 * 128 + kk;
    for (int i = 0; i < 64; ++i) {
      float z = bias;
#pragma unroll
      for (int r = 0; r < 16; ++r) z += afab[i * 32 + dir * 16 + r] * u[r];
      Gc[i * 128] = logsig(z) * (1.f / 16.f);
    }
    float run = 0.f;
    if (dir == 0) { for (int i = 0; i < 64; ++i) { run += Gc[i * 128]; Gc[i * 128] = run; } }
    else { for (int i = 63; i >= 0; --i) { run += Gc[i * 128]; Gc[i * 128] = run; } }
    const float bedge = run;
    const long hb = ((long)(dir * 2 + b) * 4 + h);
    u16* qt = (u16*)(ws + O_QT) + (hb * 4096 + c * 64) * 128 + kk;
    u16* kt = (u16*)(ws + O_KT) + (hb * 4096 + c * 64) * 128 + kk;
    ((float*)(ws + O_DEC))[(hb * 64 + c) * 128 + kk] = __expf(bedge);
    u16* KDr = KD + (dir * 128 + kk) * 72;
    const unsigned short* qsrc = cols + tok0 * NCP + C_Q + h * 128 + kk;
    const unsigned short* ksrc = cols + tok0 * NCP + C_K + h * 128 + kk;
#pragma unroll 1
    for (int i0 = 0; i0 < 64; i0 += 8) {
      u16 qv[8], kv[8];
#pragma unroll
      for (int j = 0; j < 8; ++j) { qv[j] = qsrc[(long)(i0 + j) * NCP]; kv[j] = ksrc[(long)(i0 + j) * NCP]; }
#pragma unroll
      for (int j = 0; j < 8; ++j) {
        const int i = i0 + j;
        float bb = Gc[i * 128];
        float q = bf2f(qv[j]);
        float k = bf2f(kv[j]);
        qt[i * 128] = f2bf(q * 0.08838834764831845f * __expf(bb));
        kt[i * 128] = f2bf(k * __expf(-bb));
        KDr[i] = f2bf(k * __expf(bedge - bb));
      }
    }
  }
  __syncthreads();
#pragma unroll 8
  for (int idx = tid; idx < 64 * 256; idx += 512) {
    int i = idx >> 8, vc = idx & 255;
    VL[vc * 72 + i] = cols[(tok0 + i) * NCP + C_V + h * 256 + vc];
  }
  __syncthreads();
  for (int pc = tid; pc < 4096; pc += 512) {
    int row = pc >> 3, ch = pc & 7;
    if (row < 256) {
      int dir = row >> 7, kk = row & 127;
      uint4 v = *(const uint4*)(KD + row * 72 + ch * 8);
      long hb = ((long)(dir * 2 + b) * 4 + h);
      *(uint4*)((u16*)(ws + O_KDT) + ((hb * 64 + c) * 128 + kk) * 64 + ch * 8) = v;
    } else {
      int vc = row - 256;
      uint4 v = *(const uint4*)(VL + vc * 72 + ch * 8);
      long hb = ((long)b * 4 + h);
      *(uint4*)((u16*)(ws + O_VT) + ((hb * 64 + c) * 256 + vc) * 64 + ch * 8) = v;
    }
  }
  __syncthreads();
}

DEVINL float rw_shift2(const char* colsb, float muv, unsigned o, int s) {
  const unsigned op = (s > 0) ? o - (unsigned)(NCP * 2) : o;
  const unsigned on = (s < S_ - 1) ? o + (unsigned)(NCP * 2) : o;
  float cur = bf2f(*(const u16*)(colsb + o));
  float prv = bf2f(*(const u16*)(colsb + op));
  float nxt = bf2f(*(const u16*)(colsb + on));
  if (s == 0) prv = 0.f;
  if (s == S_ - 1) nxt = 0.f;
  return cur + muv * (0.5f * (prv + nxt) - cur);
}

DEVINL void rw_shift4(const char* colsb, float4 mu, unsigned o, int s, float (&out)[4]) {
  const unsigned op = (s > 0) ? o - (unsigned)(NCP * 2) : o;
  const unsigned on = (s < S_ - 1) ? o + (unsigned)(NCP * 2) : o;
  const uint2 c = *(const uint2*)(colsb + o);
  uint2 pv = *(const uint2*)(colsb + op);
  uint2 nx = *(const uint2*)(colsb + on);
  if (s == 0) pv = make_uint2(0u, 0u);
  if (s == S_ - 1) nx = make_uint2(0u, 0u);
  const float cu[4] = {bflo(c.x), bfhi(c.x), bflo(c.y), bfhi(c.y)};
  const float pr[4] = {bflo(pv.x), bfhi(pv.x), bflo(pv.y), bfhi(pv.y)};
  const float nn[4] = {bflo(nx.x), bfhi(nx.x), bflo(nx.y), bfhi(nx.y)};
  const float m[4] = {mu.x, mu.y, mu.z, mu.w};
#pragma unroll
  for (int e = 0; e < 4; ++e) out[e] = cu[e] + m[e] * (0.5f * (pr[e] + nn[e]) - cu[e]);
}

DEVINL void rw_prep_unit(const Params& p, int unit) {
  char* ws = p.ws;
  const char* colsb = ws + O_COLS;
  const int tid = otid(), lane = tid & 63, wave = tid >> 6, l15 = lane & 15, g = lane >> 4;
  u16* AL = (u16*)dynsmem;
  const int tok0 = unit * 32;
#pragma unroll 5
  for (int idx = tid; idx < 32 * 320; idx += 512) {
    int i = idx / 320, j = idx % 320;
    int t = tok0 + i; int s = t & (S_ - 1);
    unsigned o = ((unsigned)t * (unsigned)NCP + (unsigned)(C_RW + 3072 + j)) * 2u;
    float v = rw_shift2(colsb, p.rw_mu[3072 + j], o, s);
    if (j < 128) v = tanh_(v);
    else if (j >= 192) v = sigm(v);
    AL[i * 328 + j] = f2bf(v);
  }
  __syncthreads();
  const u16* LWF = (const u16*)(ws + O_LWF);
  const u16* LWB = (const u16*)(ws + O_LWB);
  const u16* LA = (const u16*)(ws + O_LA);
  const u16* LG = (const u16*)(ws + O_LG);
#pragma unroll 1
  for (int hh = 0; hh < 2; ++hh) {
    const int head = wave * 2 + hh;
#pragma unroll 1
    for (int mt = 0; mt < 2; ++mt) {
      f32x4 awf[4], awb[4], aa[4], ag[4];
#pragma unroll
      for (int n = 0; n < 4; ++n) { awf[n] = f32x4{0, 0, 0, 0}; awb[n] = awf[n]; aa[n] = awf[n]; ag[n] = awf[n]; }
      const u16* arow = AL + (mt * 16 + l15) * 328 + 8 * g;
#pragma unroll
      for (int ks = 0; ks < 2; ++ks) {
        bf16x8 fwf = *(const bf16x8*)(arow + 32 * ks);
        bf16x8 fwb = *(const bf16x8*)(arow + 64 + 32 * ks);
        bf16x8 fa = *(const bf16x8*)(arow + 128 + 32 * ks);
#pragma unroll
        for (int n = 0; n < 4; ++n) {
          const unsigned bo = (unsigned)((head * 64 + l15 * 4 + n) * 64 + 32 * ks + 8 * g) * 2u;
          bf16x8 b1 = *(const bf16x8*)((const char*)LWF + bo);
          bf16x8 b2 = *(const bf16x8*)((const char*)LWB + bo);
          bf16x8 b3 = *(const bf16x8*)((const char*)LA + bo);
          awf[n] = MFMA16(fwf, b1, awf[n]);
          awb[n] = MFMA16(fwb, b2, awb[n]);
          aa[n] = MFMA16(fa, b3, aa[n]);
        }
        __builtin_amdgcn_sched_barrier(0);
      }
#pragma unroll
      for (int ks = 0; ks < 4; ++ks) {
        bf16x8 fg = *(const bf16x8*)(arow + 192 + 32 * ks);
#pragma unroll
        for (int n = 0; n < 4; ++n) {
          const unsigned bo = (unsigned)((head * 64 + l15 * 4 + n) * 128 + 32 * ks + 8 * g) * 2u;
          bf16x8 b4 = *(const bf16x8*)((const char*)LG + bo);
          ag[n] = MFMA16(fg, b4, ag[n]);
        }
        __builtin_amdgcn_sched_barrier(0);
      }
#pragma unroll 2
      for (int j = 0; j < 4; ++j) {
        int jo = j, zo = 0;
        asm volatile("" : "+v"(jo), "+v"(zo));
        const int t = tok0 + mt * 16 + 4 * g + jo;
        const int s = t & (S_ - 1), b = t >> 12;
        const unsigned c0 = (unsigned)(head * 64 + l15 * 4 + zo);
        const unsigned rowo = (unsigned)t * (unsigned)(NCP * 2) + (unsigned)(C_RW * 2) + c0 * 2u;
        float pr[4], pkr[4], pv[4];
        rw_shift4(colsb, *(const float4*)(p.rw_mu + c0), rowo, s, pr);
        rw_shift4(colsb, *(const float4*)(p.rw_mu + 1024u + c0), rowo + 2048u, s, pkr);
        rw_shift4(colsb, *(const float4*)(p.rw_mu + 2048u + c0), rowo + 4096u, s, pv);
        const float4 a0q = *(const float4*)(p.rw_a0 + c0), kkq = *(const float4*)(p.rw_k_k + c0);
        const float4 kaq = *(const float4*)(p.rw_k_a + c0), rkq = *(const float4*)(p.rw_r_k + c0);
        const float4 w0fq = *(const float4*)(p.rw_w0_f + c0), w0bq = *(const float4*)(p.rw_w0_b + c0);
        const float a0v[4] = {a0q.x, a0q.y, a0q.z, a0q.w}, kkp[4] = {kkq.x, kkq.y, kkq.z, kkq.w};
        const float kap[4] = {kaq.x, kaq.y, kaq.z, kaq.w}, rkp[4] = {rkq.x, rkq.y, rkq.z, rkq.w};
        const float w0f[4] = {w0fq.x, w0fq.y, w0fq.z, w0fq.w}, w0b[4] = {w0bq.x, w0bq.y, w0bq.z, w0bq.w};
        float pk[4], av[4], kkv[4];
        float n2 = 0.f, dot = 0.f;
#pragma unroll
        for (int n = 0; n < 4; ++n) {
          const float kraw = pkr[n];
          float a = sigm(a0v[n] + sel4(aa[n], j));
          av[n] = a;
          float kk = kraw * kkp[n];
          kkv[n] = kk;
          n2 += kk * kk;
          float k2 = kraw * (1.f + (a - 1.f) * kap[n]);
          pk[n] = k2;
          dot += pr[n] * k2 * rkp[n];
        }
        n2 = allred16(n2);
        dot = allred16(dot);
        const float inv = 1.f / fmaxf(sqrtf(n2), 1e-12f);
        const unsigned reco = ((unsigned)((b * 16 + head) * 4096 + s)) * 1024u;
        const unsigned tco = (unsigned)t * 2048u + c0 * 2u;
        unsigned hwf[4], hwb[4], ha[4], hb[4], hk[4], hr[4], hv[4], bg[4], bbn[4];
#pragma unroll
        for (int n = 0; n < 4; ++n) {
          float wf = __expf(-0.606531f * sigm(w0f[n] + sel4(awf[n], j)));
          float wb = __expf(-0.606531f * sigm(w0b[n] + sel4(awb[n], j)));
          float kkn = kkv[n] * inv;
          hwf[n] = f2h(wf); hwb[n] = f2h(wb); ha[n] = f2h(-kkn); hb[n] = f2h(kkn * av[n]);
          hk[n] = f2h(pk[n]); hr[n] = f2h(pr[n]); hv[n] = f2h(pv[n]);
          bg[n] = f2bf(sel4(ag[n], j)); bbn[n] = f2bf(dot * pv[n]);
        }
        char* rb = ws + O_REC + (reco + (unsigned)l15 * 64u);
        *(uint4*)(rb) = make_uint4(hwf[0] | (hwf[1] << 16), hwf[2] | (hwf[3] << 16), hwb[0] | (hwb[1] << 16), hwb[2] | (hwb[3] << 16));
        *(uint4*)(rb + 16) = make_uint4(ha[0] | (ha[1] << 16), ha[2] | (ha[3] << 16), hb[0] | (hb[1] << 16), hb[2] | (hb[3] << 16));
        *(uint4*)(rb + 32) = make_uint4(hk[0] | (hk[1] << 16), hk[2] | (hk[3] << 16), hr[0] | (hr[1] << 16), hr[2] | (hr[3] << 16));
        *(uint2*)(rb + 48) = make_uint2(hv[0] | (hv[1] << 16), hv[2] | (hv[3] << 16));
        *(uint2*)(ws + O_GRW + tco) = make_uint2(bg[0] | (bg[1] << 16), bg[2] | (bg[3] << 16));
        *(uint2*)(ws + O_BONUS + tco) = make_uint2(bbn[0] | (bbn[1] << 16), bbn[2] | (bbn[3] << 16));
      }
    }
  }
  __syncthreads();
}

DEVINL void phase2(const Params& p) {
  const int bid = blockIdx.x, nb = gridDim.x, tid = otid();
  for (int u = bid; u < 512; u += nb) gla_prep_unit(p, u);
  for (int u = bid; u < 256; u += nb) rw_prep_unit(p, u);
}

typedef unsigned u32x2 __attribute__((ext_vector_type(2)));
typedef unsigned u32x4 __attribute__((ext_vector_type(4)));
template <int DIR>
DEVINL void rwkv_scan_dir(const Params& p, int task, int lane, int wave) {
  const int b = (task >> 8) & 1, head = (task >> 4) & 15, rg = task & 15;
  const int seg = lane & 15, rl = lane >> 4, row = rg * 4 + rl;
  constexpr int DIST = 24;
  constexpr int WOFS = DIR ? 8 : 0;
  const char* recbase = p.ws + O_REC + ((long)(b * 16 + head) * 4096) * 1024 + lane * 16;
  const unsigned ring_lds = (unsigned)(unsigned long)(__attribute__((address_space(3))) char*)(dynsmem + wave * 32768);
  const unsigned ring_u = __builtin_amdgcn_readfirstlane(ring_lds);
  const unsigned a_seg = ring_lds + seg * 64;
  const unsigned a_v = ring_lds + (row >> 2) * 64 + 48 + (row & 3) * 2;
  u16* yo = (u16*)(p.ws + (DIR ? O_YB : O_YSUM)) + ((long)b * 4096) * 1024 + head * 64 + row;
  float s0 = 0.f, s1 = 0.f, s2 = 0.f, s3 = 0.f;
  float ykeep = 0.f;
  const char* recdir = recbase + (DIR ? (long)4095 * 1024 : 0);
#define RW_GPTR(q_, gp_) const char* gp_ = recdir + (DIR ? -(long)(q_) * 1024 : (long)(q_) * 1024);
#define RW_DMA_ONLY(q_) do { RW_GPTR(q_, gp_) unsigned keep_; const unsigned ld_ = ring_u + ((q_) & 31) * 1024; \
    asm volatile("s_mov_b32 %0, m0\n\ts_mov_b32 m0, %2\n\ts_nop 0\n\tglobal_load_lds_dwordx4 %1, off\n\ts_mov_b32 m0, %0" \
                 : "=&s"(keep_) : "v"(gp_), "s"(ld_) : "memory"); } while (0)
#define RW_READ(U1, WN, XN, KN, VN, VMC) do { \
    asm volatile("s_waitcnt vmcnt(" #VMC ")\n\t" \
                 "ds_read_b64 %0, %4 offset:%6\n\t" \
                 "ds_read_b128 %1, %4 offset:%7\n\t" \
                 "ds_read_b128 %2, %4 offset:%8\n\t" \
                 "ds_read_u16 %3, %5 offset:%9" \
                 : "=&v"(WN), "=&v"(XN), "=&v"(KN), "=&v"(VN) \
                 : "v"(a_seg), "v"(a_v), \
                   "i"(((U1) & 31) * 1024 + WOFS), "i"(((U1) & 31) * 1024 + 16), "i"(((U1) & 31) * 1024 + 32), "i"(((U1) & 31) * 1024) \
                 : "memory"); } while (0)
#define RW_LANDED(WN, XN, KN, VN) asm volatile("s_waitcnt lgkmcnt(0)" : "+v"(WN), "+v"(XN), "+v"(KN), "+v"(VN) :: "memory")
#define RW_STEP(U, WC, XC, KC, VC, WN, XN, KN, VN) do { \
    { RW_GPTR(st + (U) + DIST, gp_) \
      const unsigned ld_ = ring_u + (((U) + DIST) & 31) * 1024; unsigned keep_; \
      asm volatile("s_mov_b32 m0, %2\n\ts_nop 0\n\tglobal_load_lds_dwordx4 %1, off" \
                   : "=&s"(keep_) : "v"(gp_), "s"(ld_) : "memory"); } \
    RW_READ((U) + 1, WN, XN, KN, VN, 23); \
    float pa = fmul_lo(s0, XC.x); pa = fmix_hi(s1, XC.x, pa); \
    float pb = fmul_lo(s2, XC.y); pb = fmix_hi(s3, XC.y, pb); \
    float t0_ = fmul_lo(s0, WC.x), t1_ = fmul_hi(s1, WC.x), t2_ = fmul_lo(s2, WC.y), t3_ = fmul_hi(s3, WC.y); \
    t0_ = fmixhh_lo(VC, KC.x, t0_); t1_ = fmixhh_hi(VC, KC.x, t1_); \
    t2_ = fmixhh_lo(VC, KC.y, t2_); t3_ = fmixhh_hi(VC, KC.y, t3_); \
    float sa = pa + pb, yprev = ypart;            \
    allred16x2(sa, yprev); \
    ykeep = (seg == (((U) + 15) & 15)) ? yprev : ykeep; \
    s0 = fmix_lo(sa, XC.z, t0_); \
    s1 = fmix_hi(sa, XC.z, t1_); \
    s2 = fmix_lo(sa, XC.w, t2_); \
    s3 = fmix_hi(sa, XC.w, t3_); \
    float ya = fmul_lo(s0, KC.z); ya = fmix_hi(s1, KC.z, ya); \
    float yb = fmul_lo(s2, KC.w); yb = fmix_hi(s3, KC.w, yb); \
    ypart = ya + yb; \
    RW_LANDED(WN, XN, KN, VN); } while (0)
#define RW_STEP2(B) RW_STEP(B, WvA, XA, KrA, vhA, WvB, XB, KrB, vhB); RW_STEP((B) + 1, WvB, XB, KrB, vhB, WvA, XA, KrA, vhA)
#define RW_STEP4(B) RW_STEP2(B); RW_STEP2((B) + 2)
#define RW_DMA4(B) RW_DMA_ONLY(B); RW_DMA_ONLY((B) + 1); RW_DMA_ONLY((B) + 2); RW_DMA_ONLY((B) + 3)
  u32x2 WvA, WvB; u32x4 XA, XB, KrA, KrB; unsigned vhA, vhB;
  RW_DMA4(0); RW_DMA4(4); RW_DMA4(8); RW_DMA4(12); RW_DMA4(16); RW_DMA4(20);
  RW_READ(0, WvA, XA, KrA, vhA, 23);
  RW_LANDED(WvA, XA, KrA, vhA);
  float ypart = 0.f;
#pragma unroll 1
  for (int st = 0; st < 4096; st += 32) {
    RW_STEP(0, WvA, XA, KrA, vhA, WvB, XB, KrB, vhB);
    if (st > 0) { const int q0 = st - 16 + seg; yo[(long)(DIR ? (4095 - q0) : q0) * 1024] = f2bf(ykeep); }
    RW_STEP(1, WvB, XB, KrB, vhB, WvA, XA, KrA, vhA);
    RW_STEP2(2); RW_STEP4(4); RW_STEP4(8); RW_STEP4(12);
    RW_STEP(16, WvA, XA, KrA, vhA, WvB, XB, KrB, vhB);
    { const int q0 = st + seg; yo[(long)(DIR ? (4095 - q0) : q0) * 1024] = f2bf(ykeep); }
    RW_STEP(17, WvB, XB, KrB, vhB, WvA, XA, KrA, vhA);
    RW_STEP2(18); RW_STEP4(20); RW_STEP4(24); RW_STEP4(28);
  }
  {
    const float ylast = allred16(ypart);
    ykeep = (seg == 15) ? ylast : ykeep;
    const int q0 = 4096 - 16 + seg; yo[(long)(DIR ? (4095 - q0) : q0) * 1024] = f2bf(ykeep);
  }
  asm volatile("s_waitcnt vmcnt(0)" ::: "memory");
#undef RW_READ
#undef RW_LANDED
#undef RW_STEP2
#undef RW_GPTR
#undef RW_DMA_ONLY
#undef RW_STEP
#undef RW_STEP4
#undef RW_DMA4
}
DEVINL void rwkv_scan_task(const Params& p, int task, int lane, int wave) {
  if (task >> 9) rwkv_scan_dir<1>(p, task, lane, wave);
  else rwkv_scan_dir<0>(p, task, lane, wave);
}

DEVINL void gla_scan_task(const Params& p, int task, int lane) {
  const int dir = task >> 7, b = (task >> 6) & 1, h = (task >> 4) & 3, vsl = task & 15;
  const int l15 = lane & 15, g = lane >> 4;
  const long hb = (long)(dir * 2 + b) * 4 + h;
  const u16* qt = (const u16*)(p.ws + O_QT) + hb * 4096 * 128 + l15 * 128 + 4 * g;
  const u16* kt = (const u16*)(p.ws + O_KT) + hb * 4096 * 128 + l15 * 128 + 4 * g;
  const u16* kdT = (const u16*)(p.ws + O_KDT) + hb * 64 * 128 * 64 + l15 * 64 + 4 * g;
  const u16* vT = (const u16*)(p.ws + O_VT) + ((long)b * 4 + h) * 64 * 256 * 64 + (16 * vsl + l15) * 64 + 4 * g;
  const float* dec = (const float*)(p.ws + O_DEC) + hb * 64 * 128 + 4 * g;
  u16* obuf = (u16*)(p.ws + O_OSUM) + (dir ? (long)T_ * 1024 : 0) + ((long)b * 4096) * 1024 + h * 256 + 16 * vsl + l15;
  f32x4 ST[8];
#pragma unroll
  for (int m = 0; m < 8; ++m) ST[m] = f32x4{0, 0, 0, 0};
  bf16x8 KF[4][4], VF[2], QF[4][4];
#define GL_LOAD_KV(KFx, VFx, c_) do { \
    _Pragma("unroll") for (int jt = 0; jt < 4; ++jt) _Pragma("unroll") for (int ks = 0; ks < 4; ++ks) \
      KFx[jt][ks] = ldfrag(kt + ((c_) * 64 + 16 * jt) * 128 + 32 * ks); \
    _Pragma("unroll") for (int s = 0; s < 2; ++s) VFx[s] = ldfrag(vT + (c_) * (256 * 64) + 32 * s); } while (0)
#define GL_LOAD_Q(it_, c_) do { \
    _Pragma("unroll") for (int ks = 0; ks < 4; ++ks) QF[it_][ks] = ldfrag(qt + ((c_) * 64 + 16 * (it_)) * 128 + 32 * ks); } while (0)
  {
    const int c0 = dir ? 63 : 0;
    GL_LOAD_KV(KF, VF, c0);
    GL_LOAD_Q(0, c0);
  }
  for (int cc = 0; cc < 64; ++cc) {
    const int c = dir ? 63 - cc : cc;
    const int tok0 = c * 64;
    GL_LOAD_Q(1, c); GL_LOAD_Q(2, c); GL_LOAD_Q(3, c);
    bf16x8 SBf[4];
#pragma unroll
    for (int ks = 0; ks < 4; ++ks) SBf[ks] = pack8(ST[2 * ks], ST[2 * ks + 1]);
    __builtin_amdgcn_sched_barrier(0);
#pragma unroll
    for (int it = 0; it < 4; ++it) {
      f32x4 X[4];
#pragma unroll
      for (int jt = 0; jt < 4; ++jt) {
        X[jt] = f32x4{0, 0, 0, 0};
        const bool need = dir ? (jt >= it) : (jt <= it);
        if (need) {
#pragma unroll
          for (int ks = 0; ks < 4; ++ks) X[jt] = MFMA16(KF[jt][ks], QF[it][ks], X[jt]);
          if (jt == it) {
#pragma unroll
            for (int r = 0; r < 4; ++r) {
              const int j = 4 * g + r;
              const bool keep = dir ? (j >= l15) : (j <= l15);
              if (!keep) X[jt][r] = 0.f;
            }
          }
        }
      }
      bf16x8 XA0 = pack8(X[0], X[1]), XA1 = pack8(X[2], X[3]);
      f32x4 O = f32x4{0, 0, 0, 0};
      O = MFMA16(XA0, VF[0], O);
      O = MFMA16(XA1, VF[1], O);
#pragma unroll
      for (int ks = 0; ks < 4; ++ks) O = MFMA16(QF[it][ks], SBf[ks], O);
#pragma unroll
      for (int r = 0; r < 4; ++r)
        obuf[(long)(tok0 + 16 * it + 4 * g + r) * 1024] = f2bf(O[r]);
    }
    __builtin_amdgcn_sched_barrier(0);
    bf16x8 KDF[8][2]; f32x4 Dv[8];
#pragma unroll
    for (int m = 0; m < 8; ++m) {
      Dv[m] = *(const f32x4*)(dec + c * 128 + 16 * m);
#pragma unroll
      for (int s = 0; s < 2; ++s) KDF[m][s] = ldfrag(kdT + (c * 128 + 16 * m) * 64 + 32 * s);
    }
    __builtin_amdgcn_sched_barrier(0);
#pragma unroll
    for (int m = 0; m < 4; ++m) {
      ST[m] = ST[m] * Dv[m];
      ST[m] = MFMA16(KDF[m][0], VF[0], ST[m]);
      ST[m] = MFMA16(KDF[m][1], VF[1], ST[m]);
    }
    __builtin_amdgcn_sched_barrier(0);
    const int cn = (cc < 63) ? (dir ? c - 1 : c + 1) : c;
    bf16x8 VFn[2];
    GL_LOAD_KV(KF, VFn, cn);
    GL_LOAD_Q(0, cn);
    __builtin_amdgcn_sched_barrier(0);
#pragma unroll
    for (int m = 4; m < 8; ++m) {
      ST[m] = ST[m] * Dv[m];
      ST[m] = MFMA16(KDF[m][0], VF[0], ST[m]);
      ST[m] = MFMA16(KDF[m][1], VF[1], ST[m]);
    }
    VF[0] = VFn[0]; VF[1] = VFn[1];
  }
#undef GL_LOAD_KV
#undef GL_LOAD_Q
}

DEVINL void phase3(const Params& p) {
  const int tid = otid(); const int wave = tid >> 6, lane = tid & 63;
  const int nb = gridDim.x;
  int vb = blockIdx.x;
  if ((nb & 7) == 0) vb = (blockIdx.x & 7) * (nb >> 3) + (blockIdx.x >> 3);
  if (wave < 4) {
    for (int task = vb * 4 + wave; task < 1024; task += nb * 4) rwkv_scan_task(p, task, lane, wave);
  } else if (wave == 4) {
    for (int task = vb; task < 256; task += nb) gla_scan_task(p, task, lane);
  }
}

DEVINL void phase4(const Params& p) {
  char* ws = p.ws;
  const int tid = otid();
  const int lane = tid & 63;
  const int gw = blockIdx.x * 8 + (tid >> 6), nw = gridDim.x * 8;
  const u16* cols = (const u16*)(ws + O_COLS);
  for (int u = gw; u < T_ * 4; u += nw) {
    const long t = u >> 2; const int h = u & 3;
    const int c = h * 256 + lane * 4;
    float4 o;
    {
      uint2 of = *(const uint2*)((const u16*)(ws + O_OSUM) + t * 1024 + c);
      uint2 ob = *(const uint2*)((const u16*)(ws + O_OSUM) + (long)T_ * 1024 + t * 1024 + c);
      o.x = bflo(of.x) + bflo(ob.x); o.y = bfhi(of.x) + bfhi(ob.x);
      o.z = bflo(of.y) + bflo(ob.y); o.w = bfhi(of.y) + bfhi(ob.y);
    }
    float ss = o.x * o.x + o.y * o.y + o.z * o.z + o.w * o.w;
    ss = allred64(ss);
    const float rstd = rsqrtf(ss * (1.f / 256.f) + 1e-5f);
    float4 ng = *(const float4*)(p.gla_norm_g + c);
    uint2 gg = *(const uint2*)(cols + t * NCP + C_G + c);
    float g0 = bflo(gg.x), g1 = bfhi(gg.x), g2 = bflo(gg.y), g3 = bfhi(gg.y);
    float y0 = o.x * rstd * ng.x * (g0 * sigm(g0));
    float y1 = o.y * rstd * ng.y * (g1 * sigm(g1));
    float y2 = o.z * rstd * ng.z * (g2 * sigm(g2));
    float y3 = o.w * rstd * ng.w * (g3 * sigm(g3));
    *(uint2*)((u16*)(ws + O_YGLA) + t * 1024 + c) = make_uint2(pk2(y0, y1), pk2(y2, y3));
  }
  for (int u = gw; u < T_ * 4; u += nw) {
    const long t = u >> 2; const int hq = u & 3;
    const int c = (hq * 4 + (lane >> 4)) * 64 + (lane & 15) * 4;
    float4 y;
    {
      const uint2 y1 = *(const uint2*)((const u16*)(ws + O_YSUM) + t * 1024 + c);
      const uint2 y2 = *(const uint2*)((const u16*)(ws + O_YB) + t * 1024 + c);
      y.x = bflo(y1.x) + bflo(y2.x); y.y = bfhi(y1.x) + bfhi(y2.x);
      y.z = bflo(y1.y) + bflo(y2.y); y.w = bfhi(y1.y) + bfhi(y2.y);
    }
    float mu = allred16(y.x + y.y + y.z + y.w) * (1.f / 64.f);
    float d0 = y.x - mu, d1 = y.y - mu, d2 = y.z - mu, d3 = y.w - mu;
    float var = allred16(d0 * d0 + d1 * d1 + d2 * d2 + d3 * d3) * (1.f / 64.f);
    const float rstd = rsqrtf(var + 64e-5f);
    float4 lg = *(const float4*)(p.rw_ln_g + c);
    float4 lb = *(const float4*)(p.rw_ln_b + c);
    uint2 bo = *(const uint2*)((const u16*)(ws + O_BONUS) + t * 1024 + c);
    uint2 gg = *(const uint2*)((const u16*)(ws + O_GRW) + t * 1024 + c);
    float r0 = (d0 * rstd * lg.x + lb.x + bflo(bo.x)) * bflo(gg.x);
    float r1 = (d1 * rstd * lg.y + lb.y + bfhi(bo.x)) * bfhi(gg.x);
    float r2 = (d2 * rstd * lg.z + lb.z + bflo(bo.y)) * bflo(gg.y);
    float r3 = (d3 * rstd * lg.w + lb.w + bfhi(bo.y)) * bfhi(gg.y);
    *(uint2*)((u16*)(ws + O_YRW) + t * 1024 + c) = make_uint2(pk2(r0, r1), pk2(r2, r3));
  }
}

DEVINL void phase5(const Params& p) {
  const u16* A1 = (const u16*)(p.ws + O_YGLA);
  const u16* A2 = (const u16*)(p.ws + O_YRW);
  const u16* B1 = (const u16*)(p.ws + O_WUPGT);
  const u16* B2 = (const u16*)(p.ws + O_WUPRT);
  for (int t = blockIdx.x; t < 256; t += gridDim.x) {
    int pm = t & 31, pn = t >> 5;
    gemm_tile<EPI_M1, false>(p, A1, 1024, nullptr, B1, 1024, 1024, pm * 256, pn * 256, pm * 256, pn * 256);
  }
  for (int t = blockIdx.x; t < 256; t += gridDim.x) {
    int pm = t & 31, pn = t >> 5;
    gemm_tile<EPI_MERGED, false>(p, A2, 1024, nullptr, B2, 1024, 1024, pm * 256, pn * 256, pm * 256, pn * 256);
  }
}
DEVINL void phase6(const Params& p) {
  const u16* A = (const u16*)(p.ws + O_MERGED);
  const u16* Bt = (const u16*)(p.ws + O_WOUTT);
  for (int t = blockIdx.x; t < 256; t += gridDim.x) {
    int pm = t & 31, pn = t >> 5;
    gemm_tile<EPI_R1, false>(p, A, 2048, nullptr, Bt, 2048, 2048, pm * 256, pn * 256, pm * 256, pn * 256);
  }
}

DEVINL void phase7(const Params& p) {
  char* ws = p.ws;
  const int tid = otid();
  const int lane = tid & 63;
  const int gw = blockIdx.x * 8 + (tid >> 6), nw = gridDim.x * 8;
  for (int row = gw; row < T_; row += nw) {
    const u16* r1 = (const u16*)(ws + O_R1) + (long)row * 2048;
    float4 v[8];
    float sum = 0.f;
#pragma unroll
    for (int i = 0; i < 8; ++i) {
      const uint2 q = *(const uint2*)(r1 + i * 256 + lane * 4);
      v[i] = make_float4(bflo(q.x), bfhi(q.x), bflo(q.y), bfhi(q.y));
      sum += v[i].x + v[i].y + v[i].z + v[i].w;
    }
    const float mu = allred64(sum) * (1.f / 2048.f);
    float sq = 0.f;
#pragma unroll
    for (int i = 0; i < 8; ++i) {
      v[i].x -= mu; v[i].y -= mu; v[i].z -= mu; v[i].w -= mu;
      sq += v[i].x * v[i].x + v[i].y * v[i].y + v[i].z * v[i].z + v[i].w * v[i].w;
    }
    const float rstd = rsqrtf(allred64(sq) * (1.f / 2048.f) + 1e-5f);
    float lg[16];
#pragma unroll
    for (int e = 0; e < 16; ++e) lg[e] = 0.f;
#pragma unroll
    for (int i = 0; i < 8; ++i) {
      const int c = i * 256 + lane * 4;
      float4 gq = *(const float4*)(p.ln1_g + c);
      float4 bq = *(const float4*)(p.ln1_b + c);
      float h0 = v[i].x * rstd * gq.x + bq.x, h1 = v[i].y * rstd * gq.y + bq.y;
      float h2 = v[i].z * rstd * gq.z + bq.z, h3 = v[i].w * rstd * gq.w + bq.w;
      *(uint2*)((u16*)(ws + O_HBF) + (long)row * 2048 + c) = make_uint2(pk2(h0, h1), pk2(h2, h3));
      const float hh[4] = {h0, h1, h2, h3};
#pragma unroll
      for (int q = 0; q < 4; ++q) {
        const float4* wr = (const float4*)(p.w_router + (long)(c + q) * 16);
#pragma unroll
        for (int e4 = 0; e4 < 4; ++e4) {
          float4 w = wr[e4];
          lg[e4 * 4 + 0] += hh[q] * w.x; lg[e4 * 4 + 1] += hh[q] * w.y;
          lg[e4 * 4 + 2] += hh[q] * w.z; lg[e4 * 4 + 3] += hh[q] * w.w;
        }
      }
    }
    float mx = -1e30f;
#pragma unroll
    for (int e = 0; e < 16; ++e) { lg[e] = allred64(lg[e]); mx = fmaxf(mx, lg[e]); }
    float den = 0.f;
#pragma unroll
    for (int e = 0; e < 16; ++e) { lg[e] = __expf(lg[e] - mx); den += lg[e]; }
    const float inv = 1.f / den;
    float mine = 0.f;
#pragma unroll
    for (int e = 0; e < 16; ++e) if (lane == e) mine = lg[e] * inv;
    if (lane < 16) {
      const int b = row >> 12, s = row & 4095;
      ((float*)(ws + O_AFF))[((long)(b * 16 + lane)) * 4096 + s] = mine;
      ((int*)(ws + O_INV))[row * 16 + lane] = -1;
    }
  }
}

DEVINL void phase8(const Params& p) {
  char* ws = p.ws;
  const int bid = blockIdx.x, nb = gridDim.x, tid = otid();
  for (int pr = bid; pr < 32; pr += nb) {
    const int b = pr >> 4, e = pr & 15;
    unsigned* cnt = (unsigned*)dynsmem;
    const float* aff = (const float*)(ws + O_AFF) + (long)pr * 4096;
    const int lane = tid & 63;
    unsigned key[8];
#pragma unroll
    for (int i = 0; i < 8; ++i) key[i] = __float_as_uint(aff[tid + 512 * i]);
    if (tid < 40) cnt[tid] = 0u;
    __syncthreads();
    unsigned T = 0u;
    for (int bit = 30; bit >= 0; --bit) {
      const unsigned cand = T | (1u << bit);
      int c = 0;
#pragma unroll
      for (int i = 0; i < 8; ++i) c += (key[i] >= cand) ? 1 : 0;
      const float cf = allred64((float)c);
      if (lane == 0) atomicAdd(&cnt[bit], (unsigned)cf);
      __syncthreads();
      if (cnt[bit] >= 512u) T = cand;
    }
    {
      int c = 0;
#pragma unroll
      for (int i = 0; i < 8; ++i) c += (key[i] > T) ? 1 : 0;
      const float cf = allred64((float)c);
      if (lane == 0) atomicAdd(&cnt[31], (unsigned)cf);
      __syncthreads();
    }
    const unsigned ngt = cnt[31];
#pragma unroll
    for (int i = 0; i < 8; ++i) {
      int slot = -1;
      if (key[i] > T) slot = (int)atomicAdd(&cnt[32], 1u);
      else if (key[i] == T) { unsigned s2 = atomicAdd(&cnt[33], 1u); if (ngt + s2 < 512u) slot = (int)(ngt + s2); }
      if (slot >= 0) {
        ((int*)(ws + O_SELT))[e * 1024 + b * 512 + slot] = b * 4096 + tid + 512 * i;
        ((float*)(ws + O_SELG))[e * 1024 + b * 512 + slot] = __uint_as_float(key[i]);
        ((int*)(ws + O_INV))[(b * 4096 + tid + 512 * i) * 16 + e] = e * 1024 + b * 512 + slot;
      }
    }
    __syncthreads();
  }
  for (int t = bid; t < 16 * 128 * 3; t += nb) {
    const int which = t / (16 * 128), r = t % (16 * 128), e = r >> 7, tt = r & 127;
    if (which < 2) {
      const float* src = (which ? p.w3 : p.w1) + (long)e * 2048 * 1024;
      int kt = tt & 31, ntile = tt >> 5;
      tr_tile(src, 1024, 1024, kt * 64, ntile * 256, (u16*)(ws + O_W13T) + (long)e * 2048 * 2048, 2048, 128, 256, which * 128);
    } else {
      const float* src = p.w2 + (long)e * 1024 * 2048;
      int kt = tt & 15, ntile = tt >> 4;
      tr_tile(src, 2048, 2048, kt * 64, ntile * 256, (u16*)(ws + O_W2T) + (long)e * 2048 * 1024, 1024, 1 << 30, 0, 0);
    }
  }
}

DEVINL void phase9(const Params& p) {
  const u16* A = (const u16*)(p.ws + O_XE);
  for (int t = blockIdx.x; t < 512; t += gridDim.x) {
    const int e = t >> 5, pm = t & 3, pn = (t >> 2) & 7;
    const u16* Bt = (const u16*)(p.ws + O_W13T) + (long)e * 2048 * 2048;
    gemm_tile<EPI_HID, true>(p, (const u16*)(p.ws + O_HBF), 2048, (const int*)(p.ws + O_SELT), Bt, 2048, 2048, e * 1024 + pm * 256, pn * 256, e * 1024 + pm * 256, pn * 128);
  }
}
DEVINL void phase10(const Params& p) {
  const u16* A = (const u16*)(p.ws + O_HID);
  for (int t = blockIdx.x; t < 512; t += gridDim.x) {
    const int e = t >> 5, pm = t & 3, pn = (t >> 2) & 7;
    const u16* Bt = (const u16*)(p.ws + O_W2T) + (long)e * 2048 * 1024;
    gemm_tile<EPI_MOE2, false>(p, A, 1024, nullptr, Bt, 1024, 1024, e * 1024 + pm * 256, pn * 256, e * 1024 + pm * 256, pn * 256);
  }
}

DEVINL void phase11(const Params& p) {
  const int tid = otid();
  const int lane = tid & 63;
  const int gw = blockIdx.x * 8 + (tid >> 6), nw = gridDim.x * 8;
  for (int row = gw; row < T_; row += nw) {
    const u16* hb = (const u16*)(p.ws + O_HBF) + (long)row * 2048;
    float4 v[8];
    float sum = 0.f;
#pragma unroll
    for (int i = 0; i < 8; ++i) {
      const uint2 q = *(const uint2*)(hb + i * 256 + lane * 4);
      v[i] = make_float4(ALPHA * bflo(q.x), ALPHA * bfhi(q.x), ALPHA * bflo(q.y), ALPHA * bfhi(q.y));
    }
    {
      const int* inv = (const int*)(p.ws + O_INV) + row * 16;
      const int myinv = inv[lane & 15];
#pragma unroll 1
      for (int e = 0; e < 16; ++e) {
        const int er = __shfl(myinv, e);
        if (er >= 0) {
          const u16* eo = (const u16*)(p.ws + O_EO) + (long)er * 2048 + lane * 4;
#pragma unroll
          for (int i = 0; i < 8; ++i) {
            uint2 q = *(const uint2*)(eo + i * 256);
            v[i].x += bflo(q.x); v[i].y += bfhi(q.x); v[i].z += bflo(q.y); v[i].w += bfhi(q.y);
          }
        }
      }
    }
#pragma unroll
    for (int i = 0; i < 8; ++i) sum += v[i].x + v[i].y + v[i].z + v[i].w;
    const float mu = allred64(sum) * (1.f / 2048.f);
    float sq = 0.f;
#pragma unroll
    for (int i = 0; i < 8; ++i) {
      v[i].x -= mu; v[i].y -= mu; v[i].z -= mu; v[i].w -= mu;
      sq += v[i].x * v[i].x + v[i].y * v[i].y + v[i].z * v[i].z + v[i].w * v[i].w;
    }
    const float rstd = rsqrtf(allred64(sq) * (1.f / 2048.f) + 1e-5f);
#pragma unroll
    for (int i = 0; i < 8; ++i) {
      const int c = i * 256 + lane * 4;
      float4 gq = *(const float4*)(p.ln2_g + c);
      float4 bq = *(const float4*)(p.ln2_b + c);
      *(float4*)(p.out + (long)row * 2048 + c) = make_float4(v[i].x * rstd * gq.x + bq.x, v[i].y * rstd * gq.y + bq.y,
                                                             v[i].z * rstd * gq.z + bq.z, v[i].w * rstd * gq.w + bq.w);
    }
  }
}

#define XB_TMO      128
#define XB_XCNT(j)  (256  + 64 * (j))
#define XB_XSUB(j)  (1280 + 64 * (j))
#define XB_XGEN(j)  (2304 + 64 * (j))
#define XB_TOP      3328
#define XB_TOPGEN   3392
#define XCD_BAR_WORDS 3456
#define XB_SPIN_CAP (1u << 20)
#define LAS __attribute__((address_space(3)))
DEVINL unsigned xb_ld(unsigned* p_) { return __hip_atomic_load(p_, __ATOMIC_RELAXED, __HIP_MEMORY_SCOPE_AGENT); }
DEVINL unsigned xb_add(unsigned* p_, unsigned v) { return __hip_atomic_fetch_add(p_, v, __ATOMIC_RELAXED, __HIP_MEMORY_SCOPE_AGENT); }
DEVINL unsigned xb_xcc_id() { return (unsigned)__builtin_amdgcn_s_getreg((3 << 11) | 20) & 0xFu; }
#define XB_SPIN(cond, bar) do { unsigned _sp = 0; while (cond) { __builtin_amdgcn_s_sleep(1); \
    if ((++_sp & 255u) == 0u) { if (xb_ld(&(bar)[XB_TMO])) break; if (_sp > XB_SPIN_CAP) { atomicAdd(&(bar)[XB_TMO], 1u); break; } } } } while (0)
struct XcdBarrier { unsigned* bar; unsigned x; volatile LAS unsigned* st; };
DEVINL XcdBarrier xcd_barrier_post(unsigned* bar, volatile LAS unsigned* st) {
  XcdBarrier b; b.bar = bar; b.x = xb_xcc_id(); b.st = st;
  if (threadIdx.x == 0) (void)xb_add(&bar[XB_XCNT(b.x)], 1u);
  return b;
}
DEVINL void xcd_barrier_complete(unsigned* bar, unsigned x, unsigned& nloc, unsigned& nx) {
  const unsigned G = gridDim.x * gridDim.y * gridDim.z;
  unsigned sum, cnt, mine, sp = 0u;
  for (;;) {
    sum = 0u; cnt = 0u; mine = 0u;
#pragma unroll
    for (unsigned j = 0; j < 16; ++j) { const unsigned c = xb_ld(&bar[XB_XCNT(j)]); sum += c; cnt += (c > 0u) ? 1u : 0u; mine = (j == x) ? c : mine; }
    if (sum == G) break;
    __builtin_amdgcn_s_sleep(1);
    if ((++sp & 255u) == 0u) { if (xb_ld(&bar[XB_TMO])) break; if (sp > XB_SPIN_CAP) { atomicAdd(&bar[XB_TMO], 1u); break; } }
  }
  nloc = mine > 0u ? mine : 1u; nx = cnt > 0u ? cnt : 1u;
}
DEVINL void xcd_barrier(const XcdBarrier& b) {
  asm volatile("s_waitcnt vmcnt(0)" ::: "memory");
  __syncthreads();
  if (threadIdx.x == 0) {
    unsigned* bar = b.bar;
    __builtin_amdgcn_s_waitcnt(0);
    unsigned nloc = b.st[0], nx = b.st[1];
    if (nloc == 0u) { xcd_barrier_complete(bar, b.x, nloc, nx); b.st[0] = nloc; b.st[1] = nx; }
    const unsigned old = xb_add(&bar[XB_XSUB(b.x)], 1u);
    const unsigned gen = old / nloc;
    if (old + 1u == (gen + 1u) * nloc) {
      __builtin_amdgcn_fence(__ATOMIC_RELEASE, "agent");
      asm volatile("s_waitcnt vmcnt(0)" ::: "memory");
      const unsigned og = xb_add(&bar[XB_TOP], 1u);
      const unsigned tg = og / nx;
      if (og + 1u == (tg + 1u) * nx) xb_add(&bar[XB_TOPGEN], 1u);
      else XB_SPIN(xb_ld(&bar[XB_TOPGEN]) == tg, bar);
      __builtin_amdgcn_fence(__ATOMIC_ACQUIRE, "agent");
      xb_add(&bar[XB_XGEN(b.x)], 1u);
      asm volatile("s_waitcnt vmcnt(0)" ::: "memory");
    } else {
      XB_SPIN(xb_ld(&bar[XB_XGEN(b.x)]) == gen, bar);
      __builtin_amdgcn_fence(__ATOMIC_ACQUIRE, "agent");
      asm volatile("s_waitcnt vmcnt(0)" ::: "memory");
    }
  }
  __syncthreads();
}

template <int PH> DEVINL void run_phase(const Params& p) {
  if (PH == 0) phase0(p);
  else if (PH == 1) phase1(p);
  else if (PH == 2) phase2(p);
  else if (PH == 3) phase3(p);
  else if (PH == 4) phase4(p);
  else if (PH == 5) phase5(p);
  else if (PH == 6) phase6(p);
  else if (PH == 7) phase7(p);
  else if (PH == 8) phase8(p);
  else if (PH == 9) phase9(p);
  else if (PH == 10) phase10(p);
  else if (PH == 11) phase11(p);
}

constexpr int SHM_BYTES = 131072;

#if MULTI
template <int PH> __global__ void __launch_bounds__(512, 2) k_phase(Params p) { run_phase<PH>(p); }
template <int PH> static void launch_phase(const Params& p, hipStream_t stream) {
  hipFuncSetAttribute((const void*)k_phase<PH>, hipFuncAttributeMaxDynamicSharedMemorySize, SHM_BYTES);
  k_phase<PH><<<256, 512, SHM_BYTES, stream>>>(p);
}
#else
__global__ void __launch_bounds__(512, 2) k_mega(Params p) {
  cg::grid_group grid = cg::this_grid();
  __shared__ uint4 xb_words;
  unsigned* bar = (unsigned*)(p.ws + O_BAR);
  if (threadIdx.x == 0) xb_words = make_uint4(0u, 0u, 0u, 0u);
  __syncthreads();
  XcdBarrier xb = xcd_barrier_post(bar, (volatile LAS unsigned*)&xb_words);
  if (p.out == nullptr) grid.sync();
  run_phase<0>(p); xcd_barrier(xb);
  run_phase<1>(p); xcd_barrier(xb);
  run_phase<2>(p); xcd_barrier(xb);
  run_phase<3>(p); xcd_barrier(xb);
  run_phase<4>(p); xcd_barrier(xb);
  run_phase<5>(p); xcd_barrier(xb);
  run_phase<6>(p); xcd_barrier(xb);
  run_phase<7>(p); xcd_barrier(xb);
  run_phase<8>(p); xcd_barrier(xb);
  run_phase<9>(p); xcd_barrier(xb);
  run_phase<10>(p); xcd_barrier(xb);
  run_phase<11>(p);
}
#endif

extern "C" void kernel_launch(void* const* d_in, const int* in_sizes, int n_in, void* d_out, int out_size,
                              void* d_ws, size_t ws_size, hipStream_t stream) {
  Params p{};
  const float** f = (const float**)&p;
  for (int i = 0; i < 31; ++i) f[i] = (const float*)d_in[i];
  p.out = (float*)d_out;
  p.ws = (char*)d_ws;
  if (ws_size < WS_NEED) { fprintf(stderr, "workspace too small: %zu < %zu\n", ws_size, (size_t)WS_NEED); return; }
#if MULTI
  launch_phase<0>(p, stream); launch_phase<1>(p, stream); launch_phase<2>(p, stream); launch_phase<3>(p, stream);
  launch_phase<4>(p, stream); launch_phase<5>(p, stream); launch_phase<6>(p, stream); launch_phase<7>(p, stream);
  launch_phase<8>(p, stream); launch_phase<9>(p, stream); launch_phase<10>(p, stream); launch_phase<11>(p, stream);
#else
  static int grid_blocks = 0;
  if (!grid_blocks) {
    int dev = 0, cus = 0, per_cu = 0;
    hipGetDevice(&dev);
    hipDeviceGetAttribute(&cus, hipDeviceAttributeMultiprocessorCount, dev);
    hipFuncSetAttribute((const void*)k_mega, hipFuncAttributeMaxDynamicSharedMemorySize, SHM_BYTES);
    hipOccupancyMaxActiveBlocksPerMultiprocessor(&per_cu, k_mega, 512, SHM_BYTES);
    if (per_cu < 1) per_cu = 1;
    grid_blocks = cus * per_cu;
    if (grid_blocks > 256) grid_blocks = 256;
  }
  hipMemsetAsync((char*)d_ws + O_BAR, 0, XCD_BAR_WORDS * sizeof(unsigned), stream);
  void* args[] = {&p};
  hipError_t e = hipLaunchCooperativeKernel((void*)k_mega, dim3(grid_blocks), dim3(512), args, SHM_BYTES, stream);
  if (e != hipSuccess) fprintf(stderr, "cooperative launch failed: %s (grid %d)\n", hipGetErrorString(e), grid_blocks);
#endif
}
```

```cpp
#include <hip/hip_runtime.h>
#include <hip/hip_cooperative_groups.h>
#include <cstdio>
namespace cg = cooperative_groups;

#ifndef MULTI
#define MULTI 0
#endif

typedef unsigned short u16;
typedef __bf16 bf2_t __attribute__((ext_vector_type(2)));
typedef float f2_t __attribute__((ext_vector_type(2)));
using bf16x8 = __attribute__((ext_vector_type(8))) short;
using s16x4 = __attribute__((ext_vector_type(4))) short;
using f32x4 = __attribute__((ext_vector_type(4))) float;
#define DEVINL __device__ __forceinline__

constexpr int T_ = 8192, S_ = 4096, D_ = 2048, NC = 10592, NCP = 10752;
constexpr int C_Q = 0, C_K = 512, C_V = 1024, C_G = 2048, C_AF = 3072, C_RW = 3104;
constexpr int C_GG = 6496, C_GR = 8544;
constexpr float ALPHA = 1.189207115f;

constexpr size_t MB = 1ull << 20;
constexpr size_t O_XBF = 0;
constexpr size_t O_WINT = 32 * MB;
constexpr size_t O_OSUM = 0;
constexpr size_t O_YSUM = 32 * MB;
constexpr size_t O_R1 = 0;
constexpr size_t O_COLS = 76 * MB;
constexpr size_t O_ACC2 = 76 * MB;
constexpr size_t O_W13T = 140 * MB;
constexpr size_t O_W2T = 268 * MB;
constexpr size_t O_HID = 332 * MB;
constexpr size_t O_REC = 244 * MB;
constexpr size_t O_YGLA = 244 * MB;
constexpr size_t O_YRW = 260 * MB;
constexpr size_t O_MERGED = 276 * MB;
constexpr size_t O_QT = 372 * MB;
constexpr size_t O_KT = 388 * MB;
constexpr size_t O_KDT = 404 * MB;
constexpr size_t O_VT = 420 * MB;
constexpr size_t O_DEC = 436 * MB;
constexpr size_t O_M1 = 372 * MB;
constexpr size_t O_HBF = 372 * MB;
constexpr size_t O_XE = 404 * MB;
constexpr size_t O_VSCAN = 437 * MB;
constexpr size_t O_GRW = 453 * MB;
constexpr size_t O_BONUS = 469 * MB;
constexpr size_t O_WUPGT = 485 * MB;
constexpr size_t O_WUPRT = 489 * MB;
constexpr size_t O_WOUTT = 493 * MB;
constexpr size_t O_LWF = 501 * MB;
constexpr size_t O_LWB = O_LWF + 128 * 1024;
constexpr size_t O_LA = O_LWB + 128 * 1024;
constexpr size_t O_LG = O_LA + 128 * 1024;
constexpr size_t O_AFF = 502 * MB;
constexpr size_t O_SELT = O_AFF + 512 * 1024;
constexpr size_t O_SELG = O_SELT + 64 * 1024;
constexpr size_t O_YB = 503 * MB;
constexpr size_t O_EO = 140 * MB;
constexpr size_t O_INV = 535 * MB;
constexpr size_t O_BAR = 535 * MB + 768 * 1024;
constexpr size_t WS_NEED = 536 * MB;

struct Params {
  const float *x, *w_in, *gla_a_up_f, *gla_a_bias_f, *gla_a_up_b, *gla_a_bias_b, *gla_norm_g;
  const float *rw_mu, *rw_w0_f, *rw_w_up_f, *rw_w0_b, *rw_w_up_b, *rw_a0, *rw_a_up, *rw_g_up;
  const float *rw_k_k, *rw_k_a, *rw_r_k, *rw_ln_g, *rw_ln_b, *w_up_gla, *w_up_rwkv, *w_out;
  const float *ln1_g, *ln1_b, *w_router, *w1, *w3, *w2, *ln2_g, *ln2_b;
  float* out;
  char* ws;
};

DEVINL unsigned pk2(float a, float b) {
  f2_t v = {a, b};
  bf2_t r = __builtin_convertvector(v, bf2_t);
  return *(unsigned*)&r;
}
DEVINL u16 f2bf(float a) { return (u16)(pk2(a, 0.f) & 0xffffu); }
DEVINL float bf2f(u16 h) { return __uint_as_float(((unsigned)h) << 16); }
DEVINL float bflo(unsigned u) { return __uint_as_float(u << 16); }
DEVINL float bfhi(unsigned u) { return __uint_as_float(u & 0xffff0000u); }
DEVINL float sigm(float x) { return 1.f / (1.f + __expf(-x)); }
DEVINL float tanh_(float x) { return 1.f - 2.f / (__expf(2.f * x) + 1.f); }
DEVINL float logsig(float z) { return fminf(z, 0.f) - __logf(1.f + __expf(-fabsf(z))); }
template <int CTRL> DEVINL float dppf(float x) {
  return __int_as_float(__builtin_amdgcn_update_dpp(0, __float_as_int(x), CTRL, 0xF, 0xF, true));
}
DEVINL float allred16(float x) {
  x += dppf<0xB1>(x); x += dppf<0x4E>(x); x += dppf<0x141>(x); x += dppf<0x140>(x);
  return x;
}
DEVINL void allred16x2(float& a, float& b) {
  a += dppf<0xB1>(a); b += dppf<0xB1>(b);
  a += dppf<0x4E>(a); b += dppf<0x4E>(b);
  a += dppf<0x141>(a); b += dppf<0x141>(b);
  a += dppf<0x140>(a); b += dppf<0x140>(b);
}
DEVINL float allred64(float x) {
  x = allred16(x);
  x += __shfl_xor(x, 16);
  x += __shfl_xor(x, 32);
  return x;
}
DEVINL bf16x8 mk8(s16x4 lo, s16x4 hi) {
  bf16x8 r;
  r[0] = lo[0]; r[1] = lo[1]; r[2] = lo[2]; r[3] = lo[3];
  r[4] = hi[0]; r[5] = hi[1]; r[6] = hi[2]; r[7] = hi[3];
  return r;
}
DEVINL bf16x8 pack8(f32x4 a, f32x4 b) {
  union { bf16x8 v; unsigned u[4]; } r;
  r.u[0] = pk2(a[0], a[1]); r.u[1] = pk2(a[2], a[3]);
  r.u[2] = pk2(b[0], b[1]); r.u[3] = pk2(b[2], b[3]);
  return r.v;
}
DEVINL int fragpos(int idx) { const int w = idx & 31; return (idx & ~31) + (((w & 15) >> 2) << 3) + (w & 3) + ((w >> 4) << 2); }
DEVINL bf16x8 ld16(const u16* base) { return *(const bf16x8*)base; }
DEVINL bf16x8 ldfrag(const u16* base) {
  s16x4 lo = *(const s16x4*)base;
  s16x4 hi = *(const s16x4*)(base + 16);
  return mk8(lo, hi);
}
DEVINL float sel4(f32x4 v, int j) { return j == 0 ? v[0] : (j == 1 ? v[1] : (j == 2 ? v[2] : v[3])); }
DEVINL u16 f2h(float a) { _Float16 h = (_Float16)a; return __builtin_bit_cast(u16, h); }
DEVINL float fmix_lo(float s, unsigned h, float c) {
  float d; asm("v_fma_mix_f32 %0, %1, %2, %3 op_sel:[0,0,0] op_sel_hi:[0,1,0]" : "=v"(d) : "v"(s), "v"(h), "v"(c)); return d;
}
DEVINL float fmix_hi(float s, unsigned h, float c) {
  float d; asm("v_fma_mix_f32 %0, %1, %2, %3 op_sel:[0,1,0] op_sel_hi:[0,1,0]" : "=v"(d) : "v"(s), "v"(h), "v"(c)); return d;
}
DEVINL float fmixhh_lo(unsigned vh, unsigned h, float c) {
  float d; asm("v_fma_mix_f32 %0, %1, %2, %3 op_sel:[0,0,0] op_sel_hi:[1,1,0]" : "=v"(d) : "v"(vh), "v"(h), "v"(c)); return d;
}
DEVINL float fmixhh_hi(unsigned vh, unsigned h, float c) {
  float d; asm("v_fma_mix_f32 %0, %1, %2, %3 op_sel:[0,1,0] op_sel_hi:[1,1,0]" : "=v"(d) : "v"(vh), "v"(h), "v"(c)); return d;
}
DEVINL float fmul_hi(float s, unsigned h) {
  float d; asm("v_fma_mix_f32 %0, %1, %2, 0 op_sel:[0,1,0] op_sel_hi:[0,1,0]" : "=v"(d) : "v"(s), "v"(h)); return d;
}
DEVINL float fmul_lo(float s, unsigned h) {
  float d; asm("v_fma_mix_f32 %0, %1, %2, 0 op_sel:[0,0,0] op_sel_hi:[0,1,0]" : "=v"(d) : "v"(s), "v"(h)); return d;
}
#define MFMA16(a, b, c) __builtin_amdgcn_mfma_f32_16x16x32_bf16(a, b, c, 0, 0, 0)

extern __shared__ __attribute__((aligned(16))) char dynsmem[];
extern __shared__ __attribute__((aligned(16))) char dynsmem_rd[];
DEVINL int otid() { int t = threadIdx.x; asm volatile("" : "+v"(t)); return t; }

constexpr int BM = 256, BK = 64, HALF = 128, HT = HALF * BK;
DEVINL int lds_byte(int r, int c) {
  int st = (r >> 4) * 2 + (c >> 5), rr = r & 15, cc = c & 31, ob = rr * 64 + cc * 2;
  return st * 1024 + (ob ^ (((ob >> 9) & 1) << 5));
}
DEVINL void stage_rc(int b, int& R, int& C) {
  int st = b / 1024, sb = b % 1024, swz = sb ^ (((sb >> 9) & 1) << 5);
  R = (st >> 1) * 16 + swz / 64; C = (st & 1) * 32 + (swz % 64) / 2;
}

DEVINL void xchg_pairs(f32x4 v, bool odd, float (&lo)[2], float (&hi)[2]) {
  const float s0 = odd ? v[0] : v[2], s1 = odd ? v[1] : v[3];
  const float r0 = dppf<0xB1>(s0), r1 = dppf<0xB1>(s1);
  lo[0] = odd ? r0 : v[0]; hi[0] = odd ? v[2] : r0;
  lo[1] = odd ? r1 : v[1]; hi[1] = odd ? v[3] : r1;
}
enum { EPI_COLS = 0, EPI_M1, EPI_MERGED, EPI_R1, EPI_HID, EPI_MOE2 };

template <int EPI, bool GATHER>
DEVINL void gemm_tile(const Params& p, const u16* __restrict__ A, int lda, const int* __restrict__ rowidx,
                      const u16* __restrict__ Bt, int ldb, int K, int brow, int bcol, int orow, int ocol) {
  u16* shm = (u16*)dynsmem;
#define SA(b, h) (shm + ((b) * 2 + (h)) * HT)
#define SB(b, h) (shm + (4 + (b) * 2 + (h)) * HT)
  const int tid = otid();
  int offA[2][2], offB[2];
#pragma unroll
  for (int i = 0; i < 2; ++i) {
    int R, C; stage_rc(tid * 16 + i * 8192, R, C);
    offB[i] = R * ldb + C;
#pragma unroll
    for (int h = 0; h < 2; ++h) {
      if (GATHER) offA[h][i] = rowidx[brow + h * HALF + R] * lda + C;
      else offA[h][i] = R * lda + C;
    }
  }
  const u16* Ab[2]; const u16* Bb[2];
#pragma unroll
  for (int h = 0; h < 2; ++h) {
    Ab[h] = GATHER ? A : (A + (long)(brow + h * HALF) * lda);
    Bb[h] = Bt + (long)(bcol + h * HALF) * ldb;
  }
#define STAGE_A(b, h, kt) do { _Pragma("unroll") for (int _i = 0; _i < 2; ++_i) \
    __builtin_amdgcn_global_load_lds((const unsigned*)(Ab[h] + (kt) * BK + offA[GATHER ? h : 0][_i]), \
      (__attribute__((address_space(3))) unsigned*)((char*)SA(b, h) + tid * 16 + _i * 8192), 16, 0, 0); } while (0)
#define STAGE_B(b, h, kt) do { _Pragma("unroll") for (int _i = 0; _i < 2; ++_i) \
    __builtin_amdgcn_global_load_lds((const unsigned*)(Bb[h] + (kt) * BK + offB[_i]), \
      (__attribute__((address_space(3))) unsigned*)((char*)SB(b, h) + tid * 16 + _i * 8192), 16, 0, 0); } while (0)
#define LDA(dst, b, h) _Pragma("unroll") for (int m = 0; m < 4; ++m) _Pragma("unroll") for (int k = 0; k < 2; ++k) \
    dst[m][k] = *reinterpret_cast<const bf16x8*>((char*)SA(b, h) + lds_byte(wr * 64 + m * 16 + fr, k * 32 + fq * 8))
#define LDB(dst, b, h) _Pragma("unroll") for (int n = 0; n < 2; ++n) _Pragma("unroll") for (int k = 0; k < 2; ++k) \
    dst[n][k] = *reinterpret_cast<const bf16x8*>((char*)SB(b, h) + lds_byte(wc * 32 + n * 16 + fr, k * 32 + fq * 8))
#define MMA(ai, bj, At_, Bt_) do { __builtin_amdgcn_s_setprio(1); \
    _Pragma("unroll") for (int m = 0; m < 4; ++m) _Pragma("unroll") for (int n = 0; n < 2; ++n) _Pragma("unroll") for (int k = 0; k < 2; ++k) \
      acc[ai][bj][m][n] = MFMA16(At_[m][k], Bt_[n][k], acc[ai][bj][m][n]); \
    __builtin_amdgcn_s_setprio(0); } while (0)
#define WAIT_V(n) asm volatile("s_waitcnt vmcnt(" #n ")" ::: "memory")
#define WAIT_L(n) asm volatile("s_waitcnt lgkmcnt(" #n ")" ::: "memory")
#define BAR __builtin_amdgcn_s_barrier()
#define SCHED __builtin_amdgcn_sched_barrier(0)

  const int wid = tid >> 6, lane = tid & 63, wr = wid >> 2, wc = wid & 3, fr = lane & 15, fq = lane >> 4;
  f32x4 acc[2][2][4][2] = {};
  bf16x8 At[4][2], B0[2][2], B1[2][2];
  const int nt = K / BK;
  STAGE_B(0, 0, 0); STAGE_A(0, 0, 0);
  STAGE_B(0, 1, 0); STAGE_A(0, 1, 0);
  if (wr == 1) BAR;
  WAIT_V(4); BAR;
  STAGE_B(1, 0, 1); STAGE_A(1, 0, 1); STAGE_B(1, 1, 1);
  WAIT_V(6); BAR;
  for (int t = 0; t < nt - 2; t += 2) {
    LDB(B0, 0, 0); SCHED; LDA(At, 0, 0); STAGE_A(1, 1, t + 1);
    WAIT_L(8); BAR; WAIT_L(0); MMA(0, 0, At, B0); BAR; SCHED;
    LDB(B1, 0, 1); STAGE_B(0, 0, t + 2);
    BAR; WAIT_L(0); MMA(0, 1, At, B1); BAR;
    LDA(At, 0, 1); STAGE_A(0, 0, t + 2);
    BAR; WAIT_L(0); MMA(1, 0, At, B0); BAR; SCHED;
    STAGE_B(0, 1, t + 2);
    WAIT_V(6); BAR; MMA(1, 1, At, B1); BAR;
    LDB(B0, 1, 0); SCHED; LDA(At, 1, 0); STAGE_A(0, 1, t + 2);
    WAIT_L(8); BAR; WAIT_L(0); MMA(0, 0, At, B0); BAR; SCHED;
    LDB(B1, 1, 1); STAGE_B(1, 0, t + 3);
    BAR; WAIT_L(0); MMA(0, 1, At, B1); BAR;
    LDA(At, 1, 1); STAGE_A(1, 0, t + 3);
    BAR; WAIT_L(0); MMA(1, 0, At, B0); BAR; SCHED;
    STAGE_B(1, 1, t + 3);
    WAIT_V(6); BAR; MMA(1, 1, At, B1); BAR;
  }
  { LDB(B0, 0, 0); LDA(At, 0, 0); STAGE_A(1, 1, nt - 1);
    BAR; WAIT_L(0); MMA(0, 0, At, B0); BAR;
    LDB(B1, 0, 1); BAR; WAIT_L(0); MMA(0, 1, At, B1); BAR;
    LDA(At, 0, 1); WAIT_V(4); BAR; WAIT_L(0); MMA(1, 0, At, B0); MMA(1, 1, At, B1); BAR; }
  { LDB(B0, 1, 0); LDA(At, 1, 0); WAIT_V(2); BAR; WAIT_L(0); MMA(0, 0, At, B0); BAR;
    LDB(B1, 1, 1); WAIT_V(0); BAR; WAIT_L(0); MMA(0, 1, At, B1); BAR;
    LDA(At, 1, 1); BAR; WAIT_L(0); MMA(1, 0, At, B0); MMA(1, 1, At, B1); BAR; }
  if (wr == 0) BAR;

  char* ws = p.ws;
  const int row0 = orow + wr * 64 + fq * 4;
  const int col0 = ocol + wc * 32 + fr;
  const bool odd = (fr & 1) != 0;
  const int colp = col0 - (odd ? 1 : 0);
#pragma unroll
  for (int ai = 0; ai < 2; ++ai)
#pragma unroll
    for (int m = 0; m < 4; ++m) {
      const int rA = row0 + ai * HALF + m * 16 + (odd ? 2 : 0);
      float gate[2] = {0.f, 0.f};
      if (EPI == EPI_MOE2) { gate[0] = ((const float*)(ws + O_SELG))[rA]; gate[1] = ((const float*)(ws + O_SELG))[rA + 1]; }
#pragma unroll
      for (int bj = 0; bj < (EPI == EPI_HID ? 1 : 2); ++bj)
#pragma unroll
        for (int n = 0; n < 2; ++n) {
          const int cc = bj * HALF + n * 16;
          f32x4 v = acc[ai][bj][m][n];
          if (EPI == EPI_HID) {
#pragma unroll
            for (int j = 0; j < 4; ++j) { const float a1 = acc[ai][0][m][n][j], a3 = acc[ai][1][m][n][j]; v[j] = a1 * sigm(a1) * a3; }
          }
          float lo[2], hi[2];
          xchg_pairs(v, odd, lo, hi);
#pragma unroll
          for (int k = 0; k < 2; ++k) {
            const unsigned row = (unsigned)(rA + k);
            if (EPI == EPI_HID) {
              *(unsigned*)(ws + O_HID + (row * 1024u + (unsigned)(colp + cc)) * 2u) = pk2(lo[k], hi[k]);
            } else if (EPI == EPI_COLS) {
              *(unsigned*)(ws + O_COLS + (row * (unsigned)NCP + (unsigned)(colp + cc)) * 2u) = pk2(lo[k], hi[k]);
            } else if (EPI == EPI_MOE2) {
              *(unsigned*)(ws + O_EO + (row * 2048u + (unsigned)(colp + cc)) * 2u) = pk2(gate[k] * lo[k], gate[k] * hi[k]);
            } else if (EPI == EPI_M1) {
              const unsigned g2 = *(const unsigned*)(ws + O_COLS + (row * (unsigned)NCP + (unsigned)(C_GG + colp + cc)) * 2u);
              *(unsigned*)(ws + O_M1 + (row * 2048u + (unsigned)(colp + cc)) * 2u) = pk2(sigm(bflo(g2)) * lo[k], sigm(bfhi(g2)) * hi[k]);
            } else if (EPI == EPI_MERGED) {
              const unsigned g2 = *(const unsigned*)(ws + O_COLS + (row * (unsigned)NCP + (unsigned)(C_GR + colp + cc)) * 2u);
              const unsigned m1 = *(const unsigned*)(ws + O_M1 + (row * 2048u + (unsigned)(colp + cc)) * 2u);
              *(unsigned*)(ws + O_MERGED + (row * 2048u + (unsigned)(colp + cc)) * 2u) =
                  pk2(bflo(m1) + sigm(bflo(g2)) * lo[k], bfhi(m1) + sigm(bfhi(g2)) * hi[k]);
            } else if (EPI == EPI_R1) {
              const unsigned o4 = (row * 2048u + (unsigned)(colp + cc)) * 4u;
              const float2 xv = *(const float2*)((const char*)p.x + o4);
              *(unsigned*)(ws + O_R1 + (o4 >> 1)) = pk2(ALPHA * xv.x + lo[k], ALPHA * xv.y + hi[k]);
            }
          }
        }
      __builtin_amdgcn_sched_barrier(0);
    }
  __syncthreads();
#undef SA
#undef SB
}

DEVINL void tr_tile(const float* __restrict__ src, int ldsrc, int nvalid, int k0, int n0,
                    u16* __restrict__ dst, int lddst, int grp, int gstride, int goff) {
  float* tile = (float*)dynsmem;
  const int tid = otid();
  float4 v[8];
#pragma unroll
  for (int i = 0; i < 8; ++i) {
    int f = tid + i * 512; int r = f >> 6, c4 = (f & 63) * 4;
    int n = n0 + c4;
    v[i] = make_float4(0.f, 0.f, 0.f, 0.f);
    if (n < nvalid) {
      const f32x4 q = __builtin_nontemporal_load((const f32x4*)(src + (long)(k0 + r) * ldsrc + n));
      v[i] = make_float4(q[0], q[1], q[2], q[3]);
    }
  }
#pragma unroll
  for (int i = 0; i < 8; ++i) {
    int f = tid + i * 512; int r = f >> 6, c4 = (f & 63) * 4;
    float* tp = tile + r * 257 + c4;
    tp[0] = v[i].x; tp[1] = v[i].y; tp[2] = v[i].z; tp[3] = v[i].w;
  }
  __syncthreads();
  {
    const int n = tid >> 1, kc = (tid & 1) * 32;
    const float* tp = tile + kc * 257 + n;
    const int nn = n0 + n;
    const long row = (long)(nn / grp) * gstride + (nn % grp) + goff;
    uint4* dp = (uint4*)(dst + row * lddst + k0 + kc);
#pragma unroll
    for (int q = 0; q < 4; ++q) {
      uint4 o;
      o.x = pk2(tp[(q * 8 + 0) * 257], tp[(q * 8 + 1) * 257]);
      o.y = pk2(tp[(q * 8 + 2) * 257], tp[(q * 8 + 3) * 257]);
      o.z = pk2(tp[(q * 8 + 4) * 257], tp[(q * 8 + 5) * 257]);
      o.w = pk2(tp[(q * 8 + 6) * 257], tp[(q * 8 + 7) * 257]);
      dp[q] = o;
    }
  }
  __syncthreads();
}
DEVINL void tr_job(const float* src, int K, int N, int Npad, u16* dst, int bid, int nb) {
  const int tk = K / 64, tn = Npad / 256;
  for (int t = bid; t < tk * tn; t += nb) {
    int kt = t % tk, ntile = t / tk;
    tr_tile(src, N, N, kt * 64, ntile * 256, dst, K, 1 << 30, 0, 0);
  }
}

DEVINL void phase0(const Params& p) {
  char* ws = p.ws;
  const int bid = blockIdx.x, nb = gridDim.x, tid = otid();
  {
    const float4* xs = (const float4*)p.x;
    uint2* xd = (uint2*)(ws + O_XBF);
    const long n4 = (long)T_ * D_ / 4;
    const long stride = (long)nb * 512;
    for (long i = (long)bid * 512 + tid; i < n4; i += 4 * stride) {
      const f32x4* xq = (const f32x4*)xs;
      const f32x4 q0 = __builtin_nontemporal_load(xq + i), q1 = __builtin_nontemporal_load(xq + i + stride);
      const f32x4 q2 = __builtin_nontemporal_load(xq + i + 2 * stride), q3 = __builtin_nontemporal_load(xq + i + 3 * stride);
      float4 v0 = make_float4(q0[0], q0[1], q0[2], q0[3]), v1 = make_float4(q1[0], q1[1], q1[2], q1[3]);
      float4 v2 = make_float4(q2[0], q2[1], q2[2], q2[3]), v3 = make_float4(q3[0], q3[1], q3[2], q3[3]);
      xd[i] = make_uint2(pk2(v0.x, v0.y), pk2(v0.z, v0.w));
      xd[i + stride] = make_uint2(pk2(v1.x, v1.y), pk2(v1.z, v1.w));
      xd[i + 2 * stride] = make_uint2(pk2(v2.x, v2.y), pk2(v2.z, v2.w));
      xd[i + 3 * stride] = make_uint2(pk2(v3.x, v3.y), pk2(v3.z, v3.w));
    }
  }
  tr_job(p.w_in, 2048, NC, NCP, (u16*)(ws + O_WINT), bid, nb);
  tr_job(p.w_up_gla, 1024, 2048, 2048, (u16*)(ws + O_WUPGT), bid, nb);
  tr_job(p.w_up_rwkv, 1024, 2048, 2048, (u16*)(ws + O_WUPRT), bid, nb);
  tr_job(p.w_out, 2048, 2048, 2048, (u16*)(ws + O_WOUTT), bid, nb);
  tr_job(p.rw_w_up_f, 64, 1024, 1024, (u16*)(ws + O_LWF), bid, nb);
  tr_job(p.rw_w_up_b, 64, 1024, 1024, (u16*)(ws + O_LWB), bid, nb);
  tr_job(p.rw_a_up, 64, 1024, 1024, (u16*)(ws + O_LA), bid, nb);
  tr_job(p.rw_g_up, 128, 1024, 1024, (u16*)(ws + O_LG), bid, nb);
}

DEVINL void phase1(const Params& p) {
  const u16* A = (const u16*)(p.ws + O_XBF);
  const u16* Bt = (const u16*)(p.ws + O_WINT);
  const int ntiles = 32 * 42;
  for (int t = blockIdx.x; t < ntiles; t += gridDim.x) {
    int pm = t & 31, pn = t >> 5;
    gemm_tile<EPI_COLS, false>(p, A, 2048, nullptr, Bt, 2048, 2048, pm * 256, pn * 256, pm * 256, pn * 256);
  }
}

DEVINL void gla_prep_unit(const Params& p, int unit) {
  const int h = unit & 3, c = (unit >> 2) & 63, b = unit >> 8;
  char* ws = p.ws;
  const u16* cols = (const u16*)(ws + O_COLS);
  const int tid = otid();
  float* afab = (float*)dynsmem;
  float* G = (float*)(dynsmem + 8192);
  u16* KD = (u16*)(dynsmem + 8192 + 65536);
  u16* VL = (u16*)dynsmem;
  const long tok0 = (long)b * S_ + c * 64;
  for (int i = tid; i < 64 * 32; i += 512) {
    int r = i >> 5, cc = i & 31;
    afab[i] = bf2f(cols[(tok0 + r) * NCP + C_AF + cc]);
  }
  __syncthreads();
  if (tid < 256) {
    const int dir = tid >> 7, kk = tid & 127;
    const float* up = dir ? p.gla_a_up_b : p.gla_a_up_f;
    const float bias = (dir ? p.gla_a_bias_b : p.gla_a_bias_f)[h * 128 + kk];
    float u[16];
#pragma unroll
    for (int r = 0; r < 16; ++r) u[r] = up[r * 512 + h * 128 + kk];
    float* Gc = G + dir * 64 * 128 + kk;
    for (int i = 0; i < 64; ++i) {
      float z = bias;
#pragma unroll
      for (int r = 0; r < 16; ++r) z += afab[i * 32 + dir * 16 + r] * u[r];
      Gc[i * 128] = logsig(z) * (1.f / 16.f);
    }
    float run = 0.f;
    if (dir == 0) { for (int i = 0; i < 64; ++i) { run += Gc[i * 128]; Gc[i * 128] = run; } }
    else { for (int i = 63; i >= 0; --i) { run += Gc[i * 128]; Gc[i * 128] = run; } }
    const float bedge = run;
    const long hb = ((long)(dir * 2 + b) * 4 + h);
    const int pk = fragpos(kk);
    u16* qt = (u16*)(ws + O_QT) + (hb * 4096 + c * 64) * 128 + pk;
    u16* kt = (u16*)(ws + O_KT) + (hb * 4096 + c * 64) * 128 + pk;
    ((float*)(ws + O_DEC))[(hb * 64 + c) * 128 + kk] = __expf(bedge);
    u16* KDr = KD + (dir * 128 + kk) * 72;
    const unsigned short* qsrc = cols + tok0 * NCP + C_Q + h * 128 + kk;
    const unsigned short* ksrc = cols + tok0 * NCP + C_K + h * 128 + kk;
#pragma unroll 1
    for (int i0 = 0; i0 < 64; i0 += 8) {
      u16 qv[8], kv[8];
#pragma unroll
      for (int j = 0; j < 8; ++j) { qv[j] = qsrc[(long)(i0 + j) * NCP]; kv[j] = ksrc[(long)(i0 + j) * NCP]; }
#pragma unroll
      for (int j = 0; j < 8; ++j) {
        const int i = i0 + j;
        float bb = Gc[i * 128];
        float q = bf2f(qv[j]);
        float k = bf2f(kv[j]);
        qt[i * 128] = f2bf(q * 0.08838834764831845f * __expf(bb));
        kt[i * 128] = f2bf(k * __expf(-bb));
        KDr[fragpos(i)] = f2bf(k * __expf(bedge - bb));
      }
    }
  }
  __syncthreads();
#pragma unroll 8
  for (int idx = tid; idx < 64 * 256; idx += 512) {
    int i = idx >> 8, vc = idx & 255;
    VL[vc * 72 + fragpos(i)] = cols[(tok0 + i) * NCP + C_V + h * 256 + vc];
  }
  __syncthreads();
  for (int pc = tid; pc < 4096; pc += 512) {
    int row = pc >> 3, ch = pc & 7;
    if (row < 256) {
      int dir = row >> 7, kk = row & 127;
      uint4 v = *(const uint4*)(KD + row * 72 + ch * 8);
      long hb = ((long)(dir * 2 + b) * 4 + h);
      *(uint4*)((u16*)(ws + O_KDT) + ((hb * 64 + c) * 128 + kk) * 64 + ch * 8) = v;
    } else {
      int vc = row - 256;
      uint4 v = *(const uint4*)(VL + vc * 72 + ch * 8);
      long hb = ((long)b * 4 + h);
      *(uint4*)((u16*)(ws + O_VT) + ((hb * 64 + c) * 256 + vc) * 64 + ch * 8) = v;
    }
  }
  __syncthreads();
}

DEVINL float rw_shift2(const char* colsb, float muv, unsigned o, int s) {
  const unsigned op = (s > 0) ? o - (unsigned)(NCP * 2) : o;
  const unsigned on = (s < S_ - 1) ? o + (unsigned)(NCP * 2) : o;
  float cur = bf2f(*(const u16*)(colsb + o));
  float prv = bf2f(*(const u16*)(colsb + op));
  float nxt = bf2f(*(const u16*)(colsb + on));
  if (s == 0) prv = 0.f;
  if (s == S_ - 1) nxt = 0.f;
  return cur + muv * (0.5f * (prv + nxt) - cur);
}

DEVINL void rw_shift4(const char* colsb, float4 mu, unsigned o, int s, float (&out)[4]) {
  const unsigned op = (s > 0) ? o - (unsigned)(NCP * 2) : o;
  const unsigned on = (s < S_ - 1) ? o + (unsigned)(NCP * 2) : o;
  const uint2 c = *(const uint2*)(colsb + o);
  uint2 pv = *(const uint2*)(colsb + op);
  uint2 nx = *(const uint2*)(colsb + on);
  if (s == 0) pv = make_uint2(0u, 0u);
  if (s == S_ - 1) nx = make_uint2(0u, 0u);
  const float cu[4] = {bflo(c.x), bfhi(c.x), bflo(c.y), bfhi(c.y)};
  const float pr[4] = {bflo(pv.x), bfhi(pv.x), bflo(pv.y), bfhi(pv.y)};
  const float nn[4] = {bflo(nx.x), bfhi(nx.x), bflo(nx.y), bfhi(nx.y)};
  const float m[4] = {mu.x, mu.y, mu.z, mu.w};
#pragma unroll
  for (int e = 0; e < 4; ++e) out[e] = cu[e] + m[e] * (0.5f * (pr[e] + nn[e]) - cu[e]);
}

DEVINL void rw_prep_unit(const Params& p, int unit) {
  char* ws = p.ws;
  const char* colsb = ws + O_COLS;
  const int tid = otid(), lane = tid & 63, wave = tid >> 6, l15 = lane & 15, g = lane >> 4;
  u16* AL = (u16*)dynsmem;
  const int tok0 = unit * 32;
#pragma unroll 5
  for (int idx = tid; idx < 32 * 320; idx += 512) {
    int i = idx / 320, j = idx % 320;
    int t = tok0 + i; int s = t & (S_ - 1);
    unsigned o = ((unsigned)t * (unsigned)NCP + (unsigned)(C_RW + 3072 + j)) * 2u;
    float v = rw_shift2(colsb, p.rw_mu[3072 + j], o, s);
    if (j < 128) v = tanh_(v);
    else if (j >= 192) v = sigm(v);
    AL[i * 328 + j] = f2bf(v);
  }
  __syncthreads();
  const u16* LWF = (const u16*)(ws + O_LWF);
  const u16* LWB = (const u16*)(ws + O_LWB);
  const u16* LA = (const u16*)(ws + O_LA);
  const u16* LG = (const u16*)(ws + O_LG);
#pragma unroll 1
  for (int hh = 0; hh < 2; ++hh) {
    const int head = wave * 2 + hh;
#pragma unroll 1
    for (int mt = 0; mt < 2; ++mt) {
      f32x4 awf[4], awb[4], aa[4], ag[4];
#pragma unroll
      for (int n = 0; n < 4; ++n) { awf[n] = f32x4{0, 0, 0, 0}; awb[n] = awf[n]; aa[n] = awf[n]; ag[n] = awf[n]; }
      const u16* arow = AL + (mt * 16 + l15) * 328 + 8 * g;
#pragma unroll
      for (int ks = 0; ks < 2; ++ks) {
        bf16x8 fwf = *(const bf16x8*)(arow + 32 * ks);
        bf16x8 fwb = *(const bf16x8*)(arow + 64 + 32 * ks);
        bf16x8 fa = *(const bf16x8*)(arow + 128 + 32 * ks);
#pragma unroll
        for (int n = 0; n < 4; ++n) {
          const unsigned bo = (unsigned)((head * 64 + l15 * 4 + n) * 64 + 32 * ks + 8 * g) * 2u;
          bf16x8 b1 = *(const bf16x8*)((const char*)LWF + bo);
          bf16x8 b2 = *(const bf16x8*)((const char*)LWB + bo);
          bf16x8 b3 = *(const bf16x8*)((const char*)LA + bo);
          awf[n] = MFMA16(fwf, b1, awf[n]);
          awb[n] = MFMA16(fwb, b2, awb[n]);
          aa[n] = MFMA16(fa, b3, aa[n]);
        }
        __builtin_amdgcn_sched_barrier(0);
      }
#pragma unroll
      for (int ks = 0; ks < 4; ++ks) {
        bf16x8 fg = *(const bf16x8*)(arow + 192 + 32 * ks);
#pragma unroll
        for (int n = 0; n < 4; ++n) {
          const unsigned bo = (unsigned)((head * 64 + l15 * 4 + n) * 128 + 32 * ks + 8 * g) * 2u;
          bf16x8 b4 = *(const bf16x8*)((const char*)LG + bo);
          ag[n] = MFMA16(fg, b4, ag[n]);
        }
        __builtin_amdgcn_sched_barrier(0);
      }
#pragma unroll 2
      for (int j = 0; j < 4; ++j) {
        int jo = j, zo = 0;
        asm volatile("" : "+v"(jo), "+v"(zo));
        const int t = tok0 + mt * 16 + 4 * g + jo;
        const int s = t & (S_ - 1), b = t >> 12;
        const unsigned c0 = (unsigned)(head * 64 + l15 * 4 + zo);
        const unsigned rowo = (unsigned)t * (unsigned)(NCP * 2) + (unsigned)(C_RW * 2) + c0 * 2u;
        float pr[4], pkr[4], pv[4];
        rw_shift4(colsb, *(const float4*)(p.rw_mu + c0), rowo, s, pr);
        rw_shift4(colsb, *(const float4*)(p.rw_mu + 1024u + c0), rowo + 2048u, s, pkr);
        rw_shift4(colsb, *(const float4*)(p.rw_mu + 2048u + c0), rowo + 4096u, s, pv);
        const float4 a0q = *(const float4*)(p.rw_a0 + c0), kkq = *(const float4*)(p.rw_k_k + c0);
        const float4 kaq = *(const float4*)(p.rw_k_a + c0), rkq = *(const float4*)(p.rw_r_k + c0);
        const float4 w0fq = *(const float4*)(p.rw_w0_f + c0), w0bq = *(const float4*)(p.rw_w0_b + c0);
        const float a0v[4] = {a0q.x, a0q.y, a0q.z, a0q.w}, kkp[4] = {kkq.x, kkq.y, kkq.z, kkq.w};
        const float kap[4] = {kaq.x, kaq.y, kaq.z, kaq.w}, rkp[4] = {rkq.x, rkq.y, rkq.z, rkq.w};
        const float w0f[4] = {w0fq.x, w0fq.y, w0fq.z, w0fq.w}, w0b[4] = {w0bq.x, w0bq.y, w0bq.z, w0bq.w};
        float pk[4], av[4], kkv[4];
        float n2 = 0.f, dot = 0.f;
#pragma unroll
        for (int n = 0; n < 4; ++n) {
          const float kraw = pkr[n];
          float a = sigm(a0v[n] + sel4(aa[n], j));
          av[n] = a;
          float kk = kraw * kkp[n];
          kkv[n] = kk;
          n2 += kk * kk;
          float k2 = kraw * (1.f + (a - 1.f) * kap[n]);
          pk[n] = k2;
          dot += pr[n] * k2 * rkp[n];
        }
        n2 = allred16(n2);
        dot = allred16(dot);
        const float inv = 1.f / fmaxf(sqrtf(n2), 1e-12f);
        const unsigned reco = ((unsigned)((b * 16 + head) * 4096 + s)) * 1024u;
        const unsigned tco = (unsigned)t * 2048u + c0 * 2u;
        unsigned hwf[4], hwb[4], ha[4], hb[4], hk[4], hr[4], hv[4], bg[4], bbn[4];
#pragma unroll
        for (int n = 0; n < 4; ++n) {
          float wf = __expf(-0.606531f * sigm(w0f[n] + sel4(awf[n], j)));
          float wb = __expf(-0.606531f * sigm(w0b[n] + sel4(awb[n], j)));
          float kkn = kkv[n] * inv;
          hwf[n] = f2h(wf); hwb[n] = f2h(wb); ha[n] = f2h(-kkn); hb[n] = f2h(kkn * av[n]);
          hk[n] = f2h(pk[n]); hr[n] = f2h(pr[n]); hv[n] = f2h(pv[n]);
          bg[n] = f2bf(sel4(ag[n], j)); bbn[n] = f2bf(dot * pv[n]);
        }
        char* rb = ws + O_REC + (reco + (unsigned)l15 * 64u);
        *(uint4*)(rb) = make_uint4(hwf[0] | (hwf[1] << 16), hwf[2] | (hwf[3] << 16), hwb[0] | (hwb[1] << 16), hwb[2] | (hwb[3] << 16));
        *(uint4*)(rb + 16) = make_uint4(ha[0] | (ha[1] << 16), ha[2] | (ha[3] << 16), hb[0] | (hb[1] << 16), hb[2] | (hb[3] << 16));
        *(uint4*)(rb + 32) = make_uint4(hk[0] | (hk[1] << 16), hk[2] | (hk[3] << 16), hr[0] | (hr[1] << 16), hr[2] | (hr[3] << 16));
        *(uint2*)(rb + 48) = make_uint2(hv[0] | (hv[1] << 16), hv[2] | (hv[3] << 16));
        *(uint2*)(ws + O_GRW + tco) = make_uint2(bg[0] | (bg[1] << 16), bg[2] | (bg[3] << 16));
        *(uint2*)(ws + O_BONUS + tco) = make_uint2(bbn[0] | (bbn[1] << 16), bbn[2] | (bbn[3] << 16));
      }
    }
  }
  __syncthreads();
}

DEVINL void phase2(const Params& p) {
  const int bid = blockIdx.x, nb = gridDim.x, tid = otid();
  for (int u = bid; u < 512; u += nb) gla_prep_unit(p, u);
  for (int u = bid; u < 256; u += nb) rw_prep_unit(p, u);
}

typedef unsigned u32x2 __attribute__((ext_vector_type(2)));
typedef unsigned u32x4 __attribute__((ext_vector_type(4)));
template <int DIR>
DEVINL void rwkv_scan_dir(const Params& p, int task, int lane, int wave) {
  const int b = (task >> 8) & 1, head = (task >> 4) & 15, rg = task & 15;
  const int seg = lane & 15, rl = lane >> 4, row = rg * 4 + rl;
  constexpr int DIST = 24;
  constexpr int WOFS = DIR ? 8 : 0;
  const char* recbase = p.ws + O_REC + ((long)(b * 16 + head) * 4096) * 1024 + lane * 16;
  const unsigned ring_lds = (unsigned)(unsigned long)(__attribute__((address_space(3))) char*)(dynsmem + wave * 32768);
  const unsigned ring_u = __builtin_amdgcn_readfirstlane(ring_lds);
  const unsigned a_seg = ring_lds + seg * 64;
  const unsigned a_v = ring_lds + (row >> 2) * 64 + 48 + (row & 3) * 2;
  u16* yo = (u16*)(p.ws + (DIR ? O_YB : O_YSUM)) + ((long)b * 4096) * 1024 + head * 64 + row;
  float s0 = 0.f, s1 = 0.f, s2 = 0.f, s3 = 0.f;
  float ykeep = 0.f;
  const char* recdir = recbase + (DIR ? (long)4095 * 1024 : 0);
#define RW_GPTR(q_, gp_) const char* gp_ = recdir + (DIR ? -(long)(q_) * 1024 : (long)(q_) * 1024);
#define RW_DMA_ONLY(q_) do { RW_GPTR(q_, gp_) unsigned keep_; const unsigned ld_ = ring_u + ((q_) & 31) * 1024; \
    asm volatile("s_mov_b32 %0, m0\n\ts_mov_b32 m0, %2\n\ts_nop 0\n\tglobal_load_lds_dwordx4 %1, off\n\ts_mov_b32 m0, %0" \
                 : "=&s"(keep_) : "v"(gp_), "s"(ld_) : "memory"); } while (0)
#define RW_READ(U1, WN, XN, KN, VN, VMC) do { \
    asm volatile("s_waitcnt vmcnt(" #VMC ")\n\t" \
                 "ds_read_b64 %0, %4 offset:%6\n\t" \
                 "ds_read_b128 %1, %4 offset:%7\n\t" \
                 "ds_read_b128 %2, %4 offset:%8\n\t" \
                 "ds_read_u16 %3, %5 offset:%9" \
                 : "=&v"(WN), "=&v"(XN), "=&v"(KN), "=&v"(VN) \
                 : "v"(a_seg), "v"(a_v), \
                   "i"(((U1) & 31) * 1024 + WOFS), "i"(((U1) & 31) * 1024 + 16), "i"(((U1) & 31) * 1024 + 32), "i"(((U1) & 31) * 1024) \
                 : "memory"); } while (0)
#define RW_LANDED(WN, XN, KN, VN) asm volatile("s_waitcnt lgkmcnt(0)" : "+v"(WN), "+v"(XN), "+v"(KN), "+v"(VN) :: "memory")
#define FMX "op_sel_hi:[0,1,0]"
#define FHH "op_sel_hi:[1,1,0]"
#define DPPX " row_mask:0xf bank_mask:0xf bound_ctrl:1"
#define RW_STEP(U, WC, XC, KC, VC, WN, XN, KN, VN) do { \
    RW_GPTR(st + (U) + DIST, gp_) \
    const unsigned ld_ = ring_u + (((U) + DIST) & 31) * 1024; \
    float pa_, pb_, t0_, t1_, t2_, t3_, sa_; \
    asm volatile( \
      "s_mov_b32 m0, %[ld]\n\t" \
      "s_nop 0\n\t" \
      "global_load_lds_dwordx4 %[gp], off\n\t" \
      "s_waitcnt vmcnt(23)\n\t" \
      "ds_read_b64 %[wn], %[aseg] offset:%[o0]\n\t" \
      "ds_read_b128 %[xn], %[aseg] offset:%[o1]\n\t" \
      "ds_read_b128 %[kn], %[aseg] offset:%[o2]\n\t" \
      "ds_read_u16 %[vn], %[av] offset:%[o3]\n\t" \
      "v_fma_mix_f32 %[pa], %[s0], %[a01], 0 op_sel:[0,0,0] " FMX "\n\t" \
      "v_fma_mix_f32 %[pb], %[s2], %[a23], 0 op_sel:[0,0,0] " FMX "\n\t" \
      "v_fma_mix_f32 %[t0], %[s0], %[w01], 0 op_sel:[0,0,0] " FMX "\n\t" \
      "v_fma_mix_f32 %[pa], %[s1], %[a01], %[pa] op_sel:[0,1,0] " FMX "\n\t" \
      "v_fma_mix_f32 %[pb], %[s3], %[a23], %[pb] op_sel:[0,1,0] " FMX "\n\t" \
      "v_fma_mix_f32 %[t1], %[s1], %[w01], 0 op_sel:[0,1,0] " FMX "\n\t" \
      "v_fma_mix_f32 %[t2], %[s2], %[w23], 0 op_sel:[0,0,0] " FMX "\n\t" \
      "v_add_f32 %[sa], %[pa], %[pb]\n\t" \
      "v_add_f32_dpp %[yp], %[yp], %[yp] quad_perm:[1,0,3,2]" DPPX "\n\t" \
      "v_fma_mix_f32 %[t3], %[s3], %[w23], 0 op_sel:[0,1,0] " FMX "\n\t" \
      "v_fma_mix_f32 %[t0], %[vh], %[k01], %[t0] op_sel:[0,0,0] " FHH "\n\t" \
      "v_add_f32_dpp %[sa], %[sa], %[sa] quad_perm:[1,0,3,2]" DPPX "\n\t" \
      "v_add_f32_dpp %[yp], %[yp], %[yp] quad_perm:[2,3,0,1]" DPPX "\n\t" \
      "v_fma_mix_f32 %[t1], %[vh], %[k01], %[t1] op_sel:[0,1,0] " FHH "\n\t" \
      "v_fma_mix_f32 %[t2], %[vh], %[k23], %[t2] op_sel:[0,0,0] " FHH "\n\t" \
      "v_add_f32_dpp %[sa], %[sa], %[sa] quad_perm:[2,3,0,1]" DPPX "\n\t" \
      "v_add_f32_dpp %[yp], %[yp], %[yp] row_half_mirror" DPPX "\n\t" \
      "v_fma_mix_f32 %[t3], %[vh], %[k23], %[t3] op_sel:[0,1,0] " FHH "\n\t" \
      "v_add_f32_dpp %[sa], %[sa], %[sa] row_half_mirror" DPPX "\n\t" \
      "v_add_f32_dpp %[yp], %[yp], %[yp] row_mirror" DPPX "\n\t" \
      "v_cndmask_b32 %[yk], %[yk], %[yp], %[msk]\n\t" \
      "s_nop 0\n\t" \
      "v_add_f32_dpp %[sa], %[sa], %[sa] row_mirror" DPPX "\n\t" \
      "v_fma_mix_f32 %[s0], %[sa], %[b01], %[t0] op_sel:[0,0,0] " FMX "\n\t" \
      "v_fma_mix_f32 %[s1], %[sa], %[b01], %[t1] op_sel:[0,1,0] " FMX "\n\t" \
      "v_fma_mix_f32 %[s2], %[sa], %[b23], %[t2] op_sel:[0,0,0] " FMX "\n\t" \
      "v_fma_mix_f32 %[s3], %[sa], %[b23], %[t3] op_sel:[0,1,0] " FMX "\n\t" \
      "v_fma_mix_f32 %[pa], %[s0], %[r01], 0 op_sel:[0,0,0] " FMX "\n\t" \
      "v_fma_mix_f32 %[pb], %[s2], %[r23], 0 op_sel:[0,0,0] " FMX "\n\t" \
      "v_fma_mix_f32 %[pa], %[s1], %[r01], %[pa] op_sel:[0,1,0] " FMX "\n\t" \
      "v_fma_mix_f32 %[pb], %[s3], %[r23], %[pb] op_sel:[0,1,0] " FMX "\n\t" \
      "v_add_f32 %[yp], %[pa], %[pb]\n\t" \
      "s_waitcnt lgkmcnt(0)" \
      : [wn]"=&v"(WN), [xn]"=&v"(XN), [kn]"=&v"(KN), [vn]"=&v"(VN), \
        [pa]"=&v"(pa_), [pb]"=&v"(pb_), [t0]"=&v"(t0_), [t1]"=&v"(t1_), [t2]"=&v"(t2_), [t3]"=&v"(t3_), [sa]"=&v"(sa_), \
        [s0]"+v"(s0), [s1]"+v"(s1), [s2]"+v"(s2), [s3]"+v"(s3), [yp]"+v"(ypart), [yk]"+v"(ykeep) \
      : [gp]"v"(gp_), [ld]"s"(ld_), [aseg]"v"(a_seg), [av]"v"(a_v), \
        [a01]"v"(XC.x), [a23]"v"(XC.y), [b01]"v"(XC.z), [b23]"v"(XC.w), \
        [k01]"v"(KC.x), [k23]"v"(KC.y), [r01]"v"(KC.z), [r23]"v"(KC.w), \
        [w01]"v"(WC.x), [w23]"v"(WC.y), [vh]"v"(VC), [msk]"s"(ymask[((U) + 15) & 15]), \
        [o0]"i"((((U) + 1) & 31) * 1024 + WOFS), [o1]"i"((((U) + 1) & 31) * 1024 + 16), \
        [o2]"i"((((U) + 1) & 31) * 1024 + 32), [o3]"i"((((U) + 1) & 31) * 1024) \
      : "memory"); } while (0)
#define RW_STEP2(B) RW_STEP(B, WvA, XA, KrA, vhA, WvB, XB, KrB, vhB); RW_STEP((B) + 1, WvB, XB, KrB, vhB, WvA, XA, KrA, vhA)
#define RW_STEP4(B) RW_STEP2(B); RW_STEP2((B) + 2)
#define RW_DMA4(B) RW_DMA_ONLY(B); RW_DMA_ONLY((B) + 1); RW_DMA_ONLY((B) + 2); RW_DMA_ONLY((B) + 3)
  unsigned long long ymask[16];
#pragma unroll
  for (int i = 0; i < 16; ++i) ymask[i] = __ballot(seg == i);
  u32x2 WvA, WvB; u32x4 XA, XB, KrA, KrB; unsigned vhA, vhB;
  RW_DMA4(0); RW_DMA4(4); RW_DMA4(8); RW_DMA4(12); RW_DMA4(16); RW_DMA4(20);
  RW_READ(0, WvA, XA, KrA, vhA, 23);
  RW_LANDED(WvA, XA, KrA, vhA);
  float ypart = 0.f;
#pragma unroll 1
  for (int st = 0; st < 4096; st += 32) {
    RW_STEP(0, WvA, XA, KrA, vhA, WvB, XB, KrB, vhB);
    if (st > 0) { const int q0 = st - 16 + seg; yo[(long)(DIR ? (4095 - q0) : q0) * 1024] = f2bf(ykeep); }
    RW_STEP(1, WvB, XB, KrB, vhB, WvA, XA, KrA, vhA);
    RW_STEP2(2); RW_STEP4(4); RW_STEP4(8); RW_STEP4(12);
    RW_STEP(16, WvA, XA, KrA, vhA, WvB, XB, KrB, vhB);
    { const int q0 = st + seg; yo[(long)(DIR ? (4095 - q0) : q0) * 1024] = f2bf(ykeep); }
    RW_STEP(17, WvB, XB, KrB, vhB, WvA, XA, KrA, vhA);
    RW_STEP2(18); RW_STEP4(20); RW_STEP4(24); RW_STEP4(28);
  }
  {
    const float ylast = allred16(ypart);
    ykeep = (seg == 15) ? ylast : ykeep;
    const int q0 = 4096 - 16 + seg; yo[(long)(DIR ? (4095 - q0) : q0) * 1024] = f2bf(ykeep);
  }
  asm volatile("s_waitcnt vmcnt(0)" ::: "memory");
#undef RW_READ
#undef RW_LANDED
#undef RW_STEP2
#undef RW_GPTR
#undef RW_DMA_ONLY
#undef RW_STEP
#undef RW_STEP4
#undef RW_DMA4
}
DEVINL void rwkv_scan_task(const Params& p, int task, int lane, int wave) {
  if (task >> 9) rwkv_scan_dir<1>(p, task, lane, wave);
  else rwkv_scan_dir<0>(p, task, lane, wave);
}

DEVINL void gla_scan_task(const Params& p, int task, int lane) {
  const int dir = task >> 7, b = (task >> 6) & 1, h = (task >> 4) & 3, vsl = task & 15;
  const int l15 = lane & 15, g = lane >> 4;
  const long hb = (long)(dir * 2 + b) * 4 + h;
  const u16* qt = (const u16*)(p.ws + O_QT) + hb * 4096 * 128 + l15 * 128 + 8 * g;
  const u16* kt = (const u16*)(p.ws + O_KT) + hb * 4096 * 128 + l15 * 128 + 8 * g;
  const u16* kdT = (const u16*)(p.ws + O_KDT) + hb * 64 * 128 * 64 + l15 * 64 + 8 * g;
  const u16* vT = (const u16*)(p.ws + O_VT) + ((long)b * 4 + h) * 64 * 256 * 64 + (16 * vsl + l15) * 64 + 8 * g;
  const float* dec = (const float*)(p.ws + O_DEC) + hb * 64 * 128 + 4 * g;
  u16* obuf = (u16*)(p.ws + O_OSUM) + (dir ? (long)T_ * 1024 : 0) + ((long)b * 4096) * 1024 + h * 256 + 16 * vsl + l15;
  f32x4 ST[8];
#pragma unroll
  for (int m = 0; m < 8; ++m) ST[m] = f32x4{0, 0, 0, 0};
  bf16x8 KF[4][4], VF[2], QF[4][4];
#define GL_LOAD_KV(KFx, VFx, c_) do { \
    _Pragma("unroll") for (int jt = 0; jt < 4; ++jt) _Pragma("unroll") for (int ks = 0; ks < 4; ++ks) \
      KFx[jt][ks] = ld16(kt + ((c_) * 64 + 16 * jt) * 128 + 32 * ks); \
    _Pragma("unroll") for (int s = 0; s < 2; ++s) VFx[s] = ld16(vT + (c_) * (256 * 64) + 32 * s); } while (0)
#define GL_LOAD_Q(it_, c_) do { \
    _Pragma("unroll") for (int ks = 0; ks < 4; ++ks) QF[it_][ks] = ld16(qt + ((c_) * 64 + 16 * (it_)) * 128 + 32 * ks); } while (0)
  {
    const int c0 = dir ? 63 : 0;
    GL_LOAD_KV(KF, VF, c0);
    GL_LOAD_Q(0, c0);
  }
  for (int cc = 0; cc < 64; ++cc) {
    const int c = dir ? 63 - cc : cc;
    const int tok0 = c * 64;
    GL_LOAD_Q(1, c); GL_LOAD_Q(2, c); GL_LOAD_Q(3, c);
    bf16x8 SBf[4];
#pragma unroll
    for (int ks = 0; ks < 4; ++ks) SBf[ks] = pack8(ST[2 * ks], ST[2 * ks + 1]);
    __builtin_amdgcn_sched_barrier(0);
#pragma unroll
    for (int it = 0; it < 4; ++it) {
      f32x4 X[4];
#pragma unroll
      for (int jt = 0; jt < 4; ++jt) {
        X[jt] = f32x4{0, 0, 0, 0};
        const bool need = dir ? (jt >= it) : (jt <= it);
        if (need) {
#pragma unroll
          for (int ks = 0; ks < 4; ++ks) X[jt] = MFMA16(KF[jt][ks], QF[it][ks], X[jt]);
          if (jt == it) {
#pragma unroll
            for (int r = 0; r < 4; ++r) {
              const int j = 4 * g + r;
              const bool keep = dir ? (j >= l15) : (j <= l15);
              if (!keep) X[jt][r] = 0.f;
            }
          }
        }
      }
      bf16x8 XA0 = pack8(X[0], X[1]), XA1 = pack8(X[2], X[3]);
      f32x4 O = f32x4{0, 0, 0, 0};
      O = MFMA16(XA0, VF[0], O);
      O = MFMA16(XA1, VF[1], O);
#pragma unroll
      for (int ks = 0; ks < 4; ++ks) O = MFMA16(QF[it][ks], SBf[ks], O);
      {
        const bool oddc = (l15 & 1) != 0;
        float lo[2], hi[2];
        xchg_pairs(O, oddc, lo, hi);
        u16* ob = obuf - (oddc ? 1 : 0) + (long)(tok0 + 16 * it + 4 * g + (oddc ? 2 : 0)) * 1024;
        *(unsigned*)(ob) = pk2(lo[0], hi[0]);
        *(unsigned*)(ob + 1024) = pk2(lo[1], hi[1]);
      }
    }
    __builtin_amdgcn_sched_barrier(0);
    bf16x8 KDF[8][2]; f32x4 Dv[8];
#pragma unroll
    for (int m = 0; m < 8; ++m) {
      Dv[m] = *(const f32x4*)(dec + c * 128 + 16 * m);
#pragma unroll
      for (int s = 0; s < 2; ++s) KDF[m][s] = ld16(kdT + (c * 128 + 16 * m) * 64 + 32 * s);
    }
    __builtin_amdgcn_sched_barrier(0);
#pragma unroll
    for (int m = 0; m < 4; ++m) {
      ST[m] = ST[m] * Dv[m];
      ST[m] = MFMA16(KDF[m][0], VF[0], ST[m]);
      ST[m] = MFMA16(KDF[m][1], VF[1], ST[m]);
    }
    __builtin_amdgcn_sched_barrier(0);
    const int cn = (cc < 63) ? (dir ? c - 1 : c + 1) : c;
    bf16x8 VFn[2];
    GL_LOAD_KV(KF, VFn, cn);
    GL_LOAD_Q(0, cn);
    __builtin_amdgcn_sched_barrier(0);
#pragma unroll
    for (int m = 4; m < 8; ++m) {
      ST[m] = ST[m] * Dv[m];
      ST[m] = MFMA16(KDF[m][0], VF[0], ST[m]);
      ST[m] = MFMA16(KDF[m][1], VF[1], ST[m]);
    }
    VF[0] = VFn[0]; VF[1] = VFn[1];
  }
#undef GL_LOAD_KV
#undef GL_LOAD_Q
}

DEVINL void phase3(const Params& p) {
  const int tid = otid(); const int wave = tid >> 6, lane = tid & 63;
  const int nb = gridDim.x;
  int vb = blockIdx.x;
  if ((nb & 7) == 0) vb = (blockIdx.x & 7) * (nb >> 3) + (blockIdx.x >> 3);
  if (wave < 4) {
    for (int task = vb * 4 + wave; task < 1024; task += nb * 4) rwkv_scan_task(p, task, lane, wave);
  } else if (wave == 4) {
    for (int task = vb; task < 256; task += nb) gla_scan_task(p, task, lane);
  }
}

DEVINL void phase4(const Params& p) {
  char* ws = p.ws;
  const int tid = otid();
  const int lane = tid & 63;
  const int gw = blockIdx.x * 8 + (tid >> 6), nw = gridDim.x * 8;
  const u16* cols = (const u16*)(ws + O_COLS);
  for (int u = gw; u < T_ * 4; u += nw) {
    const long t = u >> 2; const int h = u & 3;
    const int c = h * 256 + lane * 4;
    float4 o;
    {
      uint2 of = *(const uint2*)((const u16*)(ws + O_OSUM) + t * 1024 + c);
      uint2 ob = *(const uint2*)((const u16*)(ws + O_OSUM) + (long)T_ * 1024 + t * 1024 + c);
      o.x = bflo(of.x) + bflo(ob.x); o.y = bfhi(of.x) + bfhi(ob.x);
      o.z = bflo(of.y) + bflo(ob.y); o.w = bfhi(of.y) + bfhi(ob.y);
    }
    float ss = o.x * o.x + o.y * o.y + o.z * o.z + o.w * o.w;
    ss = allred64(ss);
    const float rstd = rsqrtf(ss * (1.f / 256.f) + 1e-5f);
    float4 ng = *(const float4*)(p.gla_norm_g + c);
    uint2 gg = *(const uint2*)(cols + t * NCP + C_G + c);
    float g0 = bflo(gg.x), g1 = bfhi(gg.x), g2 = bflo(gg.y), g3 = bfhi(gg.y);
    float y0 = o.x * rstd * ng.x * (g0 * sigm(g0));
    float y1 = o.y * rstd * ng.y * (g1 * sigm(g1));
    float y2 = o.z * rstd * ng.z * (g2 * sigm(g2));
    float y3 = o.w * rstd * ng.w * (g3 * sigm(g3));
    *(uint2*)((u16*)(ws + O_YGLA) + t * 1024 + c) = make_uint2(pk2(y0, y1), pk2(y2, y3));
  }
  for (int u = gw; u < T_ * 4; u += nw) {
    const long t = u >> 2; const int hq = u & 3;
    const int c = (hq * 4 + (lane >> 4)) * 64 + (lane & 15) * 4;
    float4 y;
    {
      const uint2 y1 = *(const uint2*)((const u16*)(ws + O_YSUM) + t * 1024 + c);
      const uint2 y2 = *(const uint2*)((const u16*)(ws + O_YB) + t * 1024 + c);
      y.x = bflo(y1.x) + bflo(y2.x); y.y = bfhi(y1.x) + bfhi(y2.x);
      y.z = bflo(y1.y) + bflo(y2.y); y.w = bfhi(y1.y) + bfhi(y2.y);
    }
    float mu = allred16(y.x + y.y + y.z + y.w) * (1.f / 64.f);
    float d0 = y.x - mu, d1 = y.y - mu, d2 = y.z - mu, d3 = y.w - mu;
    float var = allred16(d0 * d0 + d1 * d1 + d2 * d2 + d3 * d3) * (1.f / 64.f);
    const float rstd = rsqrtf(var + 64e-5f);
    float4 lg = *(const float4*)(p.rw_ln_g + c);
    float4 lb = *(const float4*)(p.rw_ln_b + c);
    uint2 bo = *(const uint2*)((const u16*)(ws + O_BONUS) + t * 1024 + c);
    uint2 gg = *(const uint2*)((const u16*)(ws + O_GRW) + t * 1024 + c);
    float r0 = (d0 * rstd * lg.x + lb.x + bflo(bo.x)) * bflo(gg.x);
    float r1 = (d1 * rstd * lg.y + lb.y + bfhi(bo.x)) * bfhi(gg.x);
    float r2 = (d2 * rstd * lg.z + lb.z + bflo(bo.y)) * bflo(gg.y);
    float r3 = (d3 * rstd * lg.w + lb.w + bfhi(bo.y)) * bfhi(gg.y);
    *(uint2*)((u16*)(ws + O_YRW) + t * 1024 + c) = make_uint2(pk2(r0, r1), pk2(r2, r3));
  }
}

DEVINL void phase5(const Params& p) {
  const u16* A1 = (const u16*)(p.ws + O_YGLA);
  const u16* A2 = (const u16*)(p.ws + O_YRW);
  const u16* B1 = (const u16*)(p.ws + O_WUPGT);
  const u16* B2 = (const u16*)(p.ws + O_WUPRT);
  for (int t = blockIdx.x; t < 256; t += gridDim.x) {
    int pm = t & 31, pn = t >> 5;
    gemm_tile<EPI_M1, false>(p, A1, 1024, nullptr, B1, 1024, 1024, pm * 256, pn * 256, pm * 256, pn * 256);
  }
  for (int t = blockIdx.x; t < 256; t += gridDim.x) {
    int pm = t & 31, pn = t >> 5;
    gemm_tile<EPI_MERGED, false>(p, A2, 1024, nullptr, B2, 1024, 1024, pm * 256, pn * 256, pm * 256, pn * 256);
  }
}
DEVINL void phase6(const Params& p) {
  const u16* A = (const u16*)(p.ws + O_MERGED);
  const u16* Bt = (const u16*)(p.ws + O_WOUTT);
  for (int t = blockIdx.x; t < 256; t += gridDim.x) {
    int pm = t & 31, pn = t >> 5;
    gemm_tile<EPI_R1, false>(p, A, 2048, nullptr, Bt, 2048, 2048, pm * 256, pn * 256, pm * 256, pn * 256);
  }
}

DEVINL void phase7(const Params& p) {
  char* ws = p.ws;
  const int tid = otid();
  const int lane = tid & 63;
  const int gw = blockIdx.x * 8 + (tid >> 6), nw = gridDim.x * 8;
  for (int row = gw; row < T_; row += nw) {
    const u16* r1 = (const u16*)(ws + O_R1) + (long)row * 2048;
    float4 v[8];
    float sum = 0.f;
#pragma unroll
    for (int i = 0; i < 8; ++i) {
      const uint2 q = *(const uint2*)(r1 + i * 256 + lane * 4);
      v[i] = make_float4(bflo(q.x), bfhi(q.x), bflo(q.y), bfhi(q.y));
      sum += v[i].x + v[i].y + v[i].z + v[i].w;
    }
    const float mu = allred64(sum) * (1.f / 2048.f);
    float sq = 0.f;
#pragma unroll
    for (int i = 0; i < 8; ++i) {
      v[i].x -= mu; v[i].y -= mu; v[i].z -= mu; v[i].w -= mu;
      sq += v[i].x * v[i].x + v[i].y * v[i].y + v[i].z * v[i].z + v[i].w * v[i].w;
    }
    const float rstd = rsqrtf(allred64(sq) * (1.f / 2048.f) + 1e-5f);
    float lg[16];
#pragma unroll
    for (int e = 0; e < 16; ++e) lg[e] = 0.f;
#pragma unroll
    for (int i = 0; i < 8; ++i) {
      const int c = i * 256 + lane * 4;
      float4 gq = *(const float4*)(p.ln1_g + c);
      float4 bq = *(const float4*)(p.ln1_b + c);
      float h0 = v[i].x * rstd * gq.x + bq.x, h1 = v[i].y * rstd * gq.y + bq.y;
      float h2 = v[i].z * rstd * gq.z + bq.z, h3 = v[i].w * rstd * gq.w + bq.w;
      *(uint2*)((u16*)(ws + O_HBF) + (long)row * 2048 + c) = make_uint2(pk2(h0, h1), pk2(h2, h3));
      const float hh[4] = {h0, h1, h2, h3};
#pragma unroll
      for (int q = 0; q < 4; ++q) {
        const float4* wr = (const float4*)(p.w_router + (long)(c + q) * 16);
#pragma unroll
        for (int e4 = 0; e4 < 4; ++e4) {
          float4 w = wr[e4];
          lg[e4 * 4 + 0] += hh[q] * w.x; lg[e4 * 4 + 1] += hh[q] * w.y;
          lg[e4 * 4 + 2] += hh[q] * w.z; lg[e4 * 4 + 3] += hh[q] * w.w;
        }
      }
    }
    float mx = -1e30f;
#pragma unroll
    for (int e = 0; e < 16; ++e) { lg[e] = allred64(lg[e]); mx = fmaxf(mx, lg[e]); }
    float den = 0.f;
#pragma unroll
    for (int e = 0; e < 16; ++e) { lg[e] = __expf(lg[e] - mx); den += lg[e]; }
    const float inv = 1.f / den;
    float mine = 0.f;
#pragma unroll
    for (int e = 0; e < 16; ++e) if (lane == e) mine = lg[e] * inv;
    if (lane < 16) {
      const int b = row >> 12, s = row & 4095;
      ((float*)(ws + O_AFF))[((long)(b * 16 + lane)) * 4096 + s] = mine;
      ((int*)(ws + O_INV))[row * 16 + lane] = -1;
    }
  }
}

DEVINL void phase8(const Params& p) {
  char* ws = p.ws;
  const int bid = blockIdx.x, nb = gridDim.x, tid = otid();
  for (int pr = bid; pr < 32; pr += nb) {
    const int b = pr >> 4, e = pr & 15;
    unsigned* cnt = (unsigned*)dynsmem;
    const float* aff = (const float*)(ws + O_AFF) + (long)pr * 4096;
    const int lane = tid & 63;
    unsigned key[8];
#pragma unroll
    for (int i = 0; i < 8; ++i) key[i] = __float_as_uint(aff[tid + 512 * i]);
    if (tid < 40) cnt[tid] = 0u;
    __syncthreads();
    unsigned T = 0u;
    for (int bit = 30; bit >= 0; --bit) {
      const unsigned cand = T | (1u << bit);
      int c = 0;
#pragma unroll
      for (int i = 0; i < 8; ++i) c += (key[i] >= cand) ? 1 : 0;
      const float cf = allred64((float)c);
      if (lane == 0) atomicAdd(&cnt[bit], (unsigned)cf);
      __syncthreads();
      if (cnt[bit] >= 512u) T = cand;
    }
    {
      int c = 0;
#pragma unroll
      for (int i = 0; i < 8; ++i) c += (key[i] > T) ? 1 : 0;
      const float cf = allred64((float)c);
      if (lane == 0) atomicAdd(&cnt[31], (unsigned)cf);
      __syncthreads();
    }
    const unsigned ngt = cnt[31];
#pragma unroll
    for (int i = 0; i < 8; ++i) {
      int slot = -1;
      if (key[i] > T) slot = (int)atomicAdd(&cnt[32], 1u);
      else if (key[i] == T) { unsigned s2 = atomicAdd(&cnt[33], 1u); if (ngt + s2 < 512u) slot = (int)(ngt + s2); }
      if (slot >= 0) {
        ((int*)(ws + O_SELT))[e * 1024 + b * 512 + slot] = b * 4096 + tid + 512 * i;
        ((float*)(ws + O_SELG))[e * 1024 + b * 512 + slot] = __uint_as_float(key[i]);
        ((int*)(ws + O_INV))[(b * 4096 + tid + 512 * i) * 16 + e] = e * 1024 + b * 512 + slot;
      }
    }
    __syncthreads();
  }
  {
    unsigned* ticket = (unsigned*)(ws + O_BAR);
    volatile int* slot = (volatile int*)(dynsmem + 120000);
    for (;;) {
      if (tid == 0) *slot = (int)atomicAdd(ticket, 1u);
      __syncthreads();
      const int t = *slot;
      if (t >= 16 * 128 * 3) break;
      const int which = t / (16 * 128), r = t % (16 * 128), e = r >> 7, tt = r & 127;
      if (which < 2) {
        const float* src = (which ? p.w3 : p.w1) + (long)e * 2048 * 1024;
        int kt = tt & 31, ntile = tt >> 5;
        tr_tile(src, 1024, 1024, kt * 64, ntile * 256, (u16*)(ws + O_W13T) + (long)e * 2048 * 2048, 2048, 128, 256, which * 128);
      } else {
        const float* src = p.w2 + (long)e * 1024 * 2048;
        int kt = tt & 15, ntile = tt >> 4;
        tr_tile(src, 2048, 2048, kt * 64, ntile * 256, (u16*)(ws + O_W2T) + (long)e * 2048 * 1024, 1024, 1 << 30, 0, 0);
      }
    }
  }
}

DEVINL void phase9(const Params& p) {
  const u16* A = (const u16*)(p.ws + O_XE);
  for (int t = blockIdx.x; t < 512; t += gridDim.x) {
    const int e = ((t >> 8) << 3) + (t & 7), pm = (t >> 3) & 3, pn = (t >> 5) & 7;
    const u16* Bt = (const u16*)(p.ws + O_W13T) + (long)e * 2048 * 2048;
    gemm_tile<EPI_HID, true>(p, (const u16*)(p.ws + O_HBF), 2048, (const int*)(p.ws + O_SELT), Bt, 2048, 2048, e * 1024 + pm * 256, pn * 256, e * 1024 + pm * 256, pn * 128);
  }
}
DEVINL void phase10(const Params& p) {
  const u16* A = (const u16*)(p.ws + O_HID);
  for (int t = blockIdx.x; t < 512; t += gridDim.x) {
    const int e = ((t >> 8) << 3) + (t & 7), pm = (t >> 3) & 3, pn = (t >> 5) & 7;
    const u16* Bt = (const u16*)(p.ws + O_W2T) + (long)e * 2048 * 1024;
    gemm_tile<EPI_MOE2, false>(p, A, 1024, nullptr, Bt, 1024, 1024, e * 1024 + pm * 256, pn * 256, e * 1024 + pm * 256, pn * 256);
  }
}

DEVINL void phase11(const Params& p) {
  const int tid = otid();
  const int lane = tid & 63;
  const int gw = blockIdx.x * 8 + (tid >> 6), nw = gridDim.x * 8;
  for (int row = gw; row < T_; row += nw) {
    const u16* hb = (const u16*)(p.ws + O_HBF) + (long)row * 2048;
    float4 v[8];
    float sum = 0.f;
#pragma unroll
    for (int i = 0; i < 8; ++i) {
      const uint2 q = *(const uint2*)(hb + i * 256 + lane * 4);
      v[i] = make_float4(ALPHA * bflo(q.x), ALPHA * bfhi(q.x), ALPHA * bflo(q.y), ALPHA * bfhi(q.y));
    }
    {
      const int* inv = (const int*)(p.ws + O_INV) + row * 16;
      const int myinv = inv[lane & 15];
#pragma unroll 1
      for (int e = 0; e < 16; ++e) {
        const int er = __shfl(myinv, e);
        if (er >= 0) {
          const u16* eo = (const u16*)(p.ws + O_EO) + (long)er * 2048 + lane * 4;
#pragma unroll
          for (int i = 0; i < 8; ++i) {
            uint2 q = *(const uint2*)(eo + i * 256);
            v[i].x += bflo(q.x); v[i].y += bfhi(q.x); v[i].z += bflo(q.y); v[i].w += bfhi(q.y);
          }
        }
      }
    }
#pragma unroll
    for (int i = 0; i < 8; ++i) sum += v[i].x + v[i].y + v[i].z + v[i].w;
    const float mu = allred64(sum) * (1.f / 2048.f);
    float sq = 0.f;
#pragma unroll
    for (int i = 0; i < 8; ++i) {
      v[i].x -= mu; v[i].y -= mu; v[i].z -= mu; v[i].w -= mu;
      sq += v[i].x * v[i].x + v[i].y * v[i].y + v[i].z * v[i].z + v[i].w * v[i].w;
    }
    const float rstd = rsqrtf(allred64(sq) * (1.f / 2048.f) + 1e-5f);
#pragma unroll
    for (int i = 0; i < 8; ++i) {
      const int c = i * 256 + lane * 4;
      float4 gq = *(const float4*)(p.ln2_g + c);
      float4 bq = *(const float4*)(p.ln2_b + c);
      const f32x4 ov = {v[i].x * rstd * gq.x + bq.x, v[i].y * rstd * gq.y + bq.y, v[i].z * rstd * gq.z + bq.z, v[i].w * rstd * gq.w + bq.w};
      __builtin_nontemporal_store(ov, (f32x4*)(p.out + (long)row * 2048 + c));
    }
  }
}

#define XB_TMO      128
#define XB_XCNT(j)  (256  + 64 * (j))
#define XB_XSUB(j)  (1280 + 64 * (j))
#define XB_XGEN(j)  (2304 + 64 * (j))
#define XB_TOP      3328
#define XB_TOPGEN   3392
#define XCD_BAR_WORDS 3456
#define XB_SPIN_CAP (1u << 20)
#define LAS __attribute__((address_space(3)))
DEVINL unsigned xb_ld(unsigned* p_) { return __hip_atomic_load(p_, __ATOMIC_RELAXED, __HIP_MEMORY_SCOPE_AGENT); }
DEVINL unsigned xb_add(unsigned* p_, unsigned v) { return __hip_atomic_fetch_add(p_, v, __ATOMIC_RELAXED, __HIP_MEMORY_SCOPE_AGENT); }
DEVINL unsigned xb_xcc_id() { return (unsigned)__builtin_amdgcn_s_getreg((3 << 11) | 20) & 0xFu; }
#define XB_SPIN(cond, bar) do { unsigned _sp = 0; while (cond) { __builtin_amdgcn_s_sleep(1); \
    if ((++_sp & 255u) == 0u) { if (xb_ld(&(bar)[XB_TMO])) break; if (_sp > XB_SPIN_CAP) { atomicAdd(&(bar)[XB_TMO], 1u); break; } } } } while (0)
struct XcdBarrier { unsigned* bar; unsigned x; volatile LAS unsigned* st; };
DEVINL XcdBarrier xcd_barrier_post(unsigned* bar, volatile LAS unsigned* st) {
  XcdBarrier b; b.bar = bar; b.x = xb_xcc_id(); b.st = st;
  if (threadIdx.x == 0) (void)xb_add(&bar[XB_XCNT(b.x)], 1u);
  return b;
}
DEVINL void xcd_barrier_complete(unsigned* bar, unsigned x, unsigned& nloc, unsigned& nx) {
  const unsigned G = gridDim.x * gridDim.y * gridDim.z;
  unsigned sum, cnt, mine, sp = 0u;
  for (;;) {
    sum = 0u; cnt = 0u; mine = 0u;
#pragma unroll
    for (unsigned j = 0; j < 16; ++j) { const unsigned c = xb_ld(&bar[XB_XCNT(j)]); sum += c; cnt += (c > 0u) ? 1u : 0u; mine = (j == x) ? c : mine; }
    if (sum == G) break;
    __builtin_amdgcn_s_sleep(1);
    if ((++sp & 255u) == 0u) { if (xb_ld(&bar[XB_TMO])) break; if (sp > XB_SPIN_CAP) { atomicAdd(&bar[XB_TMO], 1u); break; } }
  }
  nloc = mine > 0u ? mine : 1u; nx = cnt > 0u ? cnt : 1u;
}
DEVINL void xcd_barrier(const XcdBarrier& b) {
  asm volatile("s_waitcnt vmcnt(0)" ::: "memory");
  __syncthreads();
  if (threadIdx.x == 0) {
    unsigned* bar = b.bar;
    __builtin_amdgcn_s_waitcnt(0);
    unsigned nloc = b.st[0], nx = b.st[1];
    if (nloc == 0u) { xcd_barrier_complete(bar, b.x, nloc, nx); b.st[0] = nloc; b.st[1] = nx; }
    const unsigned old = xb_add(&bar[XB_XSUB(b.x)], 1u);
    const unsigned gen = old / nloc;
    if (old + 1u == (gen + 1u) * nloc) {
      __builtin_amdgcn_fence(__ATOMIC_RELEASE, "agent");
      asm volatile("s_waitcnt vmcnt(0)" ::: "memory");
      const unsigned og = xb_add(&bar[XB_TOP], 1u);
      const unsigned tg = og / nx;
      if (og + 1u == (tg + 1u) * nx) xb_add(&bar[XB_TOPGEN], 1u);
      else XB_SPIN(xb_ld(&bar[XB_TOPGEN]) == tg, bar);
      __builtin_amdgcn_fence(__ATOMIC_ACQUIRE, "agent");
      xb_add(&bar[XB_XGEN(b.x)], 1u);
      asm volatile("s_waitcnt vmcnt(0)" ::: "memory");
    } else {
      XB_SPIN(xb_ld(&bar[XB_XGEN(b.x)]) == gen, bar);
      __builtin_amdgcn_fence(__ATOMIC_ACQUIRE, "agent");
      asm volatile("s_waitcnt vmcnt(0)" ::: "memory");
    }
  }
  __syncthreads();
}

template <int PH> DEVINL void run_phase(const Params& p) {
  if (PH == 0) phase0(p);
  else if (PH == 1) phase1(p);
  else if (PH == 2) phase2(p);
  else if (PH == 3) phase3(p);
  else if (PH == 4) phase4(p);
  else if (PH == 5) phase5(p);
  else if (PH == 6) phase6(p);
  else if (PH == 7) phase7(p);
  else if (PH == 8) phase8(p);
  else if (PH == 9) phase9(p);
  else if (PH == 10) phase10(p);
  else if (PH == 11) phase11(p);
}

constexpr int SHM_BYTES = 131072;

#if MULTI
template <int PH> __global__ void __launch_bounds__(512, 2) k_phase(Params p) { run_phase<PH>(p); }
template <int PH> static void launch_phase(const Params& p, hipStream_t stream) {
  hipFuncSetAttribute((const void*)k_phase<PH>, hipFuncAttributeMaxDynamicSharedMemorySize, SHM_BYTES);
  k_phase<PH><<<256, 512, SHM_BYTES, stream>>>(p);
}
#else
__global__ void __launch_bounds__(512, 2) k_mega(Params p) {
  cg::grid_group grid = cg::this_grid();
  __shared__ uint4 xb_words;
  unsigned* bar = (unsigned*)(p.ws + O_BAR);
  if (threadIdx.x == 0) xb_words = make_uint4(0u, 0u, 0u, 0u);
  __syncthreads();
  XcdBarrier xb = xcd_barrier_post(bar, (volatile LAS unsigned*)&xb_words);
  if (p.out == nullptr) grid.sync();
  run_phase<0>(p); xcd_barrier(xb);
  run_phase<1>(p); xcd_barrier(xb);
  run_phase<2>(p); xcd_barrier(xb);
  run_phase<3>(p); xcd_barrier(xb);
  run_phase<4>(p); xcd_barrier(xb);
  run_phase<5>(p); xcd_barrier(xb);
  run_phase<6>(p); xcd_barrier(xb);
  run_phase<7>(p); xcd_barrier(xb);
  run_phase<8>(p); xcd_barrier(xb);
  run_phase<9>(p); xcd_barrier(xb);
  run_phase<10>(p); xcd_barrier(xb);
  run_phase<11>(p);
}
#endif

extern "C" void kernel_launch(void* const* d_in, const int* in_sizes, int n_in, void* d_out, int out_size,
                              void* d_ws, size_t ws_size, hipStream_t stream) {
  Params p{};
  const float** f = (const float**)&p;
  for (int i = 0; i < 31; ++i) f[i] = (const float*)d_in[i];
  p.out = (float*)d_out;
  p.ws = (char*)d_ws;
  if (ws_size < WS_NEED) { fprintf(stderr, "workspace too small: %zu < %zu\n", ws_size, (size_t)WS_NEED); return; }
#if MULTI
  launch_phase<0>(p, stream); launch_phase<1>(p, stream); launch_phase<2>(p, stream); launch_phase<3>(p, stream);
  launch_phase<4>(p, stream); launch_phase<5>(p, stream); launch_phase<6>(p, stream); launch_phase<7>(p, stream);
  launch_phase<8>(p, stream); launch_phase<9>(p, stream); launch_phase<10>(p, stream); launch_phase<11>(p, stream);
#else
  static int grid_blocks = 0;
  if (!grid_blocks) {
    int dev = 0, cus = 0, per_cu = 0;
    hipGetDevice(&dev);
    hipDeviceGetAttribute(&cus, hipDeviceAttributeMultiprocessorCount, dev);
    hipFuncSetAttribute((const void*)k_mega, hipFuncAttributeMaxDynamicSharedMemorySize, SHM_BYTES);
    hipOccupancyMaxActiveBlocksPerMultiprocessor(&per_cu, k_mega, 512, SHM_BYTES);
    if (per_cu < 1) per_cu = 1;
    grid_blocks = cus * per_cu;
    if (grid_blocks > 256) grid_blocks = 256;
  }
  hipMemsetAsync((char*)d_ws + O_BAR, 0, XCD_BAR_WORDS * sizeof(unsigned), stream);
  void* args[] = {&p};
  hipError_t e = hipLaunchCooperativeKernel((void*)k_mega, dim3(grid_blocks), dim3(512), args, SHM_BYTES, stream);
  if (e != hipSuccess) fprintf(stderr, "cooperative launch failed: %s (grid %d)\n", hipGetErrorString(e), grid_blocks);
#endif
}
```

```cpp
#include <hip/hip_runtime.h>
#include <hip/hip_cooperative_groups.h>
#include <cstdio>
namespace cg = cooperative_groups;

#ifndef MULTI
#define MULTI 0
#endif

typedef unsigned short u16;
typedef __bf16 bf2_t __attribute__((ext_vector_type(2)));
typedef float f2_t __attribute__((ext_vector_type(2)));
using bf16x8 = __attribute__((ext_vector_type(8))) short;
using s16x4 = __attribute__((ext_vector_type(4))) short;
using f32x4 = __attribute__((ext_vector_type(4))) float;
#define DEVINL __device__ __forceinline__

constexpr int T_ = 8192, S_ = 4096, D_ = 2048, NC = 10592, NCP = 10752;
constexpr int C_Q = 0, C_K = 512, C_V = 1024, C_G = 2048, C_AF = 3072, C_RW = 3104;
constexpr int C_GG = 6496, C_GR = 8544;
constexpr float ALPHA = 1.189207115f;

constexpr size_t MB = 1ull << 20;
constexpr size_t O_XBF = 0;
constexpr size_t O_WINT = 32 * MB;
constexpr size_t O_OSUM = 0;
constexpr size_t O_YSUM = 32 * MB;
constexpr size_t O_R1 = 0;
constexpr size_t O_COLS = 76 * MB;
constexpr size_t O_ACC2 = 76 * MB;
constexpr size_t O_W13T = 140 * MB;
constexpr size_t O_W2T = 268 * MB;
constexpr size_t O_HID = 332 * MB;
constexpr size_t O_REC = 244 * MB;
constexpr size_t O_YGLA = 244 * MB;
constexpr size_t O_YRW = 260 * MB;
constexpr size_t O_MERGED = 276 * MB;
constexpr size_t O_QT = 372 * MB;
constexpr size_t O_KT = 388 * MB;
constexpr size_t O_KDT = 404 * MB;
constexpr size_t O_VT = 420 * MB;
constexpr size_t O_DEC = 436 * MB;
constexpr size_t O_M1 = 372 * MB;
constexpr size_t O_HBF = 372 * MB;
constexpr size_t O_XE = 404 * MB;
constexpr size_t O_VSCAN = 437 * MB;
constexpr size_t O_GRW = 453 * MB;
constexpr size_t O_BONUS = 469 * MB;
constexpr size_t O_WUPGT = 485 * MB;
constexpr size_t O_WUPRT = 489 * MB;
constexpr size_t O_WOUTT = 493 * MB;
constexpr size_t O_LWF = 501 * MB;
constexpr size_t O_LWB = O_LWF + 128 * 1024;
constexpr size_t O_LA = O_LWB + 128 * 1024;
constexpr size_t O_LG = O_LA + 128 * 1024;
constexpr size_t O_AFF = 502 * MB;
constexpr size_t O_SELT = O_AFF + 512 * 1024;
constexpr size_t O_SELG = O_SELT + 64 * 1024;
constexpr size_t O_YB = 503 * MB;
constexpr size_t O_EO = 140 * MB;
constexpr size_t O_INV = 535 * MB;
constexpr size_t O_BAR = 535 * MB + 768 * 1024;
constexpr size_t WS_NEED = 536 * MB;

struct Params {
  const float *x, *w_in, *gla_a_up_f, *gla_a_bias_f, *gla_a_up_b, *gla_a_bias_b, *gla_norm_g;
  const float *rw_mu, *rw_w0_f, *rw_w_up_f, *rw_w0_b, *rw_w_up_b, *rw_a0, *rw_a_up, *rw_g_up;
  const float *rw_k_k, *rw_k_a, *rw_r_k, *rw_ln_g, *rw_ln_b, *w_up_gla, *w_up_rwkv, *w_out;
  const float *ln1_g, *ln1_b, *w_router, *w1, *w3, *w2, *ln2_g, *ln2_b;
  float* out;
  char* ws;
};

DEVINL unsigned pk2(float a, float b) {
  f2_t v = {a, b};
  bf2_t r = __builtin_convertvector(v, bf2_t);
  return *(unsigned*)&r;
}
DEVINL u16 f2bf(float a) { return (u16)(pk2(a, 0.f) & 0xffffu); }
DEVINL float bf2f(u16 h) { return __uint_as_float(((unsigned)h) << 16); }
DEVINL float bflo(unsigned u) { return __uint_as_float(u << 16); }
DEVINL float bfhi(unsigned u) { return __uint_as_float(u & 0xffff0000u); }
DEVINL float sigm(float x) { return 1.f / (1.f + __expf(-x)); }
DEVINL float tanh_(float x) { return 1.f - 2.f / (__expf(2.f * x) + 1.f); }
DEVINL float logsig(float z) { return fminf(z, 0.f) - __logf(1.f + __expf(-fabsf(z))); }
template <int CTRL> DEVINL float dppf(float x) {
  return __int_as_float(__builtin_amdgcn_update_dpp(0, __float_as_int(x), CTRL, 0xF, 0xF, true));
}
DEVINL float allred16(float x) {
  x += dppf<0xB1>(x); x += dppf<0x4E>(x); x += dppf<0x141>(x); x += dppf<0x140>(x);
  return x;
}
DEVINL void allred16x2(float& a, float& b) {
  a += dppf<0xB1>(a); b += dppf<0xB1>(b);
  a += dppf<0x4E>(a); b += dppf<0x4E>(b);
  a += dppf<0x141>(a); b += dppf<0x141>(b);
  a += dppf<0x140>(a); b += dppf<0x140>(b);
}
DEVINL float allred64(float x) {
  x = allred16(x);
  x += __int_as_float(__builtin_amdgcn_update_dpp(0, __float_as_int(x), 0x142, 0xA, 0xF, false));
  x += __int_as_float(__builtin_amdgcn_update_dpp(0, __float_as_int(x), 0x143, 0xC, 0xF, false));
  return __int_as_float(__builtin_amdgcn_readlane(__float_as_int(x), 63));
}
DEVINL bf16x8 mk8(s16x4 lo, s16x4 hi) {
  bf16x8 r;
  r[0] = lo[0]; r[1] = lo[1]; r[2] = lo[2]; r[3] = lo[3];
  r[4] = hi[0]; r[5] = hi[1]; r[6] = hi[2]; r[7] = hi[3];
  return r;
}
DEVINL bf16x8 pack8(f32x4 a, f32x4 b) {
  union { bf16x8 v; unsigned u[4]; } r;
  r.u[0] = pk2(a[0], a[1]); r.u[1] = pk2(a[2], a[3]);
  r.u[2] = pk2(b[0], b[1]); r.u[3] = pk2(b[2], b[3]);
  return r.v;
}
DEVINL int fragpos(int idx) { const int w = idx & 31; return (idx & ~31) + (((w & 15) >> 2) << 3) + (w & 3) + ((w >> 4) << 2); }
DEVINL bf16x8 ld16(const u16* base) { return *(const bf16x8*)base; }
DEVINL bf16x8 ldfrag(const u16* base) {
  s16x4 lo = *(const s16x4*)base;
  s16x4 hi = *(const s16x4*)(base + 16);
  return mk8(lo, hi);
}
DEVINL float sel4(f32x4 v, int j) { return j == 0 ? v[0] : (j == 1 ? v[1] : (j == 2 ? v[2] : v[3])); }
DEVINL u16 f2h(float a) { _Float16 h = (_Float16)a; return __builtin_bit_cast(u16, h); }
DEVINL float fmix_lo(float s, unsigned h, float c) {
  float d; asm("v_fma_mix_f32 %0, %1, %2, %3 op_sel:[0,0,0] op_sel_hi:[0,1,0]" : "=v"(d) : "v"(s), "v"(h), "v"(c)); return d;
}
DEVINL float fmix_hi(float s, unsigned h, float c) {
  float d; asm("v_fma_mix_f32 %0, %1, %2, %3 op_sel:[0,1,0] op_sel_hi:[0,1,0]" : "=v"(d) : "v"(s), "v"(h), "v"(c)); return d;
}
DEVINL float fmixhh_lo(unsigned vh, unsigned h, float c) {
  float d; asm("v_fma_mix_f32 %0, %1, %2, %3 op_sel:[0,0,0] op_sel_hi:[1,1,0]" : "=v"(d) : "v"(vh), "v"(h), "v"(c)); return d;
}
DEVINL float fmixhh_hi(unsigned vh, unsigned h, float c) {
  float d; asm("v_fma_mix_f32 %0, %1, %2, %3 op_sel:[0,1,0] op_sel_hi:[1,1,0]" : "=v"(d) : "v"(vh), "v"(h), "v"(c)); return d;
}
DEVINL float fmul_hi(float s, unsigned h) {
  float d; asm("v_fma_mix_f32 %0, %1, %2, 0 op_sel:[0,1,0] op_sel_hi:[0,1,0]" : "=v"(d) : "v"(s), "v"(h)); return d;
}
DEVINL float fmul_lo(float s, unsigned h) {
  float d; asm("v_fma_mix_f32 %0, %1, %2, 0 op_sel:[0,0,0] op_sel_hi:[0,1,0]" : "=v"(d) : "v"(s), "v"(h)); return d;
}
#define MFMA16(a, b, c) __builtin_amdgcn_mfma_f32_16x16x32_bf16(a, b, c, 0, 0, 0)

extern __shared__ __attribute__((aligned(16))) char dynsmem[];
extern __shared__ __attribute__((aligned(16))) char dynsmem_rd[];
DEVINL int otid() { int t = threadIdx.x; asm volatile("" : "+v"(t)); return t; }

constexpr int BM = 256, BK = 64, HALF = 128, HT = HALF * BK;
DEVINL int lds_byte(int r, int c) {
  int st = (r >> 4) * 2 + (c >> 5), rr = r & 15, cc = c & 31, ob = rr * 64 + cc * 2;
  return st * 1024 + (ob ^ (((ob >> 9) & 1) << 5));
}
DEVINL void stage_rc(int b, int& R, int& C) {
  int st = b / 1024, sb = b % 1024, swz = sb ^ (((sb >> 9) & 1) << 5);
  R = (st >> 1) * 16 + swz / 64; C = (st & 1) * 32 + (swz % 64) / 2;
}

DEVINL void xchg_pairs(f32x4 v, bool odd, float (&lo)[2], float (&hi)[2]) {
  const float s0 = odd ? v[0] : v[2], s1 = odd ? v[1] : v[3];
  const float r0 = dppf<0xB1>(s0), r1 = dppf<0xB1>(s1);
  lo[0] = odd ? r0 : v[0]; hi[0] = odd ? v[2] : r0;
  lo[1] = odd ? r1 : v[1]; hi[1] = odd ? v[3] : r1;
}
enum { EPI_COLS = 0, EPI_M1, EPI_MERGED, EPI_R1, EPI_HID, EPI_MOE2 };

template <int EPI, bool GATHER>
DEVINL void gemm_tile(const Params& p, const u16* __restrict__ A, int lda, const int* __restrict__ rowidx,
                      const u16* __restrict__ Bt, int ldb, int K, int brow, int bcol, int orow, int ocol) {
  u16* shm = (u16*)dynsmem;
#define SA(b, h) (shm + ((b) * 2 + (h)) * HT)
#define SB(b, h) (shm + (4 + (b) * 2 + (h)) * HT)
  const int tid = otid();
  int offA[2][2], offB[2];
#pragma unroll
  for (int i = 0; i < 2; ++i) {
    int R, C; stage_rc(tid * 16 + i * 8192, R, C);
    offB[i] = R * ldb + C;
#pragma unroll
    for (int h = 0; h < 2; ++h) {
      if (GATHER) offA[h][i] = rowidx[brow + h * HALF + R] * lda + C;
      else offA[h][i] = R * lda + C;
    }
  }
  const u16* Ab[2]; const u16* Bb[2];
#pragma unroll
  for (int h = 0; h < 2; ++h) {
    Ab[h] = GATHER ? A : (A + (long)(brow + h * HALF) * lda);
    Bb[h] = Bt + (long)(bcol + h * HALF) * ldb;
  }
#define STAGE_A(b, h, kt) do { _Pragma("unroll") for (int _i = 0; _i < 2; ++_i) \
    __builtin_amdgcn_global_load_lds((const unsigned*)(Ab[h] + (kt) * BK + offA[GATHER ? h : 0][_i]), \
      (__attribute__((address_space(3))) unsigned*)((char*)SA(b, h) + tid * 16 + _i * 8192), 16, 0, 0); } while (0)
#define STAGE_B(b, h, kt) do { _Pragma("unroll") for (int _i = 0; _i < 2; ++_i) \
    __builtin_amdgcn_global_load_lds((const unsigned*)(Bb[h] + (kt) * BK + offB[_i]), \
      (__attribute__((address_space(3))) unsigned*)((char*)SB(b, h) + tid * 16 + _i * 8192), 16, 0, 0); } while (0)
#define LDA(dst, b, h) _Pragma("unroll") for (int m = 0; m < 4; ++m) _Pragma("unroll") for (int k = 0; k < 2; ++k) \
    dst[m][k] = *reinterpret_cast<const bf16x8*>((char*)SA(b, h) + lds_byte(wr * 64 + m * 16 + fr, k * 32 + fq * 8))
#define LDB(dst, b, h) _Pragma("unroll") for (int n = 0; n < 2; ++n) _Pragma("unroll") for (int k = 0; k < 2; ++k) \
    dst[n][k] = *reinterpret_cast<const bf16x8*>((char*)SB(b, h) + lds_byte(wc * 32 + n * 16 + fr, k * 32 + fq * 8))
#define MMA(ai, bj, At_, Bt_) do { __builtin_amdgcn_s_setprio(1); \
    _Pragma("unroll") for (int m = 0; m < 4; ++m) _Pragma("unroll") for (int n = 0; n < 2; ++n) _Pragma("unroll") for (int k = 0; k < 2; ++k) \
      acc[ai][bj][m][n] = MFMA16(At_[m][k], Bt_[n][k], acc[ai][bj][m][n]); \
    __builtin_amdgcn_s_setprio(0); } while (0)
#define WAIT_V(n) asm volatile("s_waitcnt vmcnt(" #n ")" ::: "memory")
#define WAIT_L(n) asm volatile("s_waitcnt lgkmcnt(" #n ")" ::: "memory")
#define BAR __builtin_amdgcn_s_barrier()
#define SCHED __builtin_amdgcn_sched_barrier(0)

  const int wid = tid >> 6, lane = tid & 63, wr = wid >> 2, wc = wid & 3, fr = lane & 15, fq = lane >> 4;
  f32x4 acc[2][2][4][2] = {};
  bf16x8 At[4][2], B0[2][2], B1[2][2];
  const int nt = K / BK;
  STAGE_B(0, 0, 0); STAGE_A(0, 0, 0);
  STAGE_B(0, 1, 0); STAGE_A(0, 1, 0);
  if (wr == 1) BAR;
  WAIT_V(4); BAR;
  STAGE_B(1, 0, 1); STAGE_A(1, 0, 1); STAGE_B(1, 1, 1);
  WAIT_V(6); BAR;
  for (int t = 0; t < nt - 2; t += 2) {
    LDB(B0, 0, 0); SCHED; LDA(At, 0, 0); STAGE_A(1, 1, t + 1);
    WAIT_L(8); BAR; WAIT_L(0); MMA(0, 0, At, B0); BAR; SCHED;
    LDB(B1, 0, 1); STAGE_B(0, 0, t + 2);
    BAR; WAIT_L(0); MMA(0, 1, At, B1); BAR;
    LDA(At, 0, 1); STAGE_A(0, 0, t + 2);
    BAR; WAIT_L(0); MMA(1, 0, At, B0); BAR; SCHED;
    STAGE_B(0, 1, t + 2);
    WAIT_V(6); BAR; MMA(1, 1, At, B1); BAR;
    LDB(B0, 1, 0); SCHED; LDA(At, 1, 0); STAGE_A(0, 1, t + 2);
    WAIT_L(8); BAR; WAIT_L(0); MMA(0, 0, At, B0); BAR; SCHED;
    LDB(B1, 1, 1); STAGE_B(1, 0, t + 3);
    BAR; WAIT_L(0); MMA(0, 1, At, B1); BAR;
    LDA(At, 1, 1); STAGE_A(1, 0, t + 3);
    BAR; WAIT_L(0); MMA(1, 0, At, B0); BAR; SCHED;
    STAGE_B(1, 1, t + 3);
    WAIT_V(6); BAR; MMA(1, 1, At, B1); BAR;
  }
  { LDB(B0, 0, 0); LDA(At, 0, 0); STAGE_A(1, 1, nt - 1);
    BAR; WAIT_L(0); MMA(0, 0, At, B0); BAR;
    LDB(B1, 0, 1); BAR; WAIT_L(0); MMA(0, 1, At, B1); BAR;
    LDA(At, 0, 1); WAIT_V(4); BAR; WAIT_L(0); MMA(1, 0, At, B0); MMA(1, 1, At, B1); BAR; }
  { LDB(B0, 1, 0); LDA(At, 1, 0); WAIT_V(2); BAR; WAIT_L(0); MMA(0, 0, At, B0); BAR;
    LDB(B1, 1, 1); WAIT_V(0); BAR; WAIT_L(0); MMA(0, 1, At, B1); BAR;
    LDA(At, 1, 1); BAR; WAIT_L(0); MMA(1, 0, At, B0); MMA(1, 1, At, B1); BAR; }
  if (wr == 0) BAR;

  char* ws = p.ws;
  const int row0 = orow + wr * 64 + fq * 4;
  const int col0 = ocol + wc * 32 + fr;
  const bool odd = (fr & 1) != 0;
  const int colp = col0 - (odd ? 1 : 0);
#pragma unroll
  for (int ai = 0; ai < 2; ++ai)
#pragma unroll
    for (int m = 0; m < 4; ++m) {
      const int rA = row0 + ai * HALF + m * 16 + (odd ? 2 : 0);
      float gate[2] = {0.f, 0.f};
      if (EPI == EPI_MOE2) { gate[0] = ((const float*)(ws + O_SELG))[rA]; gate[1] = ((const float*)(ws + O_SELG))[rA + 1]; }
#pragma unroll
      for (int bj = 0; bj < (EPI == EPI_HID ? 1 : 2); ++bj)
#pragma unroll
        for (int n = 0; n < 2; ++n) {
          const int cc = bj * HALF + n * 16;
          f32x4 v = acc[ai][bj][m][n];
          if (EPI == EPI_HID) {
#pragma unroll
            for (int j = 0; j < 4; ++j) { const float a1 = acc[ai][0][m][n][j], a3 = acc[ai][1][m][n][j]; v[j] = a1 * sigm(a1) * a3; }
          }
          float lo[2], hi[2];
          xchg_pairs(v, odd, lo, hi);
#pragma unroll
          for (int k = 0; k < 2; ++k) {
            const unsigned row = (unsigned)(rA + k);
            if (EPI == EPI_HID) {
              *(unsigned*)(ws + O_HID + (row * 1024u + (unsigned)(colp + cc)) * 2u) = pk2(lo[k], hi[k]);
            } else if (EPI == EPI_COLS) {
              *(unsigned*)(ws + O_COLS + (row * (unsigned)NCP + (unsigned)(colp + cc)) * 2u) = pk2(lo[k], hi[k]);
            } else if (EPI == EPI_MOE2) {
              *(unsigned*)(ws + O_EO + (row * 2048u + (unsigned)(colp + cc)) * 2u) = pk2(gate[k] * lo[k], gate[k] * hi[k]);
            } else if (EPI == EPI_M1) {
              const unsigned g2 = *(const unsigned*)(ws + O_COLS + (row * (unsigned)NCP + (unsigned)(C_GG + colp + cc)) * 2u);
              *(unsigned*)(ws + O_M1 + (row * 2048u + (unsigned)(colp + cc)) * 2u) = pk2(sigm(bflo(g2)) * lo[k], sigm(bfhi(g2)) * hi[k]);
            } else if (EPI == EPI_MERGED) {
              const unsigned g2 = *(const unsigned*)(ws + O_COLS + (row * (unsigned)NCP + (unsigned)(C_GR + colp + cc)) * 2u);
              const unsigned m1 = *(const unsigned*)(ws + O_M1 + (row * 2048u + (unsigned)(colp + cc)) * 2u);
              *(unsigned*)(ws + O_MERGED + (row * 2048u + (unsigned)(colp + cc)) * 2u) =
                  pk2(bflo(m1) + sigm(bflo(g2)) * lo[k], bfhi(m1) + sigm(bfhi(g2)) * hi[k]);
            } else if (EPI == EPI_R1) {
              const unsigned o4 = (row * 2048u + (unsigned)(colp + cc)) * 4u;
              const float2 xv = *(const float2*)((const char*)p.x + o4);
              *(unsigned*)(ws + O_R1 + (o4 >> 1)) = pk2(ALPHA * xv.x + lo[k], ALPHA * xv.y + hi[k]);
            }
          }
        }
      __builtin_amdgcn_sched_barrier(0);
    }
  __syncthreads();
#undef SA
#undef SB
}

DEVINL void tr_tile(const float* __restrict__ src, int ldsrc, int nvalid, int k0, int n0,
                    u16* __restrict__ dst, int lddst, int grp, int gstride, int goff) {
  float* tile = (float*)dynsmem;
  const int tid = otid();
  float4 v[8];
#pragma unroll
  for (int i = 0; i < 8; ++i) {
    int f = tid + i * 512; int r = f >> 6, c4 = (f & 63) * 4;
    int n = n0 + c4;
    v[i] = make_float4(0.f, 0.f, 0.f, 0.f);
    if (n < nvalid) {
      const f32x4 q = __builtin_nontemporal_load((const f32x4*)(src + (long)(k0 + r) * ldsrc + n));
      v[i] = make_float4(q[0], q[1], q[2], q[3]);
    }
  }
#pragma unroll
  for (int i = 0; i < 8; ++i) {
    int f = tid + i * 512; int r = f >> 6, c4 = (f & 63) * 4;
    float* tp = tile + r * 257 + c4;
    tp[0] = v[i].x; tp[1] = v[i].y; tp[2] = v[i].z; tp[3] = v[i].w;
  }
  __syncthreads();
  {
    const int n = tid >> 1, kc = (tid & 1) * 32;
    const float* tp = tile + kc * 257 + n;
    const int nn = n0 + n;
    const long row = (long)(nn / grp) * gstride + (nn % grp) + goff;
    uint4* dp = (uint4*)(dst + row * lddst + k0 + kc);
#pragma unroll
    for (int q = 0; q < 4; ++q) {
      uint4 o;
      o.x = pk2(tp[(q * 8 + 0) * 257], tp[(q * 8 + 1) * 257]);
      o.y = pk2(tp[(q * 8 + 2) * 257], tp[(q * 8 + 3) * 257]);
      o.z = pk2(tp[(q * 8 + 4) * 257], tp[(q * 8 + 5) * 257]);
      o.w = pk2(tp[(q * 8 + 6) * 257], tp[(q * 8 + 7) * 257]);
      dp[q] = o;
    }
  }
  __syncthreads();
}
DEVINL void tr_job(const float* src, int K, int N, int Npad, u16* dst, int bid, int nb) {
  const int tk = K / 64, tn = Npad / 256;
  for (int t = bid; t < tk * tn; t += nb) {
    int kt = t % tk, ntile = t / tk;
    tr_tile(src, N, N, kt * 64, ntile * 256, dst, K, 1 << 30, 0, 0);
  }
}

DEVINL void phase0(const Params& p) {
  char* ws = p.ws;
  const int bid = blockIdx.x, nb = gridDim.x, tid = otid();
  {
    const float4* xs = (const float4*)p.x;
    uint2* xd = (uint2*)(ws + O_XBF);
    const long n4 = (long)T_ * D_ / 4;
    const long stride = (long)nb * 512;
    for (long i = (long)bid * 512 + tid; i < n4; i += 4 * stride) {
      const f32x4* xq = (const f32x4*)xs;
      const f32x4 q0 = __builtin_nontemporal_load(xq + i), q1 = __builtin_nontemporal_load(xq + i + stride);
      const f32x4 q2 = __builtin_nontemporal_load(xq + i + 2 * stride), q3 = __builtin_nontemporal_load(xq + i + 3 * stride);
      float4 v0 = make_float4(q0[0], q0[1], q0[2], q0[3]), v1 = make_float4(q1[0], q1[1], q1[2], q1[3]);
      float4 v2 = make_float4(q2[0], q2[1], q2[2], q2[3]), v3 = make_float4(q3[0], q3[1], q3[2], q3[3]);
      xd[i] = make_uint2(pk2(v0.x, v0.y), pk2(v0.z, v0.w));
      xd[i + stride] = make_uint2(pk2(v1.x, v1.y), pk2(v1.z, v1.w));
      xd[i + 2 * stride] = make_uint2(pk2(v2.x, v2.y), pk2(v2.z, v2.w));
      xd[i + 3 * stride] = make_uint2(pk2(v3.x, v3.y), pk2(v3.z, v3.w));
    }
  }
  tr_job(p.w_in, 2048, NC, NCP, (u16*)(ws + O_WINT), bid, nb);
  tr_job(p.w_up_gla, 1024, 2048, 2048, (u16*)(ws + O_WUPGT), bid, nb);
  tr_job(p.w_up_rwkv, 1024, 2048, 2048, (u16*)(ws + O_WUPRT), bid, nb);
  tr_job(p.w_out, 2048, 2048, 2048, (u16*)(ws + O_WOUTT), bid, nb);
  tr_job(p.rw_w_up_f, 64, 1024, 1024, (u16*)(ws + O_LWF), bid, nb);
  tr_job(p.rw_w_up_b, 64, 1024, 1024, (u16*)(ws + O_LWB), bid, nb);
  tr_job(p.rw_a_up, 64, 1024, 1024, (u16*)(ws + O_LA), bid, nb);
  tr_job(p.rw_g_up, 128, 1024, 1024, (u16*)(ws + O_LG), bid, nb);
}

DEVINL void phase1(const Params& p) {
  const u16* A = (const u16*)(p.ws + O_XBF);
  const u16* Bt = (const u16*)(p.ws + O_WINT);
  const int ntiles = 32 * 42;
  for (int t = blockIdx.x; t < ntiles; t += gridDim.x) {
    int pm = t & 31, pn = t >> 5;
    gemm_tile<EPI_COLS, false>(p, A, 2048, nullptr, Bt, 2048, 2048, pm * 256, pn * 256, pm * 256, pn * 256);
  }
}

DEVINL void gla_prep_unit(const Params& p, int unit) {
  const int h = unit & 3, c = (unit >> 2) & 63, b = unit >> 8;
  char* ws = p.ws;
  const u16* cols = (const u16*)(ws + O_COLS);
  const int tid = otid();
  float* afab = (float*)dynsmem;
  float* G = (float*)(dynsmem + 8192);
  u16* KD = (u16*)(dynsmem + 8192 + 65536);
  u16* VL = (u16*)dynsmem;
  const long tok0 = (long)b * S_ + c * 64;
  for (int i = tid; i < 64 * 32; i += 512) {
    int r = i >> 5, cc = i & 31;
    afab[i] = bf2f(cols[(tok0 + r) * NCP + C_AF + cc]);
  }
  __syncthreads();
  if (tid < 256) {
    const int dir = tid >> 7, kk = tid & 127;
    const float* up = dir ? p.gla_a_up_b : p.gla_a_up_f;
    const float bias = (dir ? p.gla_a_bias_b : p.gla_a_bias_f)[h * 128 + kk];
    float u[16];
#pragma unroll
    for (int r = 0; r < 16; ++r) u[r] = up[r * 512 + h * 128 + kk];
    float* Gc = G + dir * 64 * 128 + kk;
    for (int i = 0; i < 64; ++i) {
      float z = bias;
#pragma unroll
      for (int r = 0; r < 16; ++r) z += afab[i * 32 + dir * 16 + r] * u[r];
      Gc[i * 128] = logsig(z) * (1.f / 16.f);
    }
    float run = 0.f;
    if (dir == 0) { for (int i = 0; i < 64; ++i) { run += Gc[i * 128]; Gc[i * 128] = run; } }
    else { for (int i = 63; i >= 0; --i) { run += Gc[i * 128]; Gc[i * 128] = run; } }
    const float bedge = run;
    const long hb = ((long)(dir * 2 + b) * 4 + h);
    const int pk = fragpos(kk);
    u16* qt = (u16*)(ws + O_QT) + (hb * 4096 + c * 64) * 128 + pk;
    u16* kt = (u16*)(ws + O_KT) + (hb * 4096 + c * 64) * 128 + pk;
    ((float*)(ws + O_DEC))[(hb * 64 + c) * 128 + kk] = __expf(bedge);
    u16* KDr = KD + (dir * 128 + kk) * 72;
    const unsigned short* qsrc = cols + tok0 * NCP + C_Q + h * 128 + kk;
    const unsigned short* ksrc = cols + tok0 * NCP + C_K + h * 128 + kk;
#pragma unroll 1
    for (int i0 = 0; i0 < 64; i0 += 8) {
      u16 qv[8], kv[8];
#pragma unroll
      for (int j = 0; j < 8; ++j) { qv[j] = qsrc[(long)(i0 + j) * NCP]; kv[j] = ksrc[(long)(i0 + j) * NCP]; }
#pragma unroll
      for (int j = 0; j < 8; ++j) {
        const int i = i0 + j;
        float bb = Gc[i * 128];
        float q = bf2f(qv[j]);
        float k = bf2f(kv[j]);
        qt[i * 128] = f2bf(q * 0.08838834764831845f * __expf(bb));
        kt[i * 128] = f2bf(k * __expf(-bb));
        KDr[fragpos(i)] = f2bf(k * __expf(bedge - bb));
      }
    }
  }
  __syncthreads();
#pragma unroll 8
  for (int idx = tid; idx < 64 * 256; idx += 512) {
    int i = idx >> 8, vc = idx & 255;
    VL[vc * 72 + fragpos(i)] = cols[(tok0 + i) * NCP + C_V + h * 256 + vc];
  }
  __syncthreads();
  for (int pc = tid; pc < 4096; pc += 512) {
    int row = pc >> 3, ch = pc & 7;
    if (row < 256) {
      int dir = row >> 7, kk = row & 127;
      uint4 v = *(const uint4*)(KD + row * 72 + ch * 8);
      long hb = ((long)(dir * 2 + b) * 4 + h);
      *(uint4*)((u16*)(ws + O_KDT) + ((hb * 64 + c) * 128 + kk) * 64 + ch * 8) = v;
    } else {
      int vc = row - 256;
      uint4 v = *(const uint4*)(VL + vc * 72 + ch * 8);
      long hb = ((long)b * 4 + h);
      *(uint4*)((u16*)(ws + O_VT) + ((hb * 64 + c) * 256 + vc) * 64 + ch * 8) = v;
    }
  }
  __syncthreads();
}

DEVINL float rw_shift2(const char* colsb, float muv, unsigned o, int s) {
  const unsigned op = (s > 0) ? o - (unsigned)(NCP * 2) : o;
  const unsigned on = (s < S_ - 1) ? o + (unsigned)(NCP * 2) : o;
  float cur = bf2f(*(const u16*)(colsb + o));
  float prv = bf2f(*(const u16*)(colsb + op));
  float nxt = bf2f(*(const u16*)(colsb + on));
  if (s == 0) prv = 0.f;
  if (s == S_ - 1) nxt = 0.f;
  return cur + muv * (0.5f * (prv + nxt) - cur);
}

DEVINL void rw_shift4(const char* colsb, float4 mu, unsigned o, int s, float (&out)[4]) {
  const unsigned op = (s > 0) ? o - (unsigned)(NCP * 2) : o;
  const unsigned on = (s < S_ - 1) ? o + (unsigned)(NCP * 2) : o;
  const uint2 c = *(const uint2*)(colsb + o);
  uint2 pv = *(const uint2*)(colsb + op);
  uint2 nx = *(const uint2*)(colsb + on);
  if (s == 0) pv = make_uint2(0u, 0u);
  if (s == S_ - 1) nx = make_uint2(0u, 0u);
  const float cu[4] = {bflo(c.x), bfhi(c.x), bflo(c.y), bfhi(c.y)};
  const float pr[4] = {bflo(pv.x), bfhi(pv.x), bflo(pv.y), bfhi(pv.y)};
  const float nn[4] = {bflo(nx.x), bfhi(nx.x), bflo(nx.y), bfhi(nx.y)};
  const float m[4] = {mu.x, mu.y, mu.z, mu.w};
#pragma unroll
  for (int e = 0; e < 4; ++e) out[e] = cu[e] + m[e] * (0.5f * (pr[e] + nn[e]) - cu[e]);
}

DEVINL void rw_prep_unit(const Params& p, int unit) {
  char* ws = p.ws;
  const char* colsb = ws + O_COLS;
  const int tid = otid(), lane = tid & 63, wave = tid >> 6, l15 = lane & 15, g = lane >> 4;
  u16* AL = (u16*)dynsmem;
  const int tok0 = unit * 32;
#pragma unroll 5
  for (int idx = tid; idx < 32 * 320; idx += 512) {
    int i = idx / 320, j = idx % 320;
    int t = tok0 + i; int s = t & (S_ - 1);
    unsigned o = ((unsigned)t * (unsigned)NCP + (unsigned)(C_RW + 3072 + j)) * 2u;
    float v = rw_shift2(colsb, p.rw_mu[3072 + j], o, s);
    if (j < 128) v = tanh_(v);
    else if (j >= 192) v = sigm(v);
    AL[i * 328 + j] = f2bf(v);
  }
  __syncthreads();
  const u16* LWF = (const u16*)(ws + O_LWF);
  const u16* LWB = (const u16*)(ws + O_LWB);
  const u16* LA = (const u16*)(ws + O_LA);
  const u16* LG = (const u16*)(ws + O_LG);
#pragma unroll 1
  for (int hh = 0; hh < 2; ++hh) {
    const int head = wave * 2 + hh;
#pragma unroll 1
    for (int mt = 0; mt < 2; ++mt) {
      f32x4 awf[4], awb[4], aa[4], ag[4];
#pragma unroll
      for (int n = 0; n < 4; ++n) { awf[n] = f32x4{0, 0, 0, 0}; awb[n] = awf[n]; aa[n] = awf[n]; ag[n] = awf[n]; }
      const u16* arow = AL + (mt * 16 + l15) * 328 + 8 * g;
#pragma unroll
      for (int ks = 0; ks < 2; ++ks) {
        bf16x8 fwf = *(const bf16x8*)(arow + 32 * ks);
        bf16x8 fwb = *(const bf16x8*)(arow + 64 + 32 * ks);
        bf16x8 fa = *(const bf16x8*)(arow + 128 + 32 * ks);
#pragma unroll
        for (int n = 0; n < 4; ++n) {
          const unsigned bo = (unsigned)((head * 64 + l15 * 4 + n) * 64 + 32 * ks + 8 * g) * 2u;
          bf16x8 b1 = *(const bf16x8*)((const char*)LWF + bo);
          bf16x8 b2 = *(const bf16x8*)((const char*)LWB + bo);
          bf16x8 b3 = *(const bf16x8*)((const char*)LA + bo);
          awf[n] = MFMA16(fwf, b1, awf[n]);
          awb[n] = MFMA16(fwb, b2, awb[n]);
          aa[n] = MFMA16(fa, b3, aa[n]);
        }
        __builtin_amdgcn_sched_barrier(0);
      }
#pragma unroll
      for (int ks = 0; ks < 4; ++ks) {
        bf16x8 fg = *(const bf16x8*)(arow + 192 + 32 * ks);
#pragma unroll
        for (int n = 0; n < 4; ++n) {
          const unsigned bo = (unsigned)((head * 64 + l15 * 4 + n) * 128 + 32 * ks + 8 * g) * 2u;
          bf16x8 b4 = *(const bf16x8*)((const char*)LG + bo);
          ag[n] = MFMA16(fg, b4, ag[n]);
        }
        __builtin_amdgcn_sched_barrier(0);
      }
#pragma unroll 2
      for (int j = 0; j < 4; ++j) {
        int jo = j, zo = 0;
        asm volatile("" : "+v"(jo), "+v"(zo));
        const int t = tok0 + mt * 16 + 4 * g + jo;
        const int s = t & (S_ - 1), b = t >> 12;
        const unsigned c0 = (unsigned)(head * 64 + l15 * 4 + zo);
        const unsigned rowo = (unsigned)t * (unsigned)(NCP * 2) + (unsigned)(C_RW * 2) + c0 * 2u;
        float pr[4], pkr[4], pv[4];
        rw_shift4(colsb, *(const float4*)(p.rw_mu + c0), rowo, s, pr);
        rw_shift4(colsb, *(const float4*)(p.rw_mu + 1024u + c0), rowo + 2048u, s, pkr);
        rw_shift4(colsb, *(const float4*)(p.rw_mu + 2048u + c0), rowo + 4096u, s, pv);
        const float4 a0q = *(const float4*)(p.rw_a0 + c0), kkq = *(const float4*)(p.rw_k_k + c0);
        const float4 kaq = *(const float4*)(p.rw_k_a + c0), rkq = *(const float4*)(p.rw_r_k + c0);
        const float4 w0fq = *(const float4*)(p.rw_w0_f + c0), w0bq = *(const float4*)(p.rw_w0_b + c0);
        const float a0v[4] = {a0q.x, a0q.y, a0q.z, a0q.w}, kkp[4] = {kkq.x, kkq.y, kkq.z, kkq.w};
        const float kap[4] = {kaq.x, kaq.y, kaq.z, kaq.w}, rkp[4] = {rkq.x, rkq.y, rkq.z, rkq.w};
        const float w0f[4] = {w0fq.x, w0fq.y, w0fq.z, w0fq.w}, w0b[4] = {w0bq.x, w0bq.y, w0bq.z, w0bq.w};
        float pk[4], av[4], kkv[4];
        float n2 = 0.f, dot = 0.f;
#pragma unroll
        for (int n = 0; n < 4; ++n) {
          const float kraw = pkr[n];
          float a = sigm(a0v[n] + sel4(aa[n], j));
          av[n] = a;
          float kk = kraw * kkp[n];
          kkv[n] = kk;
          n2 += kk * kk;
          float k2 = kraw * (1.f + (a - 1.f) * kap[n]);
          pk[n] = k2;
          dot += pr[n] * k2 * rkp[n];
        }
        n2 = allred16(n2);
        dot = allred16(dot);
        const float inv = 1.f / fmaxf(sqrtf(n2), 1e-12f);
        const unsigned reco = ((unsigned)((b * 16 + head) * 4096 + s)) * 1024u;
        const unsigned tco = (unsigned)t * 2048u + c0 * 2u;
        unsigned hwf[4], hwb[4], ha[4], hb[4], hk[4], hr[4], hv[4], bg[4], bbn[4];
#pragma unroll
        for (int n = 0; n < 4; ++n) {
          float wf = __expf(-0.606531f * sigm(w0f[n] + sel4(awf[n], j)));
          float wb = __expf(-0.606531f * sigm(w0b[n] + sel4(awb[n], j)));
          float kkn = kkv[n] * inv;
          hwf[n] = f2h(wf); hwb[n] = f2h(wb); ha[n] = f2h(-kkn); hb[n] = f2h(kkn * av[n]);
          hk[n] = f2h(pk[n]); hr[n] = f2h(pr[n]); hv[n] = f2h(pv[n]);
          bg[n] = f2bf(sel4(ag[n], j)); bbn[n] = f2bf(dot * pv[n]);
        }
        char* rb = ws + O_REC + (reco + (unsigned)l15 * 64u);
        *(uint4*)(rb) = make_uint4(hwf[0] | (hwf[1] << 16), hwf[2] | (hwf[3] << 16), hwb[0] | (hwb[1] << 16), hwb[2] | (hwb[3] << 16));
        *(uint4*)(rb + 16) = make_uint4(ha[0] | (ha[1] << 16), ha[2] | (ha[3] << 16), hb[0] | (hb[1] << 16), hb[2] | (hb[3] << 16));
        *(uint4*)(rb + 32) = make_uint4(hk[0] | (hk[1] << 16), hk[2] | (hk[3] << 16), hr[0] | (hr[1] << 16), hr[2] | (hr[3] << 16));
        *(uint2*)(rb + 48) = make_uint2(hv[0] | (hv[1] << 16), hv[2] | (hv[3] << 16));
        *(uint2*)(ws + O_GRW + tco) = make_uint2(bg[0] | (bg[1] << 16), bg[2] | (bg[3] << 16));
        *(uint2*)(ws + O_BONUS + tco) = make_uint2(bbn[0] | (bbn[1] << 16), bbn[2] | (bbn[3] << 16));
      }
    }
  }
  __syncthreads();
}

DEVINL void phase2(const Params& p) {
  const int bid = blockIdx.x, nb = gridDim.x, tid = otid();
  for (int u = bid; u < 512; u += nb) gla_prep_unit(p, u);
  for (int u = bid; u < 256; u += nb) rw_prep_unit(p, u);
}

typedef unsigned u32x2 __attribute__((ext_vector_type(2)));
typedef unsigned u32x4 __attribute__((ext_vector_type(4)));
template <int DIR>
DEVINL void rwkv_scan_dir(const Params& p, int task, int lane, int wave) {
  const int b = (task >> 8) & 1, head = (task >> 4) & 15, rg = task & 15;
  const int seg = lane & 15, rl = lane >> 4, row = rg * 4 + rl;
  constexpr int DIST = 24;
  constexpr int WOFS = DIR ? 8 : 0;
  const char* recbase = p.ws + O_REC + ((long)(b * 16 + head) * 4096) * 1024 + lane * 16;
  const unsigned ring_lds = (unsigned)(unsigned long)(__attribute__((address_space(3))) char*)(dynsmem + wave * 32768);
  const unsigned ring_u = __builtin_amdgcn_readfirstlane(ring_lds);
  const unsigned a_seg = ring_lds + seg * 64;
  const unsigned a_v = ring_lds + (row >> 2) * 64 + 48 + (row & 3) * 2;
  u16* yo = (u16*)(p.ws + (DIR ? O_YB : O_YSUM)) + ((long)b * 4096) * 1024 + head * 64 + row;
  float s0 = 0.f, s1 = 0.f, s2 = 0.f, s3 = 0.f;
  float ykeep = 0.f;
  const char* recdir = recbase + (DIR ? (long)4095 * 1024 : 0);
#define RW_GPTR(q_, gp_) const char* gp_ = recdir + (DIR ? -(long)(q_) * 1024 : (long)(q_) * 1024);
#define RW_DMA_ONLY(q_) do { RW_GPTR(q_, gp_) unsigned keep_; const unsigned ld_ = ring_u + ((q_) & 31) * 1024; \
    asm volatile("s_mov_b32 %0, m0\n\ts_mov_b32 m0, %2\n\ts_nop 0\n\tglobal_load_lds_dwordx4 %1, off\n\ts_mov_b32 m0, %0" \
                 : "=&s"(keep_) : "v"(gp_), "s"(ld_) : "memory"); } while (0)
#define RW_READ(U1, WN, XN, KN, VN, VMC) do { \
    asm volatile("s_waitcnt vmcnt(" #VMC ")\n\t" \
                 "ds_read_b64 %0, %4 offset:%6\n\t" \
                 "ds_read_b128 %1, %4 offset:%7\n\t" \
                 "ds_read_b128 %2, %4 offset:%8\n\t" \
                 "ds_read_u16 %3, %5 offset:%9" \
                 : "=&v"(WN), "=&v"(XN), "=&v"(KN), "=&v"(VN) \
                 : "v"(a_seg), "v"(a_v), \
                   "i"(((U1) & 31) * 1024 + WOFS), "i"(((U1) & 31) * 1024 + 16), "i"(((U1) & 31) * 1024 + 32), "i"(((U1) & 31) * 1024) \
                 : "memory"); } while (0)
#define RW_LANDED(WN, XN, KN, VN) asm volatile("s_waitcnt lgkmcnt(0)" : "+v"(WN), "+v"(XN), "+v"(KN), "+v"(VN) :: "memory")
#define FMX "op_sel_hi:[0,1,0]"
#define FHH "op_sel_hi:[1,1,0]"
#define DPPX " row_mask:0xf bank_mask:0xf bound_ctrl:1"
#define RW_STEP(U, WC, XC, KC, VC, WN, XN, KN, VN) do { \
    RW_GPTR(st + (U) + DIST, gp_) \
    const unsigned ld_ = ring_u + (((U) + DIST) & 31) * 1024; \
    float pa_, pb_, t0_, t1_, t2_, t3_, sa_; \
    asm volatile( \
      "s_mov_b32 m0, %[ld]\n\t" \
      "s_nop 0\n\t" \
      "global_load_lds_dwordx4 %[gp], off\n\t" \
      "s_waitcnt vmcnt(23)\n\t" \
      "ds_read_b64 %[wn], %[aseg] offset:%[o0]\n\t" \
      "ds_read_b128 %[xn], %[aseg] offset:%[o1]\n\t" \
      "ds_read_b128 %[kn], %[aseg] offset:%[o2]\n\t" \
      "ds_read_u16 %[vn], %[av] offset:%[o3]\n\t" \
      "v_fma_mix_f32 %[pa], %[s0], %[a01], 0 op_sel:[0,0,0] " FMX "\n\t" \
      "v_fma_mix_f32 %[pb], %[s2], %[a23], 0 op_sel:[0,0,0] " FMX "\n\t" \
      "v_fma_mix_f32 %[t0], %[s0], %[w01], 0 op_sel:[0,0,0] " FMX "\n\t" \
      "v_fma_mix_f32 %[pa], %[s1], %[a01], %[pa] op_sel:[0,1,0] " FMX "\n\t" \
      "v_fma_mix_f32 %[pb], %[s3], %[a23], %[pb] op_sel:[0,1,0] " FMX "\n\t" \
      "v_fma_mix_f32 %[t1], %[s1], %[w01], 0 op_sel:[0,1,0] " FMX "\n\t" \
      "v_fma_mix_f32 %[t2], %[s2], %[w23], 0 op_sel:[0,0,0] " FMX "\n\t" \
      "v_add_f32 %[sa], %[pa], %[pb]\n\t" \
      "v_add_f32_dpp %[yp], %[yp], %[yp] quad_perm:[1,0,3,2]" DPPX "\n\t" \
      "v_fma_mix_f32 %[t3], %[s3], %[w23], 0 op_sel:[0,1,0] " FMX "\n\t" \
      "v_fma_mix_f32 %[t0], %[vh], %[k01], %[t0] op_sel:[0,0,0] " FHH "\n\t" \
      "v_add_f32_dpp %[sa], %[sa], %[sa] quad_perm:[1,0,3,2]" DPPX "\n\t" \
      "v_add_f32_dpp %[yp], %[yp], %[yp] quad_perm:[2,3,0,1]" DPPX "\n\t" \
      "v_fma_mix_f32 %[t1], %[vh], %[k01], %[t1] op_sel:[0,1,0] " FHH "\n\t" \
      "v_fma_mix_f32 %[t2], %[vh], %[k23], %[t2] op_sel:[0,0,0] " FHH "\n\t" \
      "v_add_f32_dpp %[sa], %[sa], %[sa] quad_perm:[2,3,0,1]" DPPX "\n\t" \
      "v_add_f32_dpp %[yp], %[yp], %[yp] row_half_mirror" DPPX "\n\t" \
      "v_fma_mix_f32 %[t3], %[vh], %[k23], %[t3] op_sel:[0,1,0] " FHH "\n\t" \
      "v_cmp_eq_u32 vcc, %[fin], %[segv]\n\t" \
      "v_add_f32_dpp %[sa], %[sa], %[sa] row_half_mirror" DPPX "\n\t" \
      "v_add_f32_dpp %[yp], %[yp], %[yp] row_mirror" DPPX "\n\t" \
      "v_cndmask_b32 %[yk], %[yk], %[yp], vcc\n\t" \
      "s_nop 0\n\t" \
      "v_add_f32_dpp %[sa], %[sa], %[sa] row_mirror" DPPX "\n\t" \
      "v_fma_mix_f32 %[s0], %[sa], %[b01], %[t0] op_sel:[0,0,0] " FMX "\n\t" \
      "v_fma_mix_f32 %[s1], %[sa], %[b01], %[t1] op_sel:[0,1,0] " FMX "\n\t" \
      "v_fma_mix_f32 %[s2], %[sa], %[b23], %[t2] op_sel:[0,0,0] " FMX "\n\t" \
      "v_fma_mix_f32 %[s3], %[sa], %[b23], %[t3] op_sel:[0,1,0] " FMX "\n\t" \
      "v_fma_mix_f32 %[pa], %[s0], %[r01], 0 op_sel:[0,0,0] " FMX "\n\t" \
      "v_fma_mix_f32 %[pb], %[s2], %[r23], 0 op_sel:[0,0,0] " FMX "\n\t" \
      "v_fma_mix_f32 %[pa], %[s1], %[r01], %[pa] op_sel:[0,1,0] " FMX "\n\t" \
      "v_fma_mix_f32 %[pb], %[s3], %[r23], %[pb] op_sel:[0,1,0] " FMX "\n\t" \
      "v_add_f32 %[yp], %[pa], %[pb]\n\t" \
      "s_waitcnt lgkmcnt(0)" \
      : [wn]"=&v"(WN), [xn]"=&v"(XN), [kn]"=&v"(KN), [vn]"=&v"(VN), \
        [pa]"=&v"(pa_), [pb]"=&v"(pb_), [t0]"=&v"(t0_), [t1]"=&v"(t1_), [t2]"=&v"(t2_), [t3]"=&v"(t3_), [sa]"=&v"(sa_), \
        [s0]"+v"(s0), [s1]"+v"(s1), [s2]"+v"(s2), [s3]"+v"(s3), [yp]"+v"(ypart), [yk]"+v"(ykeep) \
      : [gp]"v"(gp_), [ld]"s"(ld_), [aseg]"v"(a_seg), [av]"v"(a_v), \
        [a01]"v"(XC.x), [a23]"v"(XC.y), [b01]"v"(XC.z), [b23]"v"(XC.w), \
        [k01]"v"(KC.x), [k23]"v"(KC.y), [r01]"v"(KC.z), [r23]"v"(KC.w), \
        [w01]"v"(WC.x), [w23]"v"(WC.y), [vh]"v"(VC), [segv]"v"(seg), [fin]"i"(((U) + 15) & 15), \
        [o0]"i"((((U) + 1) & 31) * 1024 + WOFS), [o1]"i"((((U) + 1) & 31) * 1024 + 16), \
        [o2]"i"((((U) + 1) & 31) * 1024 + 32), [o3]"i"((((U) + 1) & 31) * 1024) \
      : "memory", "vcc"); } while (0)
#define RW_STEP2(B) RW_STEP(B, WvA, XA, KrA, vhA, WvB, XB, KrB, vhB); RW_STEP((B) + 1, WvB, XB, KrB, vhB, WvA, XA, KrA, vhA)
#define RW_STEP4(B) RW_STEP2(B); RW_STEP2((B) + 2)
#define RW_DMA4(B) RW_DMA_ONLY(B); RW_DMA_ONLY((B) + 1); RW_DMA_ONLY((B) + 2); RW_DMA_ONLY((B) + 3)
  u32x2 WvA, WvB; u32x4 XA, XB, KrA, KrB; unsigned vhA, vhB;
  RW_DMA4(0); RW_DMA4(4); RW_DMA4(8); RW_DMA4(12); RW_DMA4(16); RW_DMA4(20);
  RW_READ(0, WvA, XA, KrA, vhA, 23);
  RW_LANDED(WvA, XA, KrA, vhA);
  float ypart = 0.f;
#pragma unroll 1
  for (int st = 0; st < 4096; st += 32) {
    RW_STEP(0, WvA, XA, KrA, vhA, WvB, XB, KrB, vhB);
    if (st > 0) { const int q0 = st - 16 + seg; yo[(long)(DIR ? (4095 - q0) : q0) * 1024] = f2bf(ykeep); }
    RW_STEP(1, WvB, XB, KrB, vhB, WvA, XA, KrA, vhA);
    RW_STEP2(2); RW_STEP4(4); RW_STEP4(8); RW_STEP4(12);
    RW_STEP(16, WvA, XA, KrA, vhA, WvB, XB, KrB, vhB);
    { const int q0 = st + seg; yo[(long)(DIR ? (4095 - q0) : q0) * 1024] = f2bf(ykeep); }
    RW_STEP(17, WvB, XB, KrB, vhB, WvA, XA, KrA, vhA);
    RW_STEP2(18); RW_STEP4(20); RW_STEP4(24); RW_STEP4(28);
  }
  {
    const float ylast = allred16(ypart);
    ykeep = (seg == 15) ? ylast : ykeep;
    const int q0 = 4096 - 16 + seg; yo[(long)(DIR ? (4095 - q0) : q0) * 1024] = f2bf(ykeep);
  }
  asm volatile("s_waitcnt vmcnt(0)" ::: "memory");
#undef RW_READ
#undef RW_LANDED
#undef RW_STEP2
#undef RW_GPTR
#undef RW_DMA_ONLY
#undef RW_STEP
#undef RW_STEP4
#undef RW_DMA4
}
DEVINL void rwkv_scan_task(const Params& p, int task, int lane, int wave) {
  if (task >> 9) rwkv_scan_dir<1>(p, task, lane, wave);
  else rwkv_scan_dir<0>(p, task, lane, wave);
}

DEVINL void gla_scan_task(const Params& p, int task, int lane) {
  const int dir = task >> 7, b = (task >> 6) & 1, h = (task >> 4) & 3, vsl = task & 15;
  const int l15 = lane & 15, g = lane >> 4;
  const long hb = (long)(dir * 2 + b) * 4 + h;
  const u16* qt = (const u16*)(p.ws + O_QT) + hb * 4096 * 128 + l15 * 128 + 8 * g;
  const u16* kt = (const u16*)(p.ws + O_KT) + hb * 4096 * 128 + l15 * 128 + 8 * g;
  const u16* kdT = (const u16*)(p.ws + O_KDT) + hb * 64 * 128 * 64 + l15 * 64 + 8 * g;
  const u16* vT = (const u16*)(p.ws + O_VT) + ((long)b * 4 + h) * 64 * 256 * 64 + (16 * vsl + l15) * 64 + 8 * g;
  const float* dec = (const float*)(p.ws + O_DEC) + hb * 64 * 128 + 4 * g;
  u16* obuf = (u16*)(p.ws + O_OSUM) + (dir ? (long)T_ * 1024 : 0) + ((long)b * 4096) * 1024 + h * 256 + 16 * vsl + l15;
  f32x4 ST[8];
#pragma unroll
  for (int m = 0; m < 8; ++m) ST[m] = f32x4{0, 0, 0, 0};
  bf16x8 KF[4][4], VF[2], QF[4][4];
#define GL_LOAD_KV(KFx, VFx, c_) do { \
    _Pragma("unroll") for (int jt = 0; jt < 4; ++jt) _Pragma("unroll") for (int ks = 0; ks < 4; ++ks) \
      KFx[jt][ks] = ld16(kt + ((c_) * 64 + 16 * jt) * 128 + 32 * ks); \
    _Pragma("unroll") for (int s = 0; s < 2; ++s) VFx[s] = ld16(vT + (c_) * (256 * 64) + 32 * s); } while (0)
#define GL_LOAD_Q(it_, c_) do { \
    _Pragma("unroll") for (int ks = 0; ks < 4; ++ks) QF[it_][ks] = ld16(qt + ((c_) * 64 + 16 * (it_)) * 128 + 32 * ks); } while (0)
  {
    const int c0 = dir ? 63 : 0;
    GL_LOAD_KV(KF, VF, c0);
    GL_LOAD_Q(0, c0);
  }
  for (int cc = 0; cc < 64; ++cc) {
    const int c = dir ? 63 - cc : cc;
    const int tok0 = c * 64;
    GL_LOAD_Q(1, c); GL_LOAD_Q(2, c); GL_LOAD_Q(3, c);
    bf16x8 SBf[4];
#pragma unroll
    for (int ks = 0; ks < 4; ++ks) SBf[ks] = pack8(ST[2 * ks], ST[2 * ks + 1]);
    __builtin_amdgcn_sched_barrier(0);
#pragma unroll
    for (int it = 0; it < 4; ++it) {
      f32x4 X[4];
#pragma unroll
      for (int jt = 0; jt < 4; ++jt) {
        X[jt] = f32x4{0, 0, 0, 0};
        const bool need = dir ? (jt >= it) : (jt <= it);
        if (need) {
#pragma unroll
          for (int ks = 0; ks < 4; ++ks) X[jt] = MFMA16(KF[jt][ks], QF[it][ks], X[jt]);
          if (jt == it) {
#pragma unroll
            for (int r = 0; r < 4; ++r) {
              const int j = 4 * g + r;
              const bool keep = dir ? (j >= l15) : (j <= l15);
              if (!keep) X[jt][r] = 0.f;
            }
          }
        }
      }
      bf16x8 XA0 = pack8(X[0], X[1]), XA1 = pack8(X[2], X[3]);
      f32x4 O = f32x4{0, 0, 0, 0};
      O = MFMA16(XA0, VF[0], O);
      O = MFMA16(XA1, VF[1], O);
#pragma unroll
      for (int ks = 0; ks < 4; ++ks) O = MFMA16(QF[it][ks], SBf[ks], O);
      {
        const bool oddc = (l15 & 1) != 0;
        float lo[2], hi[2];
        xchg_pairs(O, oddc, lo, hi);
        u16* ob = obuf - (oddc ? 1 : 0) + (long)(tok0 + 16 * it + 4 * g + (oddc ? 2 : 0)) * 1024;
        *(unsigned*)(ob) = pk2(lo[0], hi[0]);
        *(unsigned*)(ob + 1024) = pk2(lo[1], hi[1]);
      }
    }
    __builtin_amdgcn_sched_barrier(0);
    bf16x8 KDF[8][2]; f32x4 Dv[8];
#pragma unroll
    for (int m = 0; m < 8; ++m) {
      Dv[m] = *(const f32x4*)(dec + c * 128 + 16 * m);
#pragma unroll
      for (int s = 0; s < 2; ++s) KDF[m][s] = ld16(kdT + (c * 128 + 16 * m) * 64 + 32 * s);
    }
    __builtin_amdgcn_sched_barrier(0);
#pragma unroll
    for (int m = 0; m < 4; ++m) {
      ST[m] = ST[m] * Dv[m];
      ST[m] = MFMA16(KDF[m][0], VF[0], ST[m]);
      ST[m] = MFMA16(KDF[m][1], VF[1], ST[m]);
    }
    __builtin_amdgcn_sched_barrier(0);
    const int cn = (cc < 63) ? (dir ? c - 1 : c + 1) : c;
    bf16x8 VFn[2];
    GL_LOAD_KV(KF, VFn, cn);
    GL_LOAD_Q(0, cn);
    __builtin_amdgcn_sched_barrier(0);
#pragma unroll
    for (int m = 4; m < 8; ++m) {
      ST[m] = ST[m] * Dv[m];
      ST[m] = MFMA16(KDF[m][0], VF[0], ST[m]);
      ST[m] = MFMA16(KDF[m][1], VF[1], ST[m]);
    }
    VF[0] = VFn[0]; VF[1] = VFn[1];
  }
#undef GL_LOAD_KV
#undef GL_LOAD_Q
}

DEVINL void phase3(const Params& p) {
  const int tid = otid(); const int wave = tid >> 6, lane = tid & 63;
  const int nb = gridDim.x;
  int vb = blockIdx.x;
  if ((nb & 7) == 0) vb = (blockIdx.x & 7) * (nb >> 3) + (blockIdx.x >> 3);
  if (wave < 4) {
    for (int task = vb * 4 + wave; task < 1024; task += nb * 4) rwkv_scan_task(p, task, lane, wave);
  } else if (wave == 4) {
    for (int task = vb; task < 256; task += nb) gla_scan_task(p, task, lane);
  }
}

DEVINL void phase4(const Params& p) {
  char* ws = p.ws;
  const int tid = otid();
  const int lane = tid & 63;
  const int gw = blockIdx.x * 8 + (tid >> 6), nw = gridDim.x * 8;
  const u16* cols = (const u16*)(ws + O_COLS);
  for (int u = gw; u < T_ * 4; u += nw) {
    const long t = u >> 2; const int h = u & 3;
    const int c = h * 256 + lane * 4;
    float4 o;
    {
      uint2 of = *(const uint2*)((const u16*)(ws + O_OSUM) + t * 1024 + c);
      uint2 ob = *(const uint2*)((const u16*)(ws + O_OSUM) + (long)T_ * 1024 + t * 1024 + c);
      o.x = bflo(of.x) + bflo(ob.x); o.y = bfhi(of.x) + bfhi(ob.x);
      o.z = bflo(of.y) + bflo(ob.y); o.w = bfhi(of.y) + bfhi(ob.y);
    }
    float ss = o.x * o.x + o.y * o.y + o.z * o.z + o.w * o.w;
    ss = allred64(ss);
    const float rstd = rsqrtf(ss * (1.f / 256.f) + 1e-5f);
    float4 ng = *(const float4*)(p.gla_norm_g + c);
    uint2 gg = *(const uint2*)(cols + t * NCP + C_G + c);
    float g0 = bflo(gg.x), g1 = bfhi(gg.x), g2 = bflo(gg.y), g3 = bfhi(gg.y);
    float y0 = o.x * rstd * ng.x * (g0 * sigm(g0));
    float y1 = o.y * rstd * ng.y * (g1 * sigm(g1));
    float y2 = o.z * rstd * ng.z * (g2 * sigm(g2));
    float y3 = o.w * rstd * ng.w * (g3 * sigm(g3));
    *(uint2*)((u16*)(ws + O_YGLA) + t * 1024 + c) = make_uint2(pk2(y0, y1), pk2(y2, y3));
  }
  for (int u = gw; u < T_ * 4; u += nw) {
    const long t = u >> 2; const int hq = u & 3;
    const int c = (hq * 4 + (lane >> 4)) * 64 + (lane & 15) * 4;
    float4 y;
    {
      const uint2 y1 = *(const uint2*)((const u16*)(ws + O_YSUM) + t * 1024 + c);
      const uint2 y2 = *(const uint2*)((const u16*)(ws + O_YB) + t * 1024 + c);
      y.x = bflo(y1.x) + bflo(y2.x); y.y = bfhi(y1.x) + bfhi(y2.x);
      y.z = bflo(y1.y) + bflo(y2.y); y.w = bfhi(y1.y) + bfhi(y2.y);
    }
    float mu = allred16(y.x + y.y + y.z + y.w) * (1.f / 64.f);
    float d0 = y.x - mu, d1 = y.y - mu, d2 = y.z - mu, d3 = y.w - mu;
    float var = allred16(d0 * d0 + d1 * d1 + d2 * d2 + d3 * d3) * (1.f / 64.f);
    const float rstd = rsqrtf(var + 64e-5f);
    float4 lg = *(const float4*)(p.rw_ln_g + c);
    float4 lb = *(const float4*)(p.rw_ln_b + c);
    uint2 bo = *(const uint2*)((const u16*)(ws + O_BONUS) + t * 1024 + c);
    uint2 gg = *(const uint2*)((const u16*)(ws + O_GRW) + t * 1024 + c);
    float r0 = (d0 * rstd * lg.x + lb.x + bflo(bo.x)) * bflo(gg.x);
    float r1 = (d1 * rstd * lg.y + lb.y + bfhi(bo.x)) * bfhi(gg.x);
    float r2 = (d2 * rstd * lg.z + lb.z + bflo(bo.y)) * bflo(gg.y);
    float r3 = (d3 * rstd * lg.w + lb.w + bfhi(bo.y)) * bfhi(gg.y);
    *(uint2*)((u16*)(ws + O_YRW) + t * 1024 + c) = make_uint2(pk2(r0, r1), pk2(r2, r3));
  }
}

DEVINL void phase5(const Params& p) {
  const u16* A1 = (const u16*)(p.ws + O_YGLA);
  const u16* A2 = (const u16*)(p.ws + O_YRW);
  const u16* B1 = (const u16*)(p.ws + O_WUPGT);
  const u16* B2 = (const u16*)(p.ws + O_WUPRT);
  for (int t = blockIdx.x; t < 256; t += gridDim.x) {
    int pm = t & 31, pn = t >> 5;
    gemm_tile<EPI_M1, false>(p, A1, 1024, nullptr, B1, 1024, 1024, pm * 256, pn * 256, pm * 256, pn * 256);
  }
  for (int t = blockIdx.x; t < 256; t += gridDim.x) {
    int pm = t & 31, pn = t >> 5;
    gemm_tile<EPI_MERGED, false>(p, A2, 1024, nullptr, B2, 1024, 1024, pm * 256, pn * 256, pm * 256, pn * 256);
  }
}
DEVINL void phase6(const Params& p) {
  const u16* A = (const u16*)(p.ws + O_MERGED);
  const u16* Bt = (const u16*)(p.ws + O_WOUTT);
  for (int t = blockIdx.x; t < 256; t += gridDim.x) {
    int pm = t & 31, pn = t >> 5;
    gemm_tile<EPI_R1, false>(p, A, 2048, nullptr, Bt, 2048, 2048, pm * 256, pn * 256, pm * 256, pn * 256);
  }
}

DEVINL void phase7(const Params& p) {
  char* ws = p.ws;
  const int tid = otid();
  const int lane = tid & 63;
  const int gw = blockIdx.x * 8 + (tid >> 6), nw = gridDim.x * 8;
  for (int row = gw; row < T_; row += nw) {
    const u16* r1 = (const u16*)(ws + O_R1) + (long)row * 2048;
    float4 v[8];
    float sum = 0.f;
#pragma unroll
    for (int i = 0; i < 8; ++i) {
      const uint2 q = *(const uint2*)(r1 + i * 256 + lane * 4);
      v[i] = make_float4(bflo(q.x), bfhi(q.x), bflo(q.y), bfhi(q.y));
      sum += v[i].x + v[i].y + v[i].z + v[i].w;
    }
    const float mu = allred64(sum) * (1.f / 2048.f);
    float sq = 0.f;
#pragma unroll
    for (int i = 0; i < 8; ++i) {
      v[i].x -= mu; v[i].y -= mu; v[i].z -= mu; v[i].w -= mu;
      sq += v[i].x * v[i].x + v[i].y * v[i].y + v[i].z * v[i].z + v[i].w * v[i].w;
    }
    const float rstd = rsqrtf(allred64(sq) * (1.f / 2048.f) + 1e-5f);
    float lg[16];
#pragma unroll
    for (int e = 0; e < 16; ++e) lg[e] = 0.f;
#pragma unroll
    for (int i = 0; i < 8; ++i) {
      const int c = i * 256 + lane * 4;
      float4 gq = *(const float4*)(p.ln1_g + c);
      float4 bq = *(const float4*)(p.ln1_b + c);
      float h0 = v[i].x * rstd * gq.x + bq.x, h1 = v[i].y * rstd * gq.y + bq.y;
      float h2 = v[i].z * rstd * gq.z + bq.z, h3 = v[i].w * rstd * gq.w + bq.w;
      *(uint2*)((u16*)(ws + O_HBF) + (long)row * 2048 + c) = make_uint2(pk2(h0, h1), pk2(h2, h3));
      const float hh[4] = {h0, h1, h2, h3};
#pragma unroll
      for (int q = 0; q < 4; ++q) {
        const float4* wr = (const float4*)(p.w_router + (long)(c + q) * 16);
#pragma unroll
        for (int e4 = 0; e4 < 4; ++e4) {
          float4 w = wr[e4];
          lg[e4 * 4 + 0] += hh[q] * w.x; lg[e4 * 4 + 1] += hh[q] * w.y;
          lg[e4 * 4 + 2] += hh[q] * w.z; lg[e4 * 4 + 3] += hh[q] * w.w;
        }
      }
    }
    float mx = -1e30f;
#pragma unroll
    for (int e = 0; e < 16; ++e) { lg[e] = allred64(lg[e]); mx = fmaxf(mx, lg[e]); }
    float den = 0.f;
#pragma unroll
    for (int e = 0; e < 16; ++e) { lg[e] = __expf(lg[e] - mx); den += lg[e]; }
    const float inv = 1.f / den;
    float mine = 0.f;
#pragma unroll
    for (int e = 0; e < 16; ++e) if (lane == e) mine = lg[e] * inv;
    if (lane < 16) {
      const int b = row >> 12, s = row & 4095;
      ((float*)(ws + O_AFF))[((long)(b * 16 + lane)) * 4096 + s] = mine;
      ((int*)(ws + O_INV))[row * 16 + lane] = -1;
    }
  }
}

DEVINL void phase8(const Params& p) {
  char* ws = p.ws;
  const int bid = blockIdx.x, nb = gridDim.x, tid = otid();
  for (int pr = bid; pr < 32; pr += nb) {
    const int b = pr >> 4, e = pr & 15;
    unsigned* cnt = (unsigned*)dynsmem;
    const float* aff = (const float*)(ws + O_AFF) + (long)pr * 4096;
    const int lane = tid & 63;
    unsigned key[8];
#pragma unroll
    for (int i = 0; i < 8; ++i) key[i] = __float_as_uint(aff[tid + 512 * i]);
    if (tid < 40) cnt[tid] = 0u;
    __syncthreads();
    unsigned T = 0u;
    for (int bit = 30; bit >= 0; --bit) {
      const unsigned cand = T | (1u << bit);
      int c = 0;
#pragma unroll
      for (int i = 0; i < 8; ++i) c += (key[i] >= cand) ? 1 : 0;
      const float cf = allred64((float)c);
      if (lane == 0) atomicAdd(&cnt[bit], (unsigned)cf);
      __syncthreads();
      if (cnt[bit] >= 512u) T = cand;
    }
    {
      int c = 0;
#pragma unroll
      for (int i = 0; i < 8; ++i) c += (key[i] > T) ? 1 : 0;
      const float cf = allred64((float)c);
      if (lane == 0) atomicAdd(&cnt[31], (unsigned)cf);
      __syncthreads();
    }
    const unsigned ngt = cnt[31];
#pragma unroll
    for (int i = 0; i < 8; ++i) {
      int slot = -1;
      if (key[i] > T) slot = (int)atomicAdd(&cnt[32], 1u);
      else if (key[i] == T) { unsigned s2 = atomicAdd(&cnt[33], 1u); if (ngt + s2 < 512u) slot = (int)(ngt + s2); }
      if (slot >= 0) {
        ((int*)(ws + O_SELT))[e * 1024 + b * 512 + slot] = b * 4096 + tid + 512 * i;
        ((float*)(ws + O_SELG))[e * 1024 + b * 512 + slot] = __uint_as_float(key[i]);
        ((int*)(ws + O_INV))[(b * 4096 + tid + 512 * i) * 16 + e] = e * 1024 + b * 512 + slot;
      }
    }
    __syncthreads();
  }
  {
    unsigned* ticket = (unsigned*)(ws + O_BAR);
    volatile int* slot = (volatile int*)(dynsmem + 120000);
    for (;;) {
      if (tid == 0) *slot = (int)atomicAdd(ticket, 1u);
      __syncthreads();
      const int t = *slot;
      if (t >= 16 * 128 * 3) break;
      const int which = t / (16 * 128), r = t % (16 * 128), e = r >> 7, tt = r & 127;
      if (which < 2) {
        const float* src = (which ? p.w3 : p.w1) + (long)e * 2048 * 1024;
        int kt = tt & 31, ntile = tt >> 5;
        tr_tile(src, 1024, 1024, kt * 64, ntile * 256, (u16*)(ws + O_W13T) + (long)e * 2048 * 2048, 2048, 128, 256, which * 128);
      } else {
        const float* src = p.w2 + (long)e * 1024 * 2048;
        int kt = tt & 15, ntile = tt >> 4;
        tr_tile(src, 2048, 2048, kt * 64, ntile * 256, (u16*)(ws + O_W2T) + (long)e * 2048 * 1024, 1024, 1 << 30, 0, 0);
      }
    }
  }
}

DEVINL void phase9(const Params& p) {
  const u16* A = (const u16*)(p.ws + O_XE);
  for (int t = blockIdx.x; t < 512; t += gridDim.x) {
    const int e = ((t >> 8) << 3) + (t & 7), pm = (t >> 3) & 3, pn = (t >> 5) & 7;
    const u16* Bt = (const u16*)(p.ws + O_W13T) + (long)e * 2048 * 2048;
    gemm_tile<EPI_HID, true>(p, (const u16*)(p.ws + O_HBF), 2048, (const int*)(p.ws + O_SELT), Bt, 2048, 2048, e * 1024 + pm * 256, pn * 256, e * 1024 + pm * 256, pn * 128);
  }
}
DEVINL void phase10(const Params& p) {
  const u16* A = (const u16*)(p.ws + O_HID);
  for (int t = blockIdx.x; t < 512; t += gridDim.x) {
    const int e = ((t >> 8) << 3) + (t & 7), pm = (t >> 3) & 3, pn = (t >> 5) & 7;
    const u16* Bt = (const u16*)(p.ws + O_W2T) + (long)e * 2048 * 1024;
    gemm_tile<EPI_MOE2, false>(p, A, 1024, nullptr, Bt, 1024, 1024, e * 1024 + pm * 256, pn * 256, e * 1024 + pm * 256, pn * 256);
  }
}

DEVINL void phase11(const Params& p) {
  const int tid = otid();
  const int lane = tid & 63;
  const int gw = blockIdx.x * 8 + (tid >> 6), nw = gridDim.x * 8;
  for (int row = gw; row < T_; row += nw) {
    const u16* hb = (const u16*)(p.ws + O_HBF) + (long)row * 2048;
    float4 v[8];
    float sum = 0.f;
#pragma unroll
    for (int i = 0; i < 8; ++i) {
      const uint2 q = *(const uint2*)(hb + i * 256 + lane * 4);
      v[i] = make_float4(ALPHA * bflo(q.x), ALPHA * bfhi(q.x), ALPHA * bflo(q.y), ALPHA * bfhi(q.y));
    }
    {
      const int* inv = (const int*)(p.ws + O_INV) + row * 16;
      const int myinv = inv[lane & 15];
#pragma unroll 1
      for (int e = 0; e < 16; ++e) {
        const int er = __shfl(myinv, e);
        if (er >= 0) {
          const u16* eo = (const u16*)(p.ws + O_EO) + (long)er * 2048 + lane * 4;
#pragma unroll
          for (int i = 0; i < 8; ++i) {
            uint2 q = *(const uint2*)(eo + i * 256);
            v[i].x += bflo(q.x); v[i].y += bfhi(q.x); v[i].z += bflo(q.y); v[i].w += bfhi(q.y);
          }
        }
      }
    }
#pragma unroll
    for (int i = 0; i < 8; ++i) sum += v[i].x + v[i].y + v[i].z + v[i].w;
    const float mu = allred64(sum) * (1.f / 2048.f);
    float sq = 0.f;
#pragma unroll
    for (int i = 0; i < 8; ++i) {
      v[i].x -= mu; v[i].y -= mu; v[i].z -= mu; v[i].w -= mu;
      sq += v[i].x * v[i].x + v[i].y * v[i].y + v[i].z * v[i].z + v[i].w * v[i].w;
    }
    const float rstd = rsqrtf(allred64(sq) * (1.f / 2048.f) + 1e-5f);
#pragma unroll
    for (int i = 0; i < 8; ++i) {
      const int c = i * 256 + lane * 4;
      float4 gq = *(const float4*)(p.ln2_g + c);
      float4 bq = *(const float4*)(p.ln2_b + c);
      const f32x4 ov = {v[i].x * rstd * gq.x + bq.x, v[i].y * rstd * gq.y + bq.y, v[i].z * rstd * gq.z + bq.z, v[i].w * rstd * gq.w + bq.w};
      __builtin_nontemporal_store(ov, (f32x4*)(p.out + (long)row * 2048 + c));
    }
  }
}

#define XB_TMO      128
#define XB_XCNT(j)  (256  + 64 * (j))
#define XB_XSUB(j)  (1280 + 64 * (j))
#define XB_XGEN(j)  (2304 + 64 * (j))
#define XB_TOP      3328
#define XB_TOPGEN   3392
#define XCD_BAR_WORDS 3456
#define XB_SPIN_CAP (1u << 20)
#define LAS __attribute__((address_space(3)))
DEVINL unsigned xb_ld(unsigned* p_) { return __hip_atomic_load(p_, __ATOMIC_RELAXED, __HIP_MEMORY_SCOPE_AGENT); }
DEVINL unsigned xb_add(unsigned* p_, unsigned v) { return __hip_atomic_fetch_add(p_, v, __ATOMIC_RELAXED, __HIP_MEMORY_SCOPE_AGENT); }
DEVINL unsigned xb_xcc_id() { return (unsigned)__builtin_amdgcn_s_getreg((3 << 11) | 20) & 0xFu; }
#define XB_SPIN(cond, bar) do { unsigned _sp = 0; while (cond) { __builtin_amdgcn_s_sleep(1); \
    if ((++_sp & 255u) == 0u) { if (xb_ld(&(bar)[XB_TMO])) break; if (_sp > XB_SPIN_CAP) { atomicAdd(&(bar)[XB_TMO], 1u); break; } } } } while (0)
struct XcdBarrier { unsigned* bar; unsigned x; volatile LAS unsigned* st; };
DEVINL XcdBarrier xcd_barrier_post(unsigned* bar, volatile LAS unsigned* st) {
  XcdBarrier b; b.bar = bar; b.x = xb_xcc_id(); b.st = st;
  if (threadIdx.x == 0) (void)xb_add(&bar[XB_XCNT(b.x)], 1u);
  return b;
}
DEVINL void xcd_barrier_complete(unsigned* bar, unsigned x, unsigned& nloc, unsigned& nx) {
  const unsigned G = gridDim.x * gridDim.y * gridDim.z;
  unsigned sum, cnt, mine, sp = 0u;
  for (;;) {
    sum = 0u; cnt = 0u; mine = 0u;
#pragma unroll
    for (unsigned j = 0; j < 16; ++j) { const unsigned c = xb_ld(&bar[XB_XCNT(j)]); sum += c; cnt += (c > 0u) ? 1u : 0u; mine = (j == x) ? c : mine; }
    if (sum == G) break;
    __builtin_amdgcn_s_sleep(1);
    if ((++sp & 255u) == 0u) { if (xb_ld(&bar[XB_TMO])) break; if (sp > XB_SPIN_CAP) { atomicAdd(&bar[XB_TMO], 1u); break; } }
  }
  nloc = mine > 0u ? mine : 1u; nx = cnt > 0u ? cnt : 1u;
}
DEVINL void xcd_barrier(const XcdBarrier& b) {
  asm volatile("s_waitcnt vmcnt(0)" ::: "memory");
  __syncthreads();
  if (threadIdx.x == 0) {
    unsigned* bar = b.bar;
    __builtin_amdgcn_s_waitcnt(0);
    unsigned nloc = b.st[0], nx = b.st[1];
    if (nloc == 0u) { xcd_barrier_complete(bar, b.x, nloc, nx); b.st[0] = nloc; b.st[1] = nx; }
    const unsigned old = xb_add(&bar[XB_XSUB(b.x)], 1u);
    const unsigned gen = old / nloc;
    if (old + 1u == (gen + 1u) * nloc) {
      __builtin_amdgcn_fence(__ATOMIC_RELEASE, "agent");
      asm volatile("s_waitcnt vmcnt(0)" ::: "memory");
      const unsigned og = xb_add(&bar[XB_TOP], 1u);
      const unsigned tg = og / nx;
      if (og + 1u == (tg + 1u) * nx) xb_add(&bar[XB_TOPGEN], 1u);
      else XB_SPIN(xb_ld(&bar[XB_TOPGEN]) == tg, bar);
      __builtin_amdgcn_fence(__ATOMIC_ACQUIRE, "agent");
      xb_add(&bar[XB_XGEN(b.x)], 1u);
      asm volatile("s_waitcnt vmcnt(0)" ::: "memory");
    } else {
      XB_SPIN(xb_ld(&bar[XB_XGEN(b.x)]) == gen, bar);
      __builtin_amdgcn_fence(__ATOMIC_ACQUIRE, "agent");
      asm volatile("s_waitcnt vmcnt(0)" ::: "memory");
    }
  }
  __syncthreads();
}

template <int PH> DEVINL void run_phase(const Params& p) {
  if (PH == 0) phase0(p);
  else if (PH == 1) phase1(p);
  else if (PH == 2) phase2(p);
  else if (PH == 3) phase3(p);
  else if (PH == 4) phase4(p);
  else if (PH == 5) phase5(p);
  else if (PH == 6) phase6(p);
  else if (PH == 7) phase7(p);
  else if (PH == 8) phase8(p);
  else if (PH == 9) phase9(p);
  else if (PH == 10) phase10(p);
  else if (PH == 11) phase11(p);
}

constexpr int SHM_BYTES = 131072;

#if MULTI
template <int PH> __global__ void __launch_bounds__(512, 2) k_phase(Params p) { run_phase<PH>(p); }
template <int PH> static void launch_phase(const Params& p, hipStream_t stream) {
  hipFuncSetAttribute((const void*)k_phase<PH>, hipFuncAttributeMaxDynamicSharedMemorySize, SHM_BYTES);
  k_phase<PH><<<256, 512, SHM_BYTES, stream>>>(p);
}
#else
__global__ void __launch_bounds__(512, 2) k_mega(Params p) {
  cg::grid_group grid = cg::this_grid();
  __shared__ uint4 xb_words;
  unsigned* bar = (unsigned*)(p.ws + O_BAR);
  if (threadIdx.x == 0) xb_words = make_uint4(0u, 0u, 0u, 0u);
  __syncthreads();
  XcdBarrier xb = xcd_barrier_post(bar, (volatile LAS unsigned*)&xb_words);
  if (p.out == nullptr) grid.sync();
  run_phase<0>(p); xcd_barrier(xb);
  run_phase<1>(p); xcd_barrier(xb);
  run_phase<2>(p); xcd_barrier(xb);
  run_phase<3>(p); xcd_barrier(xb);
  run_phase<4>(p); xcd_barrier(xb);
  run_phase<5>(p); xcd_barrier(xb);
  run_phase<6>(p); xcd_barrier(xb);
  run_phase<7>(p); xcd_barrier(xb);
  run_phase<8>(p); xcd_barrier(xb);
  run_phase<9>(p); xcd_barrier(xb);
  run_phase<10>(p); xcd_barrier(xb);
  run_phase<11>(p);
}
#endif

extern "C" void kernel_launch(void* const* d_in, const int* in_sizes, int n_in, void* d_out, int out_size,
                              void* d_ws, size_t ws_size, hipStream_t stream) {
  Params p{};
  const float** f = (const float**)&p;
  for (int i = 0; i < 31; ++i) f[i] = (const float*)d_in[i];
  p.out = (float*)d_out;
  p.ws = (char*)d_ws;
  if (ws_size < WS_NEED) { fprintf(stderr, "workspace too small: %zu < %zu\n", ws_size, (size_t)WS_NEED); return; }
#if MULTI
  launch_phase<0>(p, stream); launch_phase<1>(p, stream); launch_phase<2>(p, stream); launch_phase<3>(p, stream);
  launch_phase<4>(p, stream); launch_phase<5>(p, stream); launch_phase<6>(p, stream); launch_phase<7>(p, stream);
  launch_phase<8>(p, stream); launch_phase<9>(p, stream); launch_phase<10>(p, stream); launch_phase<11>(p, stream);
#else
  static int grid_blocks = 0;
  if (!grid_blocks) {
    int dev = 0, cus = 0, per_cu = 0;
    hipGetDevice(&dev);
    hipDeviceGetAttribute(&cus, hipDeviceAttributeMultiprocessorCount, dev);
    hipFuncSetAttribute((const void*)k_mega, hipFuncAttributeMaxDynamicSharedMemorySize, SHM_BYTES);
    hipOccupancyMaxActiveBlocksPerMultiprocessor(&per_cu, k_mega, 512, SHM_BYTES);
    if (per_cu < 1) per_cu = 1;
    grid_blocks = cus * per_cu;
    if (grid_blocks > 256) grid_blocks = 256;
  }
  hipMemsetAsync((char*)d_ws + O_BAR, 0, XCD_BAR_WORDS * sizeof(unsigned), stream);
  void* args[] = {&p};
  hipError_t e = hipLaunchCooperativeKernel((void*)k_mega, dim3(grid_blocks), dim3(512), args, SHM_BYTES, stream);
  if (e != hipSuccess) fprintf(stderr, "cooperative launch failed: %s (grid %d)\n", hipGetErrorString(e), grid_blocks);
#endif
}
```

```cpp
#include <hip/hip_runtime.h>
#include <hip/hip_cooperative_groups.h>
#include <cstdio>
namespace cg = cooperative_groups;

#ifndef MULTI
#define MULTI 0
#endif

typedef unsigned short u16;
typedef __bf16 bf2_t __attribute__((ext_vector_type(2)));
typedef float f2_t __attribute__((ext_vector_type(2)));
using bf16x8 = __attribute__((ext_vector_type(8))) short;
using s16x4 = __attribute__((ext_vector_type(4))) short;
using f32x4 = __attribute__((ext_vector_type(4))) float;
#define DEVINL __device__ __forceinline__

constexpr int T_ = 8192, S_ = 4096, D_ = 2048, NC = 10592, NCP = 10752;
constexpr int C_Q = 0, C_K = 512, C_V = 1024, C_G = 2048, C_AF = 3072, C_RW = 3104;
constexpr int C_GG = 6496, C_GR = 8544;
constexpr float ALPHA = 1.189207115f;

constexpr size_t MB = 1ull << 20;
constexpr size_t O_XBF = 0;
constexpr size_t O_WINT = 32 * MB;
constexpr size_t O_OSUM = 0;
constexpr size_t O_YSUM = 32 * MB;
constexpr size_t O_R1 = 0;
constexpr size_t O_COLS = 76 * MB;
constexpr size_t O_ACC2 = 76 * MB;
constexpr size_t O_W13T = 140 * MB;
constexpr size_t O_W2T = 268 * MB;
constexpr size_t O_HID = 332 * MB;
constexpr size_t O_REC = 244 * MB;
constexpr size_t O_YGLA = 244 * MB;
constexpr size_t O_YRW = 260 * MB;
constexpr size_t O_MERGED = 276 * MB;
constexpr size_t O_QT = 372 * MB;
constexpr size_t O_KT = 388 * MB;
constexpr size_t O_KDT = 404 * MB;
constexpr size_t O_VT = 420 * MB;
constexpr size_t O_DEC = 436 * MB;
constexpr size_t O_M1 = 372 * MB;
constexpr size_t O_HBF = 372 * MB;
constexpr size_t O_XE = 404 * MB;
constexpr size_t O_VSCAN = 437 * MB;
constexpr size_t O_GRW = 453 * MB;
constexpr size_t O_BONUS = 469 * MB;
constexpr size_t O_WUPGT = 485 * MB;
constexpr size_t O_WUPRT = 489 * MB;
constexpr size_t O_WOUTT = 493 * MB;
constexpr size_t O_LWF = 501 * MB;
constexpr size_t O_LWB = O_LWF + 128 * 1024;
constexpr size_t O_LA = O_LWB + 128 * 1024;
constexpr size_t O_LG = O_LA + 128 * 1024;
constexpr size_t O_AFF = 502 * MB;
constexpr size_t O_SELT = O_AFF + 512 * 1024;
constexpr size_t O_SELG = O_SELT + 64 * 1024;
constexpr size_t O_YB = 503 * MB;
constexpr size_t O_EO = 140 * MB;
constexpr size_t O_INV = 535 * MB;
constexpr size_t O_BAR = 535 * MB + 768 * 1024;
constexpr size_t WS_NEED = 536 * MB;

struct Params {
  const float *x, *w_in, *gla_a_up_f, *gla_a_bias_f, *gla_a_up_b, *gla_a_bias_b, *gla_norm_g;
  const float *rw_mu, *rw_w0_f, *rw_w_up_f, *rw_w0_b, *rw_w_up_b, *rw_a0, *rw_a_up, *rw_g_up;
  const float *rw_k_k, *rw_k_a, *rw_r_k, *rw_ln_g, *rw_ln_b, *w_up_gla, *w_up_rwkv, *w_out;
  const float *ln1_g, *ln1_b, *w_router, *w1, *w3, *w2, *ln2_g, *ln2_b;
  float* out;
  char* ws;
};

DEVINL unsigned pk2(float a, float b) {
  f2_t v = {a, b};
  bf2_t r = __builtin_convertvector(v, bf2_t);
  return *(unsigned*)&r;
}
DEVINL u16 f2bf(float a) { return (u16)(pk2(a, 0.f) & 0xffffu); }
DEVINL float bf2f(u16 h) { return __uint_as_float(((unsigned)h) << 16); }
DEVINL float bflo(unsigned u) { return __uint_as_float(u << 16); }
DEVINL float bfhi(unsigned u) { return __uint_as_float(u & 0xffff0000u); }
DEVINL float sigm(float x) { return 1.f / (1.f + __expf(-x)); }
DEVINL float tanh_(float x) { return 1.f - 2.f / (__expf(2.f * x) + 1.f); }
DEVINL float logsig(float z) { return fminf(z, 0.f) - __logf(1.f + __expf(-fabsf(z))); }
template <int CTRL> DEVINL float dppf(float x) {
  return __int_as_float(__builtin_amdgcn_update_dpp(0, __float_as_int(x), CTRL, 0xF, 0xF, true));
}
DEVINL float allred16(float x) {
  x += dppf<0xB1>(x); x += dppf<0x4E>(x); x += dppf<0x141>(x); x += dppf<0x140>(x);
  return x;
}
DEVINL void allred16x2(float& a, float& b) {
  a += dppf<0xB1>(a); b += dppf<0xB1>(b);
  a += dppf<0x4E>(a); b += dppf<0x4E>(b);
  a += dppf<0x141>(a); b += dppf<0x141>(b);
  a += dppf<0x140>(a); b += dppf<0x140>(b);
}
DEVINL float allred64(float x) {
  x = allred16(x);
  x += __int_as_float(__builtin_amdgcn_update_dpp(0, __float_as_int(x), 0x142, 0xA, 0xF, false));
  x += __int_as_float(__builtin_amdgcn_update_dpp(0, __float_as_int(x), 0x143, 0xC, 0xF, false));
  return __int_as_float(__builtin_amdgcn_readlane(__float_as_int(x), 63));
}
DEVINL bf16x8 mk8(s16x4 lo, s16x4 hi) {
  bf16x8 r;
  r[0] = lo[0]; r[1] = lo[1]; r[2] = lo[2]; r[3] = lo[3];
  r[4] = hi[0]; r[5] = hi[1]; r[6] = hi[2]; r[7] = hi[3];
  return r;
}
DEVINL bf16x8 pack8(f32x4 a, f32x4 b) {
  union { bf16x8 v; unsigned u[4]; } r;
  r.u[0] = pk2(a[0], a[1]); r.u[1] = pk2(a[2], a[3]);
  r.u[2] = pk2(b[0], b[1]); r.u[3] = pk2(b[2], b[3]);
  return r.v;
}
DEVINL int fragpos(int idx) { const int w = idx & 31; return (idx & ~31) + (((w & 15) >> 2) << 3) + (w & 3) + ((w >> 4) << 2); }
DEVINL bf16x8 ld16(const u16* base) { return *(const bf16x8*)base; }
DEVINL bf16x8 ldfrag(const u16* base) {
  s16x4 lo = *(const s16x4*)base;
  s16x4 hi = *(const s16x4*)(base + 16);
  return mk8(lo, hi);
}
DEVINL float sel4(f32x4 v, int j) { return j == 0 ? v[0] : (j == 1 ? v[1] : (j == 2 ? v[2] : v[3])); }
DEVINL u16 f2h(float a) { _Float16 h = (_Float16)a; return __builtin_bit_cast(u16, h); }
DEVINL float fmix_lo(float s, unsigned h, float c) {
  float d; asm("v_fma_mix_f32 %0, %1, %2, %3 op_sel:[0,0,0] op_sel_hi:[0,1,0]" : "=v"(d) : "v"(s), "v"(h), "v"(c)); return d;
}
DEVINL float fmix_hi(float s, unsigned h, float c) {
  float d; asm("v_fma_mix_f32 %0, %1, %2, %3 op_sel:[0,1,0] op_sel_hi:[0,1,0]" : "=v"(d) : "v"(s), "v"(h), "v"(c)); return d;
}
DEVINL float fmixhh_lo(unsigned vh, unsigned h, float c) {
  float d; asm("v_fma_mix_f32 %0, %1, %2, %3 op_sel:[0,0,0] op_sel_hi:[1,1,0]" : "=v"(d) : "v"(vh), "v"(h), "v"(c)); return d;
}
DEVINL float fmixhh_hi(unsigned vh, unsigned h, float c) {
  float d; asm("v_fma_mix_f32 %0, %1, %2, %3 op_sel:[0,1,0] op_sel_hi:[1,1,0]" : "=v"(d) : "v"(vh), "v"(h), "v"(c)); return d;
}
DEVINL float fmul_hi(float s, unsigned h) {
  float d; asm("v_fma_mix_f32 %0, %1, %2, 0 op_sel:[0,1,0] op_sel_hi:[0,1,0]" : "=v"(d) : "v"(s), "v"(h)); return d;
}
DEVINL float fmul_lo(float s, unsigned h) {
  float d; asm("v_fma_mix_f32 %0, %1, %2, 0 op_sel:[0,0,0] op_sel_hi:[0,1,0]" : "=v"(d) : "v"(s), "v"(h)); return d;
}
#define MFMA16(a, b, c) __builtin_amdgcn_mfma_f32_16x16x32_bf16(a, b, c, 0, 0, 0)

extern __shared__ __attribute__((aligned(16))) char dynsmem[];
extern __shared__ __attribute__((aligned(16))) char dynsmem_rd[];
DEVINL int otid() { int t = threadIdx.x; asm volatile("" : "+v"(t)); return t; }

constexpr int BM = 256, BK = 64, HALF = 128, HT = HALF * BK;
DEVINL int lds_byte(int r, int c) {
  int st = (r >> 4) * 2 + (c >> 5), rr = r & 15, cc = c & 31, ob = rr * 64 + cc * 2;
  return st * 1024 + (ob ^ (((ob >> 9) & 1) << 5));
}
DEVINL void stage_rc(int b, int& R, int& C) {
  int st = b / 1024, sb = b % 1024, swz = sb ^ (((sb >> 9) & 1) << 5);
  R = (st >> 1) * 16 + swz / 64; C = (st & 1) * 32 + (swz % 64) / 2;
}

DEVINL void xchg_pairs(f32x4 v, bool odd, float (&lo)[2], float (&hi)[2]) {
  const float s0 = odd ? v[0] : v[2], s1 = odd ? v[1] : v[3];
  const float r0 = dppf<0xB1>(s0), r1 = dppf<0xB1>(s1);
  lo[0] = odd ? r0 : v[0]; hi[0] = odd ? v[2] : r0;
  lo[1] = odd ? r1 : v[1]; hi[1] = odd ? v[3] : r1;
}
enum { EPI_COLS = 0, EPI_M1, EPI_MERGED, EPI_R1, EPI_HID, EPI_MOE2 };

template <int EPI, bool GATHER>
DEVINL void gemm_tile(const Params& p, const u16* __restrict__ A, int lda, const int* __restrict__ rowidx,
                      const u16* __restrict__ Bt, int ldb, int K, int brow, int bcol, int orow, int ocol) {
  u16* shm = (u16*)dynsmem;
#define SA(b, h) (shm + ((b) * 2 + (h)) * HT)
#define SB(b, h) (shm + (4 + (b) * 2 + (h)) * HT)
  const int tid = otid();
  int offA[2][2], offB[2];
#pragma unroll
  for (int i = 0; i < 2; ++i) {
    int R, C; stage_rc(tid * 16 + i * 8192, R, C);
    offB[i] = R * ldb + C;
#pragma unroll
    for (int h = 0; h < 2; ++h) {
      if (GATHER) offA[h][i] = rowidx[brow + h * HALF + R] * lda + C;
      else offA[h][i] = R * lda + C;
    }
  }
  const u16* Ab[2]; const u16* Bb[2];
#pragma unroll
  for (int h = 0; h < 2; ++h) {
    Ab[h] = GATHER ? A : (A + (long)(brow + h * HALF) * lda);
    Bb[h] = Bt + (long)(bcol + h * HALF) * ldb;
  }
#define STAGE_A(b, h, kt) do { _Pragma("unroll") for (int _i = 0; _i < 2; ++_i) \
    __builtin_amdgcn_global_load_lds((const unsigned*)(Ab[h] + (kt) * BK + offA[GATHER ? h : 0][_i]), \
      (__attribute__((address_space(3))) unsigned*)((char*)SA(b, h) + tid * 16 + _i * 8192), 16, 0, 0); } while (0)
#define STAGE_B(b, h, kt) do { _Pragma("unroll") for (int _i = 0; _i < 2; ++_i) \
    __builtin_amdgcn_global_load_lds((const unsigned*)(Bb[h] + (kt) * BK + offB[_i]), \
      (__attribute__((address_space(3))) unsigned*)((char*)SB(b, h) + tid * 16 + _i * 8192), 16, 0, 0); } while (0)
#define LDA(dst, b, h) _Pragma("unroll") for (int m = 0; m < 4; ++m) _Pragma("unroll") for (int k = 0; k < 2; ++k) \
    dst[m][k] = *reinterpret_cast<const bf16x8*>((char*)SA(b, h) + lds_byte(wr * 64 + m * 16 + fr, k * 32 + fq * 8))
#define LDB(dst, b, h) _Pragma("unroll") for (int n = 0; n < 2; ++n) _Pragma("unroll") for (int k = 0; k < 2; ++k) \
    dst[n][k] = *reinterpret_cast<const bf16x8*>((char*)SB(b, h) + lds_byte(wc * 32 + n * 16 + fr, k * 32 + fq * 8))
#define MMA(ai, bj, At_, Bt_) do { __builtin_amdgcn_s_setprio(1); \
    _Pragma("unroll") for (int m = 0; m < 4; ++m) _Pragma("unroll") for (int n = 0; n < 2; ++n) _Pragma("unroll") for (int k = 0; k < 2; ++k) \
      acc[ai][bj][m][n] = MFMA16(At_[m][k], Bt_[n][k], acc[ai][bj][m][n]); \
    __builtin_amdgcn_s_setprio(0); } while (0)
#define WAIT_V(n) asm volatile("s_waitcnt vmcnt(" #n ")" ::: "memory")
#define WAIT_L(n) asm volatile("s_waitcnt lgkmcnt(" #n ")" ::: "memory")
#define BAR __builtin_amdgcn_s_barrier()
#define SCHED __builtin_amdgcn_sched_barrier(0)

  const int wid = tid >> 6, lane = tid & 63, wr = wid >> 2, wc = wid & 3, fr = lane & 15, fq = lane >> 4;
  f32x4 acc[2][2][4][2] = {};
  bf16x8 At[4][2], B0[2][2], B1[2][2];
  const int nt = K / BK;
  STAGE_B(0, 0, 0); STAGE_A(0, 0, 0);
  STAGE_B(0, 1, 0); STAGE_A(0, 1, 0);
  if (wr == 1) BAR;
  WAIT_V(4); BAR;
  STAGE_B(1, 0, 1); STAGE_A(1, 0, 1); STAGE_B(1, 1, 1);
  WAIT_V(6); BAR;
  for (int t = 0; t < nt - 2; t += 2) {
    LDB(B0, 0, 0); SCHED; LDA(At, 0, 0); STAGE_A(1, 1, t + 1);
    WAIT_L(8); BAR; WAIT_L(0); MMA(0, 0, At, B0); BAR; SCHED;
    LDB(B1, 0, 1); STAGE_B(0, 0, t + 2);
    BAR; WAIT_L(0); MMA(0, 1, At, B1); BAR;
    LDA(At, 0, 1); STAGE_A(0, 0, t + 2);
    BAR; WAIT_L(0); MMA(1, 0, At, B0); BAR; SCHED;
    STAGE_B(0, 1, t + 2);
    WAIT_V(6); BAR; MMA(1, 1, At, B1); BAR;
    LDB(B0, 1, 0); SCHED; LDA(At, 1, 0); STAGE_A(0, 1, t + 2);
    WAIT_L(8); BAR; WAIT_L(0); MMA(0, 0, At, B0); BAR; SCHED;
    LDB(B1, 1, 1); STAGE_B(1, 0, t + 3);
    BAR; WAIT_L(0); MMA(0, 1, At, B1); BAR;
    LDA(At, 1, 1); STAGE_A(1, 0, t + 3);
    BAR; WAIT_L(0); MMA(1, 0, At, B0); BAR; SCHED;
    STAGE_B(1, 1, t + 3);
    WAIT_V(6); BAR; MMA(1, 1, At, B1); BAR;
  }
  { LDB(B0, 0, 0); LDA(At, 0, 0); STAGE_A(1, 1, nt - 1);
    BAR; WAIT_L(0); MMA(0, 0, At, B0); BAR;
    LDB(B1, 0, 1); BAR; WAIT_L(0); MMA(0, 1, At, B1); BAR;
    LDA(At, 0, 1); WAIT_V(4); BAR; WAIT_L(0); MMA(1, 0, At, B0); MMA(1, 1, At, B1); BAR; }
  { LDB(B0, 1, 0); LDA(At, 1, 0); WAIT_V(2); BAR; WAIT_L(0); MMA(0, 0, At, B0); BAR;
    LDB(B1, 1, 1); WAIT_V(0); BAR; WAIT_L(0); MMA(0, 1, At, B1); BAR;
    LDA(At, 1, 1); BAR; WAIT_L(0); MMA(1, 0, At, B0); MMA(1, 1, At, B1); BAR; }
  if (wr == 0) BAR;

  char* ws = p.ws;
  const int row0 = orow + wr * 64 + fq * 4;
  const int col0 = ocol + wc * 32 + fr;
  const bool odd = (fr & 1) != 0;
  const int colp = col0 - (odd ? 1 : 0);
#pragma unroll
  for (int ai = 0; ai < 2; ++ai)
#pragma unroll
    for (int m = 0; m < 4; ++m) {
      const int rA = row0 + ai * HALF + m * 16 + (odd ? 2 : 0);
      float gate[2] = {0.f, 0.f};
      if (EPI == EPI_MOE2) { gate[0] = ((const float*)(ws + O_SELG))[rA]; gate[1] = ((const float*)(ws + O_SELG))[rA + 1]; }
#pragma unroll
      for (int bj = 0; bj < (EPI == EPI_HID ? 1 : 2); ++bj)
#pragma unroll
        for (int n = 0; n < 2; ++n) {
          const int cc = bj * HALF + n * 16;
          f32x4 v = acc[ai][bj][m][n];
          if (EPI == EPI_HID) {
#pragma unroll
            for (int j = 0; j < 4; ++j) { const float a1 = acc[ai][0][m][n][j], a3 = acc[ai][1][m][n][j]; v[j] = a1 * sigm(a1) * a3; }
          }
          float lo[2], hi[2];
          xchg_pairs(v, odd, lo, hi);
#pragma unroll
          for (int k = 0; k < 2; ++k) {
            const unsigned row = (unsigned)(rA + k);
            if (EPI == EPI_HID) {
              *(unsigned*)(ws + O_HID + (row * 1024u + (unsigned)(colp + cc)) * 2u) = pk2(lo[k], hi[k]);
            } else if (EPI == EPI_COLS) {
              *(unsigned*)(ws + O_COLS + (row * (unsigned)NCP + (unsigned)(colp + cc)) * 2u) = pk2(lo[k], hi[k]);
            } else if (EPI == EPI_MOE2) {
              *(unsigned*)(ws + O_EO + (row * 2048u + (unsigned)(colp + cc)) * 2u) = pk2(gate[k] * lo[k], gate[k] * hi[k]);
            } else if (EPI == EPI_M1) {
              const unsigned g2 = *(const unsigned*)(ws + O_COLS + (row * (unsigned)NCP + (unsigned)(C_GG + colp + cc)) * 2u);
              *(unsigned*)(ws + O_M1 + (row * 2048u + (unsigned)(colp + cc)) * 2u) = pk2(sigm(bflo(g2)) * lo[k], sigm(bfhi(g2)) * hi[k]);
            } else if (EPI == EPI_MERGED) {
              const unsigned g2 = *(const unsigned*)(ws + O_COLS + (row * (unsigned)NCP + (unsigned)(C_GR + colp + cc)) * 2u);
              const unsigned m1 = *(const unsigned*)(ws + O_M1 + (row * 2048u + (unsigned)(colp + cc)) * 2u);
              *(unsigned*)(ws + O_MERGED + (row * 2048u + (unsigned)(colp + cc)) * 2u) =
                  pk2(bflo(m1) + sigm(bflo(g2)) * lo[k], bfhi(m1) + sigm(bfhi(g2)) * hi[k]);
            } else if (EPI == EPI_R1) {
              const unsigned o4 = (row * 2048u + (unsigned)(colp + cc)) * 4u;
              const float2 xv = *(const float2*)((const char*)p.x + o4);
              *(unsigned*)(ws + O_R1 + (o4 >> 1)) = pk2(ALPHA * xv.x + lo[k], ALPHA * xv.y + hi[k]);
            }
          }
        }
      __builtin_amdgcn_sched_barrier(0);
    }
  __syncthreads();
#undef SA
#undef SB
}

DEVINL void tr_tile(const float* __restrict__ src, int ldsrc, int nvalid, int k0, int n0,
                    u16* __restrict__ dst, int lddst, int grp, int gstride, int goff) {
  float* tile = (float*)dynsmem;
  const int tid = otid();
  float4 v[8];
#pragma unroll
  for (int i = 0; i < 8; ++i) {
    int f = tid + i * 512; int r = f >> 6, c4 = (f & 63) * 4;
    int n = n0 + c4;
    v[i] = make_float4(0.f, 0.f, 0.f, 0.f);
    if (n < nvalid) {
      const f32x4 q = __builtin_nontemporal_load((const f32x4*)(src + (long)(k0 + r) * ldsrc + n));
      v[i] = make_float4(q[0], q[1], q[2], q[3]);
    }
  }
#pragma unroll
  for (int i = 0; i < 8; ++i) {
    int f = tid + i * 512; int r = f >> 6, c4 = (f & 63) * 4;
    float* tp = tile + r * 257 + c4;
    tp[0] = v[i].x; tp[1] = v[i].y; tp[2] = v[i].z; tp[3] = v[i].w;
  }
  __syncthreads();
  {
    const int n = tid >> 1, kc = (tid & 1) * 32;
    const float* tp = tile + kc * 257 + n;
    const int nn = n0 + n;
    const long row = (long)(nn / grp) * gstride + (nn % grp) + goff;
    uint4* dp = (uint4*)(dst + row * lddst + k0 + kc);
#pragma unroll
    for (int q = 0; q < 4; ++q) {
      uint4 o;
      o.x = pk2(tp[(q * 8 + 0) * 257], tp[(q * 8 + 1) * 257]);
      o.y = pk2(tp[(q * 8 + 2) * 257], tp[(q * 8 + 3) * 257]);
      o.z = pk2(tp[(q * 8 + 4) * 257], tp[(q * 8 + 5) * 257]);
      o.w = pk2(tp[(q * 8 + 6) * 257], tp[(q * 8 + 7) * 257]);
      dp[q] = o;
    }
  }
  __syncthreads();
}
DEVINL void tr_job(const float* src, int K, int N, int Npad, u16* dst, int bid, int nb) {
  const int tk = K / 64, tn = Npad / 256;
  for (int t = bid; t < tk * tn; t += nb) {
    int kt = t % tk, ntile = t / tk;
    tr_tile(src, N, N, kt * 64, ntile * 256, dst, K, 1 << 30, 0, 0);
  }
}

DEVINL void phase0(const Params& p) {
  char* ws = p.ws;
  const int bid = blockIdx.x, nb = gridDim.x, tid = otid();
  {
    const float4* xs = (const float4*)p.x;
    uint2* xd = (uint2*)(ws + O_XBF);
    const long n4 = (long)T_ * D_ / 4;
    const long stride = (long)nb * 512;
    for (long i = (long)bid * 512 + tid; i < n4; i += 4 * stride) {
      const f32x4* xq = (const f32x4*)xs;
      const f32x4 q0 = __builtin_nontemporal_load(xq + i), q1 = __builtin_nontemporal_load(xq + i + stride);
      const f32x4 q2 = __builtin_nontemporal_load(xq + i + 2 * stride), q3 = __builtin_nontemporal_load(xq + i + 3 * stride);
      float4 v0 = make_float4(q0[0], q0[1], q0[2], q0[3]), v1 = make_float4(q1[0], q1[1], q1[2], q1[3]);
      float4 v2 = make_float4(q2[0], q2[1], q2[2], q2[3]), v3 = make_float4(q3[0], q3[1], q3[2], q3[3]);
      xd[i] = make_uint2(pk2(v0.x, v0.y), pk2(v0.z, v0.w));
      xd[i + stride] = make_uint2(pk2(v1.x, v1.y), pk2(v1.z, v1.w));
      xd[i + 2 * stride] = make_uint2(pk2(v2.x, v2.y), pk2(v2.z, v2.w));
      xd[i + 3 * stride] = make_uint2(pk2(v3.x, v3.y), pk2(v3.z, v3.w));
    }
  }
  tr_job(p.w_in, 2048, NC, NCP, (u16*)(ws + O_WINT), bid, nb);
  tr_job(p.w_up_gla, 1024, 2048, 2048, (u16*)(ws + O_WUPGT), bid, nb);
  tr_job(p.w_up_rwkv, 1024, 2048, 2048, (u16*)(ws + O_WUPRT), bid, nb);
  tr_job(p.w_out, 2048, 2048, 2048, (u16*)(ws + O_WOUTT), bid, nb);
  tr_job(p.rw_w_up_f, 64, 1024, 1024, (u16*)(ws + O_LWF), bid, nb);
  tr_job(p.rw_w_up_b, 64, 1024, 1024, (u16*)(ws + O_LWB), bid, nb);
  tr_job(p.rw_a_up, 64, 1024, 1024, (u16*)(ws + O_LA), bid, nb);
  tr_job(p.rw_g_up, 128, 1024, 1024, (u16*)(ws + O_LG), bid, nb);
}

DEVINL void phase1(const Params& p) {
  const u16* A = (const u16*)(p.ws + O_XBF);
  const u16* Bt = (const u16*)(p.ws + O_WINT);
  const int ntiles = 32 * 42;
  for (int t = blockIdx.x; t < ntiles; t += gridDim.x) {
    int pm = t & 31, pn = t >> 5;
    gemm_tile<EPI_COLS, false>(p, A, 2048, nullptr, Bt, 2048, 2048, pm * 256, pn * 256, pm * 256, pn * 256);
  }
}

DEVINL void gla_prep_unit(const Params& p, int unit) {
  const int h = unit & 3, c = (unit >> 2) & 63, b = unit >> 8;
  char* ws = p.ws;
  const u16* cols = (const u16*)(ws + O_COLS);
  const int tid = otid();
  float* afab = (float*)dynsmem;
  float* G = (float*)(dynsmem + 8192);
  u16* KD = (u16*)(dynsmem + 8192 + 65536);
  u16* VL = (u16*)dynsmem;
  const long tok0 = (long)b * S_ + c * 64;
  for (int i = tid; i < 64 * 32; i += 512) {
    int r = i >> 5, cc = i & 31;
    afab[i] = bf2f(cols[(tok0 + r) * NCP + C_AF + cc]);
  }
  __syncthreads();
  if (tid < 256) {
    const int dir = tid >> 7, kk = tid & 127;
    const float* up = dir ? p.gla_a_up_b : p.gla_a_up_f;
    const float bias = (dir ? p.gla_a_bias_b : p.gla_a_bias_f)[h * 128 + kk];
    float u[16];
#pragma unroll
    for (int r = 0; r < 16; ++r) u[r] = up[r * 512 + h * 128 + kk];
    float* Gc = G + dir * 64 * 128 + kk;
    for (int i = 0; i < 64; ++i) {
      float z = bias;
#pragma unroll
      for (int r = 0; r < 16; ++r) z += afab[i * 32 + dir * 16 + r] * u[r];
      Gc[i * 128] = logsig(z) * (1.f / 16.f);
    }
    float run = 0.f;
    if (dir == 0) { for (int i = 0; i < 64; ++i) { run += Gc[i * 128]; Gc[i * 128] = run; } }
    else { for (int i = 63; i >= 0; --i) { run += Gc[i * 128]; Gc[i * 128] = run; } }
    const float bedge = run;
    const long hb = ((long)(dir * 2 + b) * 4 + h);
    const int pk = fragpos(kk);
    u16* qt = (u16*)(ws + O_QT) + (hb * 4096 + c * 64) * 128 + pk;
    u16* kt = (u16*)(ws + O_KT) + (hb * 4096 + c * 64) * 128 + pk;
    ((float*)(ws + O_DEC))[(hb * 64 + c) * 128 + kk] = __expf(bedge);
    u16* KDr = KD + (dir * 128 + kk) * 72;
    const unsigned short* qsrc = cols + tok0 * NCP + C_Q + h * 128 + kk;
    const unsigned short* ksrc = cols + tok0 * NCP + C_K + h * 128 + kk;
#pragma unroll 1
    for (int i0 = 0; i0 < 64; i0 += 8) {
      u16 qv[8], kv[8];
#pragma unroll
      for (int j = 0; j < 8; ++j) { qv[j] = qsrc[(long)(i0 + j) * NCP]; kv[j] = ksrc[(long)(i0 + j) * NCP]; }
#pragma unroll
      for (int j = 0; j < 8; ++j) {
        const int i = i0 + j;
        float bb = Gc[i * 128];
        float q = bf2f(qv[j]);
        float k = bf2f(kv[j]);
        qt[i * 128] = f2bf(q * 0.08838834764831845f * __expf(bb));
        kt[i * 128] = f2bf(k * __expf(-bb));
        KDr[fragpos(i)] = f2bf(k * __expf(bedge - bb));
      }
    }
  }
  __syncthreads();
#pragma unroll 8
  for (int idx = tid; idx < 64 * 256; idx += 512) {
    int i = idx >> 8, vc = idx & 255;
    VL[vc * 72 + fragpos(i)] = cols[(tok0 + i) * NCP + C_V + h * 256 + vc];
  }
  __syncthreads();
  for (int pc = tid; pc < 4096; pc += 512) {
    int row = pc >> 3, ch = pc & 7;
    if (row < 256) {
      int dir = row >> 7, kk = row & 127;
      uint4 v = *(const uint4*)(KD + row * 72 + ch * 8);
      long hb = ((long)(dir * 2 + b) * 4 + h);
      *(uint4*)((u16*)(ws + O_KDT) + ((hb * 64 + c) * 128 + kk) * 64 + ch * 8) = v;
    } else {
      int vc = row - 256;
      uint4 v = *(const uint4*)(VL + vc * 72 + ch * 8);
      long hb = ((long)b * 4 + h);
      *(uint4*)((u16*)(ws + O_VT) + ((hb * 64 + c) * 256 + vc) * 64 + ch * 8) = v;
    }
  }
  __syncthreads();
}

DEVINL float rw_shift2(const char* colsb, float muv, unsigned o, int s) {
  const unsigned op = (s > 0) ? o - (unsigned)(NCP * 2) : o;
  const unsigned on = (s < S_ - 1) ? o + (unsigned)(NCP * 2) : o;
  float cur = bf2f(*(const u16*)(colsb + o));
  float prv = bf2f(*(const u16*)(colsb + op));
  float nxt = bf2f(*(const u16*)(colsb + on));
  if (s == 0) prv = 0.f;
  if (s == S_ - 1) nxt = 0.f;
  return cur + muv * (0.5f * (prv + nxt) - cur);
}

DEVINL void rw_shift4(const char* colsb, float4 mu, unsigned o, int s, float (&out)[4]) {
  const unsigned op = (s > 0) ? o - (unsigned)(NCP * 2) : o;
  const unsigned on = (s < S_ - 1) ? o + (unsigned)(NCP * 2) : o;
  const uint2 c = *(const uint2*)(colsb + o);
  uint2 pv = *(const uint2*)(colsb + op);
  uint2 nx = *(const uint2*)(colsb + on);
  if (s == 0) pv = make_uint2(0u, 0u);
  if (s == S_ - 1) nx = make_uint2(0u, 0u);
  const float cu[4] = {bflo(c.x), bfhi(c.x), bflo(c.y), bfhi(c.y)};
  const float pr[4] = {bflo(pv.x), bfhi(pv.x), bflo(pv.y), bfhi(pv.y)};
  const float nn[4] = {bflo(nx.x), bfhi(nx.x), bflo(nx.y), bfhi(nx.y)};
  const float m[4] = {mu.x, mu.y, mu.z, mu.w};
#pragma unroll
  for (int e = 0; e < 4; ++e) out[e] = cu[e] + m[e] * (0.5f * (pr[e] + nn[e]) - cu[e]);
}

DEVINL void rw_prep_unit(const Params& p, int unit) {
  char* ws = p.ws;
  const char* colsb = ws + O_COLS;
  const int tid = otid(), lane = tid & 63, wave = tid >> 6, l15 = lane & 15, g = lane >> 4;
  u16* AL = (u16*)dynsmem;
  const int tok0 = unit * 32;
#pragma unroll 5
  for (int idx = tid; idx < 32 * 320; idx += 512) {
    int i = idx / 320, j = idx % 320;
    int t = tok0 + i; int s = t & (S_ - 1);
    unsigned o = ((unsigned)t * (unsigned)NCP + (unsigned)(C_RW + 3072 + j)) * 2u;
    float v = rw_shift2(colsb, p.rw_mu[3072 + j], o, s);
    if (j < 128) v = tanh_(v);
    else if (j >= 192) v = sigm(v);
    AL[i * 328 + j] = f2bf(v);
  }
  __syncthreads();
  const u16* LWF = (const u16*)(ws + O_LWF);
  const u16* LWB = (const u16*)(ws + O_LWB);
  const u16* LA = (const u16*)(ws + O_LA);
  const u16* LG = (const u16*)(ws + O_LG);
#pragma unroll 1
  for (int hh = 0; hh < 2; ++hh) {
    const int head = wave * 2 + hh;
#pragma unroll 1
    for (int mt = 0; mt < 2; ++mt) {
      f32x4 awf[4], awb[4], aa[4], ag[4];
#pragma unroll
      for (int n = 0; n < 4; ++n) { awf[n] = f32x4{0, 0, 0, 0}; awb[n] = awf[n]; aa[n] = awf[n]; ag[n] = awf[n]; }
      const u16* arow = AL + (mt * 16 + l15) * 328 + 8 * g;
#pragma unroll
      for (int ks = 0; ks < 2; ++ks) {
        bf16x8 fwf = *(const bf16x8*)(arow + 32 * ks);
        bf16x8 fwb = *(const bf16x8*)(arow + 64 + 32 * ks);
        bf16x8 fa = *(const bf16x8*)(arow + 128 + 32 * ks);
#pragma unroll
        for (int n = 0; n < 4; ++n) {
          const unsigned bo = (unsigned)((head * 64 + l15 * 4 + n) * 64 + 32 * ks + 8 * g) * 2u;
          bf16x8 b1 = *(const bf16x8*)((const char*)LWF + bo);
          bf16x8 b2 = *(const bf16x8*)((const char*)LWB + bo);
          bf16x8 b3 = *(const bf16x8*)((const char*)LA + bo);
          awf[n] = MFMA16(fwf, b1, awf[n]);
          awb[n] = MFMA16(fwb, b2, awb[n]);
          aa[n] = MFMA16(fa, b3, aa[n]);
        }
        __builtin_amdgcn_sched_barrier(0);
      }
#pragma unroll
      for (int ks = 0; ks < 4; ++ks) {
        bf16x8 fg = *(const bf16x8*)(arow + 192 + 32 * ks);
#pragma unroll
        for (int n = 0; n < 4; ++n) {
          const unsigned bo = (unsigned)((head * 64 + l15 * 4 + n) * 128 + 32 * ks + 8 * g) * 2u;
          bf16x8 b4 = *(const bf16x8*)((const char*)LG + bo);
          ag[n] = MFMA16(fg, b4, ag[n]);
        }
        __builtin_amdgcn_sched_barrier(0);
      }
#pragma unroll 2
      for (int j = 0; j < 4; ++j) {
        int jo = j, zo = 0;
        asm volatile("" : "+v"(jo), "+v"(zo));
        const int t = tok0 + mt * 16 + 4 * g + jo;
        const int s = t & (S_ - 1), b = t >> 12;
        const unsigned c0 = (unsigned)(head * 64 + l15 * 4 + zo);
        const unsigned rowo = (unsigned)t * (unsigned)(NCP * 2) + (unsigned)(C_RW * 2) + c0 * 2u;
        float pr[4], pkr[4], pv[4];
        rw_shift4(colsb, *(const float4*)(p.rw_mu + c0), rowo, s, pr);
        rw_shift4(colsb, *(const float4*)(p.rw_mu + 1024u + c0), rowo + 2048u, s, pkr);
        rw_shift4(colsb, *(const float4*)(p.rw_mu + 2048u + c0), rowo + 4096u, s, pv);
        const float4 a0q = *(const float4*)(p.rw_a0 + c0), kkq = *(const float4*)(p.rw_k_k + c0);
        const float4 kaq = *(const float4*)(p.rw_k_a + c0), rkq = *(const float4*)(p.rw_r_k + c0);
        const float4 w0fq = *(const float4*)(p.rw_w0_f + c0), w0bq = *(const float4*)(p.rw_w0_b + c0);
        const float a0v[4] = {a0q.x, a0q.y, a0q.z, a0q.w}, kkp[4] = {kkq.x, kkq.y, kkq.z, kkq.w};
        const float kap[4] = {kaq.x, kaq.y, kaq.z, kaq.w}, rkp[4] = {rkq.x, rkq.y, rkq.z, rkq.w};
        const float w0f[4] = {w0fq.x, w0fq.y, w0fq.z, w0fq.w}, w0b[4] = {w0bq.x, w0bq.y, w0bq.z, w0bq.w};
        float pk[4], av[4], kkv[4];
        float n2 = 0.f, dot = 0.f;
#pragma unroll
        for (int n = 0; n < 4; ++n) {
          const float kraw = pkr[n];
          float a = sigm(a0v[n] + sel4(aa[n], j));
          av[n] = a;
          float kk = kraw * kkp[n];
          kkv[n] = kk;
          n2 += kk * kk;
          float k2 = kraw * (1.f + (a - 1.f) * kap[n]);
          pk[n] = k2;
          dot += pr[n] * k2 * rkp[n];
        }
        n2 = allred16(n2);
        dot = allred16(dot);
        const float inv = 1.f / fmaxf(sqrtf(n2), 1e-12f);
        const unsigned reco = ((unsigned)((b * 16 + head) * 4096 + s)) * 1024u;
        const unsigned tco = (unsigned)t * 2048u + c0 * 2u;
        unsigned hwf[4], hwb[4], ha[4], hb[4], hk[4], hr[4], hv[4], bg[4], bbn[4];
#pragma unroll
        for (int n = 0; n < 4; ++n) {
          float wf = __expf(-0.606531f * sigm(w0f[n] + sel4(awf[n], j)));
          float wb = __expf(-0.606531f * sigm(w0b[n] + sel4(awb[n], j)));
          float kkn = kkv[n] * inv;
          hwf[n] = f2h(wf); hwb[n] = f2h(wb); ha[n] = f2h(-kkn); hb[n] = f2h(kkn * av[n]);
          hk[n] = f2h(pk[n]); hr[n] = f2h(pr[n]); hv[n] = f2h(pv[n]);
          bg[n] = f2bf(sel4(ag[n], j)); bbn[n] = f2bf(dot * pv[n]);
        }
        char* rb = ws + O_REC + (reco + (unsigned)l15 * 64u);
        *(uint4*)(rb) = make_uint4(hwf[0] | (hwf[1] << 16), hwf[2] | (hwf[3] << 16), hwb[0] | (hwb[1] << 16), hwb[2] | (hwb[3] << 16));
        *(uint4*)(rb + 16) = make_uint4(ha[0] | (ha[1] << 16), ha[2] | (ha[3] << 16), hb[0] | (hb[1] << 16), hb[2] | (hb[3] << 16));
        *(uint4*)(rb + 32) = make_uint4(hk[0] | (hk[1] << 16), hk[2] | (hk[3] << 16), hr[0] | (hr[1] << 16), hr[2] | (hr[3] << 16));
        *(uint2*)(rb + 48) = make_uint2(hv[0] | (hv[1] << 16), hv[2] | (hv[3] << 16));
        *(uint2*)(ws + O_GRW + tco) = make_uint2(bg[0] | (bg[1] << 16), bg[2] | (bg[3] << 16));
        *(uint2*)(ws + O_BONUS + tco) = make_uint2(bbn[0] | (bbn[1] << 16), bbn[2] | (bbn[3] << 16));
      }
    }
  }
  __syncthreads();
}

DEVINL void phase2(const Params& p) {
  const int bid = blockIdx.x, nb = gridDim.x, tid = otid();
  for (int u = bid; u < 512; u += nb) gla_prep_unit(p, u);
  for (int u = bid; u < 256; u += nb) rw_prep_unit(p, u);
}

typedef unsigned u32x2 __attribute__((ext_vector_type(2)));
typedef unsigned u32x4 __attribute__((ext_vector_type(4)));
template <int DIR>
DEVINL void rwkv_scan_dir(const Params& p, int task, int lane, int wave) {
  const int b = (task >> 8) & 1, head = (task >> 4) & 15, rg = task & 15;
  const int seg = lane & 15, rl = lane >> 4, row = rg * 4 + rl;
  constexpr int DIST = 24;
  constexpr int WOFS = DIR ? 8 : 0;
  const char* recbase = p.ws + O_REC + ((long)(b * 16 + head) * 4096) * 1024 + lane * 16;
  const unsigned ring_lds = (unsigned)(unsigned long)(__attribute__((address_space(3))) char*)(dynsmem + wave * 32768);
  const unsigned ring_u = __builtin_amdgcn_readfirstlane(ring_lds);
  const unsigned a_seg = ring_lds + seg * 64;
  const unsigned a_v = ring_lds + (row >> 2) * 64 + 48 + (row & 3) * 2;
  u16* yo = (u16*)(p.ws + (DIR ? O_YB : O_YSUM)) + ((long)b * 4096) * 1024 + head * 64 + row;
  float s0 = 0.f, s1 = 0.f, s2 = 0.f, s3 = 0.f;
  float ykeep = 0.f;
  const char* recdir = recbase + (DIR ? (long)4095 * 1024 : 0);
#define RW_GPTR(q_, gp_) const char* gp_ = recdir + (DIR ? -(long)(q_) * 1024 : (long)(q_) * 1024);
#define RW_DMA_ONLY(q_) do { RW_GPTR(q_, gp_) unsigned keep_; const unsigned ld_ = ring_u + ((q_) & 31) * 1024; \
    asm volatile("s_mov_b32 %0, m0\n\ts_mov_b32 m0, %2\n\ts_nop 0\n\tglobal_load_lds_dwordx4 %1, off\n\ts_mov_b32 m0, %0" \
                 : "=&s"(keep_) : "v"(gp_), "s"(ld_) : "memory"); } while (0)
#define RW_READ(U1, WN, XN, KN, VN, VMC) do { \
    asm volatile("s_waitcnt vmcnt(" #VMC ")\n\t" \
                 "ds_read_b64 %0, %4 offset:%6\n\t" \
                 "ds_read_b128 %1, %4 offset:%7\n\t" \
                 "ds_read_b128 %2, %4 offset:%8\n\t" \
                 "ds_read_u16 %3, %5 offset:%9" \
                 : "=&v"(WN), "=&v"(XN), "=&v"(KN), "=&v"(VN) \
                 : "v"(a_seg), "v"(a_v), \
                   "i"(((U1) & 31) * 1024 + WOFS), "i"(((U1) & 31) * 1024 + 16), "i"(((U1) & 31) * 1024 + 32), "i"(((U1) & 31) * 1024) \
                 : "memory"); } while (0)
#define RW_LANDED(WN, XN, KN, VN) asm volatile("s_waitcnt lgkmcnt(0)" : "+v"(WN), "+v"(XN), "+v"(KN), "+v"(VN) :: "memory")
#define FMX "op_sel_hi:[0,1,0]"
#define FHH "op_sel_hi:[1,1,0]"
#define DPPX " row_mask:0xf bank_mask:0xf bound_ctrl:1"
#define RW_STEP(U, WC, XC, KC, VC, WN, XN, KN, VN) do { \
    RW_GPTR(st + (U) + DIST, gp_) \
    const unsigned ld_ = ring_u + (((U) + DIST) & 31) * 1024; \
    float pa_, pb_, t0_, t1_, t2_, t3_, sa_; \
    asm volatile( \
      "s_mov_b32 m0, %[ld]\n\t" \
      "s_waitcnt vmcnt(22)\n\t"                         \
      "ds_read_b64 %[wn], %[aseg] offset:%[o0]\n\t" \
      "ds_read_b128 %[xn], %[aseg] offset:%[o1]\n\t" \
      "ds_read_b128 %[kn], %[aseg] offset:%[o2]\n\t" \
      "ds_read_u16 %[vn], %[av] offset:%[o3]\n\t" \
      "global_load_lds_dwordx4 %[gp], off\n\t"          \
      "v_fma_mix_f32 %[pa], %[s0], %[a01], 0 op_sel:[0,0,0] " FMX "\n\t" \
      "v_fma_mix_f32 %[pb], %[s2], %[a23], 0 op_sel:[0,0,0] " FMX "\n\t" \
      "v_fma_mix_f32 %[t0], %[s0], %[w01], 0 op_sel:[0,0,0] " FMX "\n\t" \
      "v_fma_mix_f32 %[pa], %[s1], %[a01], %[pa] op_sel:[0,1,0] " FMX "\n\t" \
      "v_fma_mix_f32 %[pb], %[s3], %[a23], %[pb] op_sel:[0,1,0] " FMX "\n\t" \
      "v_fma_mix_f32 %[t1], %[s1], %[w01], 0 op_sel:[0,1,0] " FMX "\n\t" \
      "v_fma_mix_f32 %[t2], %[s2], %[w23], 0 op_sel:[0,0,0] " FMX "\n\t" \
      "v_add_f32 %[sa], %[pa], %[pb]\n\t" \
      "v_add_f32_dpp %[yp], %[yp], %[yp] quad_perm:[1,0,3,2]" DPPX "\n\t" \
      "v_fma_mix_f32 %[t3], %[s3], %[w23], 0 op_sel:[0,1,0] " FMX "\n\t" \
      "v_fma_mix_f32 %[t0], %[vh], %[k01], %[t0] op_sel:[0,0,0] " FHH "\n\t" \
      "v_add_f32_dpp %[sa], %[sa], %[sa] quad_perm:[1,0,3,2]" DPPX "\n\t" \
      "v_add_f32_dpp %[yp], %[yp], %[yp] quad_perm:[2,3,0,1]" DPPX "\n\t" \
      "v_fma_mix_f32 %[t1], %[vh], %[k01], %[t1] op_sel:[0,1,0] " FHH "\n\t" \
      "v_fma_mix_f32 %[t2], %[vh], %[k23], %[t2] op_sel:[0,0,0] " FHH "\n\t" \
      "v_add_f32_dpp %[sa], %[sa], %[sa] quad_perm:[2,3,0,1]" DPPX "\n\t" \
      "v_add_f32_dpp %[yp], %[yp], %[yp] row_half_mirror" DPPX "\n\t" \
      "v_fma_mix_f32 %[t3], %[vh], %[k23], %[t3] op_sel:[0,1,0] " FHH "\n\t" \
      "v_cmp_eq_u32 vcc, %[fin], %[segv]\n\t" \
      "v_add_f32_dpp %[sa], %[sa], %[sa] row_half_mirror" DPPX "\n\t" \
      "v_add_f32_dpp %[yp], %[yp], %[yp] row_mirror" DPPX "\n\t" \
      "v_cndmask_b32 %[yk], %[yk], %[yp], vcc\n\t" \
      "s_nop 0\n\t" \
      "v_add_f32_dpp %[sa], %[sa], %[sa] row_mirror" DPPX "\n\t" \
      "v_fma_mix_f32 %[s0], %[sa], %[b01], %[t0] op_sel:[0,0,0] " FMX "\n\t" \
      "v_fma_mix_f32 %[s1], %[sa], %[b01], %[t1] op_sel:[0,1,0] " FMX "\n\t" \
      "v_fma_mix_f32 %[s2], %[sa], %[b23], %[t2] op_sel:[0,0,0] " FMX "\n\t" \
      "v_fma_mix_f32 %[s3], %[sa], %[b23], %[t3] op_sel:[0,1,0] " FMX "\n\t" \
      "v_fma_mix_f32 %[pa], %[s0], %[r01], 0 op_sel:[0,0,0] " FMX "\n\t" \
      "v_fma_mix_f32 %[pb], %[s2], %[r23], 0 op_sel:[0,0,0] " FMX "\n\t" \
      "v_fma_mix_f32 %[pa], %[s1], %[r01], %[pa] op_sel:[0,1,0] " FMX "\n\t" \
      "v_fma_mix_f32 %[pb], %[s3], %[r23], %[pb] op_sel:[0,1,0] " FMX "\n\t" \
      "v_add_f32 %[yp], %[pa], %[pb]\n\t" \
      "s_waitcnt lgkmcnt(0)" \
      : [wn]"=&v"(WN), [xn]"=&v"(XN), [kn]"=&v"(KN), [vn]"=&v"(VN), \
        [pa]"=&v"(pa_), [pb]"=&v"(pb_), [t0]"=&v"(t0_), [t1]"=&v"(t1_), [t2]"=&v"(t2_), [t3]"=&v"(t3_), [sa]"=&v"(sa_), \
        [s0]"+v"(s0), [s1]"+v"(s1), [s2]"+v"(s2), [s3]"+v"(s3), [yp]"+v"(ypart), [yk]"+v"(ykeep) \
      : [gp]"v"(gp_), [ld]"s"(ld_), [aseg]"v"(a_seg), [av]"v"(a_v), \
        [a01]"v"(XC.x), [a23]"v"(XC.y), [b01]"v"(XC.z), [b23]"v"(XC.w), \
        [k01]"v"(KC.x), [k23]"v"(KC.y), [r01]"v"(KC.z), [r23]"v"(KC.w), \
        [w01]"v"(WC.x), [w23]"v"(WC.y), [vh]"v"(VC), [segv]"v"(seg), [fin]"i"(((U) + 15) & 15), \
        [o0]"i"((((U) + 1) & 31) * 1024 + WOFS), [o1]"i"((((U) + 1) & 31) * 1024 + 16), \
        [o2]"i"((((U) + 1) & 31) * 1024 + 32), [o3]"i"((((U) + 1) & 31) * 1024) \
      : "memory", "vcc"); } while (0)
#define RW_STEP2(B) RW_STEP(B, WvA, XA, KrA, vhA, WvB, XB, KrB, vhB); RW_STEP((B) + 1, WvB, XB, KrB, vhB, WvA, XA, KrA, vhA)
#define RW_STEP4(B) RW_STEP2(B); RW_STEP2((B) + 2)
#define RW_DMA4(B) RW_DMA_ONLY(B); RW_DMA_ONLY((B) + 1); RW_DMA_ONLY((B) + 2); RW_DMA_ONLY((B) + 3)
  u32x2 WvA, WvB; u32x4 XA, XB, KrA, KrB; unsigned vhA, vhB;
  RW_DMA4(0); RW_DMA4(4); RW_DMA4(8); RW_DMA4(12); RW_DMA4(16); RW_DMA4(20);
  RW_READ(0, WvA, XA, KrA, vhA, 23);
  RW_LANDED(WvA, XA, KrA, vhA);
  float ypart = 0.f;
#pragma unroll 1
  for (int st = 0; st < 4096; st += 32) {
    RW_STEP(0, WvA, XA, KrA, vhA, WvB, XB, KrB, vhB);
    if (st > 0) { const int q0 = st - 16 + seg; yo[(long)(DIR ? (4095 - q0) : q0) * 1024] = f2bf(ykeep); }
    RW_STEP(1, WvB, XB, KrB, vhB, WvA, XA, KrA, vhA);
    RW_STEP2(2); RW_STEP4(4); RW_STEP4(8); RW_STEP4(12);
    RW_STEP(16, WvA, XA, KrA, vhA, WvB, XB, KrB, vhB);
    { const int q0 = st + seg; yo[(long)(DIR ? (4095 - q0) : q0) * 1024] = f2bf(ykeep); }
    RW_STEP(17, WvB, XB, KrB, vhB, WvA, XA, KrA, vhA);
    RW_STEP2(18); RW_STEP4(20); RW_STEP4(24); RW_STEP4(28);
  }
  {
    const float ylast = allred16(ypart);
    ykeep = (seg == 15) ? ylast : ykeep;
    const int q0 = 4096 - 16 + seg; yo[(long)(DIR ? (4095 - q0) : q0) * 1024] = f2bf(ykeep);
  }
  asm volatile("s_waitcnt vmcnt(0)" ::: "memory");
#undef RW_READ
#undef RW_LANDED
#undef RW_STEP2
#undef RW_GPTR
#undef RW_DMA_ONLY
#undef RW_STEP
#undef RW_STEP4
#undef RW_DMA4
}
DEVINL void rwkv_scan_task(const Params& p, int task, int lane, int wave) {
  if (task >> 9) rwkv_scan_dir<1>(p, task, lane, wave);
  else rwkv_scan_dir<0>(p, task, lane, wave);
}

DEVINL void gla_scan_task(const Params& p, int task, int lane) {
  const int dir = task >> 7, b = (task >> 6) & 1, h = (task >> 4) & 3, vsl = task & 15;
  const int l15 = lane & 15, g = lane >> 4;
  const long hb = (long)(dir * 2 + b) * 4 + h;
  const u16* qt = (const u16*)(p.ws + O_QT) + hb * 4096 * 128 + l15 * 128 + 8 * g;
  const u16* kt = (const u16*)(p.ws + O_KT) + hb * 4096 * 128 + l15 * 128 + 8 * g;
  const u16* kdT = (const u16*)(p.ws + O_KDT) + hb * 64 * 128 * 64 + l15 * 64 + 8 * g;
  const u16* vT = (const u16*)(p.ws + O_VT) + ((long)b * 4 + h) * 64 * 256 * 64 + (16 * vsl + l15) * 64 + 8 * g;
  const float* dec = (const float*)(p.ws + O_DEC) + hb * 64 * 128 + 4 * g;
  u16* obuf = (u16*)(p.ws + O_OSUM) + (dir ? (long)T_ * 1024 : 0) + ((long)b * 4096) * 1024 + h * 256 + 16 * vsl + l15;
  f32x4 ST[8];
#pragma unroll
  for (int m = 0; m < 8; ++m) ST[m] = f32x4{0, 0, 0, 0};
  bf16x8 KF[4][4], VF[2], QF[4][4];
#define GL_LOAD_KV(KFx, VFx, c_) do { \
    _Pragma("unroll") for (int jt = 0; jt < 4; ++jt) _Pragma("unroll") for (int ks = 0; ks < 4; ++ks) \
      KFx[jt][ks] = ld16(kt + ((c_) * 64 + 16 * jt) * 128 + 32 * ks); \
    _Pragma("unroll") for (int s = 0; s < 2; ++s) VFx[s] = ld16(vT + (c_) * (256 * 64) + 32 * s); } while (0)
#define GL_LOAD_Q(it_, c_) do { \
    _Pragma("unroll") for (int ks = 0; ks < 4; ++ks) QF[it_][ks] = ld16(qt + ((c_) * 64 + 16 * (it_)) * 128 + 32 * ks); } while (0)
  {
    const int c0 = dir ? 63 : 0;
    GL_LOAD_KV(KF, VF, c0);
    GL_LOAD_Q(0, c0);
  }
  for (int cc = 0; cc < 64; ++cc) {
    const int c = dir ? 63 - cc : cc;
    const int tok0 = c * 64;
    GL_LOAD_Q(1, c); GL_LOAD_Q(2, c); GL_LOAD_Q(3, c);
    bf16x8 SBf[4];
#pragma unroll
    for (int ks = 0; ks < 4; ++ks) SBf[ks] = pack8(ST[2 * ks], ST[2 * ks + 1]);
    __builtin_amdgcn_sched_barrier(0);
#pragma unroll
    for (int it = 0; it < 4; ++it) {
      f32x4 X[4];
#pragma unroll
      for (int jt = 0; jt < 4; ++jt) {
        X[jt] = f32x4{0, 0, 0, 0};
        const bool need = dir ? (jt >= it) : (jt <= it);
        if (need) {
#pragma unroll
          for (int ks = 0; ks < 4; ++ks) X[jt] = MFMA16(KF[jt][ks], QF[it][ks], X[jt]);
          if (jt == it) {
#pragma unroll
            for (int r = 0; r < 4; ++r) {
              const int j = 4 * g + r;
              const bool keep = dir ? (j >= l15) : (j <= l15);
              if (!keep) X[jt][r] = 0.f;
            }
          }
        }
      }
      bf16x8 XA0 = pack8(X[0], X[1]), XA1 = pack8(X[2], X[3]);
      f32x4 O = f32x4{0, 0, 0, 0};
      O = MFMA16(XA0, VF[0], O);
      O = MFMA16(XA1, VF[1], O);
#pragma unroll
      for (int ks = 0; ks < 4; ++ks) O = MFMA16(QF[it][ks], SBf[ks], O);
      {
        const bool oddc = (l15 & 1) != 0;
        float lo[2], hi[2];
        xchg_pairs(O, oddc, lo, hi);
        u16* ob = obuf - (oddc ? 1 : 0) + (long)(tok0 + 16 * it + 4 * g + (oddc ? 2 : 0)) * 1024;
        *(unsigned*)(ob) = pk2(lo[0], hi[0]);
        *(unsigned*)(ob + 1024) = pk2(lo[1], hi[1]);
      }
    }
    __builtin_amdgcn_sched_barrier(0);
    bf16x8 KDF[8][2]; f32x4 Dv[8];
#pragma unroll
    for (int m = 0; m < 8; ++m) {
      Dv[m] = *(const f32x4*)(dec + c * 128 + 16 * m);
#pragma unroll
      for (int s = 0; s < 2; ++s) KDF[m][s] = ld16(kdT + (c * 128 + 16 * m) * 64 + 32 * s);
    }
    __builtin_amdgcn_sched_barrier(0);
#pragma unroll
    for (int m = 0; m < 4; ++m) {
      ST[m] = ST[m] * Dv[m];
      ST[m] = MFMA16(KDF[m][0], VF[0], ST[m]);
      ST[m] = MFMA16(KDF[m][1], VF[1], ST[m]);
    }
    __builtin_amdgcn_sched_barrier(0);
    const int cn = (cc < 63) ? (dir ? c - 1 : c + 1) : c;
    bf16x8 VFn[2];
    GL_LOAD_KV(KF, VFn, cn);
    GL_LOAD_Q(0, cn);
    __builtin_amdgcn_sched_barrier(0);
#pragma unroll
    for (int m = 4; m < 8; ++m) {
      ST[m] = ST[m] * Dv[m];
      ST[m] = MFMA16(KDF[m][0], VF[0], ST[m]);
      ST[m] = MFMA16(KDF[m][1], VF[1], ST[m]);
    }
    VF[0] = VFn[0]; VF[1] = VFn[1];
  }
#undef GL_LOAD_KV
#undef GL_LOAD_Q
}

DEVINL void phase3(const Params& p) {
  const int tid = otid(); const int wave = tid >> 6, lane = tid & 63;
  const int nb = gridDim.x;
  int vb = blockIdx.x;
  if ((nb & 7) == 0) vb = (blockIdx.x & 7) * (nb >> 3) + (blockIdx.x >> 3);
  if (wave < 4) {
    for (int task = vb * 4 + wave; task < 1024; task += nb * 4) rwkv_scan_task(p, task, lane, wave);
  } else if (wave == 4) {
    for (int task = vb; task < 256; task += nb) gla_scan_task(p, task, lane);
  }
}

DEVINL void phase4(const Params& p) {
  char* ws = p.ws;
  const int tid = otid();
  const int lane = tid & 63;
  const int gw = blockIdx.x * 8 + (tid >> 6), nw = gridDim.x * 8;
  const u16* cols = (const u16*)(ws + O_COLS);
  for (int u = gw; u < T_ * 4; u += nw) {
    const long t = u >> 2; const int h = u & 3;
    const int c = h * 256 + lane * 4;
    float4 o;
    {
      uint2 of = *(const uint2*)((const u16*)(ws + O_OSUM) + t * 1024 + c);
      uint2 ob = *(const uint2*)((const u16*)(ws + O_OSUM) + (long)T_ * 1024 + t * 1024 + c);
      o.x = bflo(of.x) + bflo(ob.x); o.y = bfhi(of.x) + bfhi(ob.x);
      o.z = bflo(of.y) + bflo(ob.y); o.w = bfhi(of.y) + bfhi(ob.y);
    }
    float ss = o.x * o.x + o.y * o.y + o.z * o.z + o.w * o.w;
    ss = allred64(ss);
    const float rstd = rsqrtf(ss * (1.f / 256.f) + 1e-5f);
    float4 ng = *(const float4*)(p.gla_norm_g + c);
    uint2 gg = *(const uint2*)(cols + t * NCP + C_G + c);
    float g0 = bflo(gg.x), g1 = bfhi(gg.x), g2 = bflo(gg.y), g3 = bfhi(gg.y);
    float y0 = o.x * rstd * ng.x * (g0 * sigm(g0));
    float y1 = o.y * rstd * ng.y * (g1 * sigm(g1));
    float y2 = o.z * rstd * ng.z * (g2 * sigm(g2));
    float y3 = o.w * rstd * ng.w * (g3 * sigm(g3));
    *(uint2*)((u16*)(ws + O_YGLA) + t * 1024 + c) = make_uint2(pk2(y0, y1), pk2(y2, y3));
  }
  for (int u = gw; u < T_ * 4; u += nw) {
    const long t = u >> 2; const int hq = u & 3;
    const int c = (hq * 4 + (lane >> 4)) * 64 + (lane & 15) * 4;
    float4 y;
    {
      const uint2 y1 = *(const uint2*)((const u16*)(ws + O_YSUM) + t * 1024 + c);
      const uint2 y2 = *(const uint2*)((const u16*)(ws + O_YB) + t * 1024 + c);
      y.x = bflo(y1.x) + bflo(y2.x); y.y = bfhi(y1.x) + bfhi(y2.x);
      y.z = bflo(y1.y) + bflo(y2.y); y.w = bfhi(y1.y) + bfhi(y2.y);
    }
    float mu = allred16(y.x + y.y + y.z + y.w) * (1.f / 64.f);
    float d0 = y.x - mu, d1 = y.y - mu, d2 = y.z - mu, d3 = y.w - mu;
    float var = allred16(d0 * d0 + d1 * d1 + d2 * d2 + d3 * d3) * (1.f / 64.f);
    const float rstd = rsqrtf(var + 64e-5f);
    float4 lg = *(const float4*)(p.rw_ln_g + c);
    float4 lb = *(const float4*)(p.rw_ln_b + c);
    uint2 bo = *(const uint2*)((const u16*)(ws + O_BONUS) + t * 1024 + c);
    uint2 gg = *(const uint2*)((const u16*)(ws + O_GRW) + t * 1024 + c);
    float r0 = (d0 * rstd * lg.x + lb.x + bflo(bo.x)) * bflo(gg.x);
    float r1 = (d1 * rstd * lg.y + lb.y + bfhi(bo.x)) * bfhi(gg.x);
    float r2 = (d2 * rstd * lg.z + lb.z + bflo(bo.y)) * bflo(gg.y);
    float r3 = (d3 * rstd * lg.w + lb.w + bfhi(bo.y)) * bfhi(gg.y);
    *(uint2*)((u16*)(ws + O_YRW) + t * 1024 + c) = make_uint2(pk2(r0, r1), pk2(r2, r3));
  }
}

DEVINL void phase5(const Params& p) {
  const u16* A1 = (const u16*)(p.ws + O_YGLA);
  const u16* A2 = (const u16*)(p.ws + O_YRW);
  const u16* B1 = (const u16*)(p.ws + O_WUPGT);
  const u16* B2 = (const u16*)(p.ws + O_WUPRT);
  for (int t = blockIdx.x; t < 256; t += gridDim.x) {
    int pm = t & 31, pn = t >> 5;
    gemm_tile<EPI_M1, false>(p, A1, 1024, nullptr, B1, 1024, 1024, pm * 256, pn * 256, pm * 256, pn * 256);
  }
  for (int t = blockIdx.x; t < 256; t += gridDim.x) {
    int pm = t & 31, pn = t >> 5;
    gemm_tile<EPI_MERGED, false>(p, A2, 1024, nullptr, B2, 1024, 1024, pm * 256, pn * 256, pm * 256, pn * 256);
  }
}
DEVINL void phase6(const Params& p) {
  const u16* A = (const u16*)(p.ws + O_MERGED);
  const u16* Bt = (const u16*)(p.ws + O_WOUTT);
  for (int t = blockIdx.x; t < 256; t += gridDim.x) {
    int pm = t & 31, pn = t >> 5;
    gemm_tile<EPI_R1, false>(p, A, 2048, nullptr, Bt, 2048, 2048, pm * 256, pn * 256, pm * 256, pn * 256);
  }
}

DEVINL void phase7(const Params& p) {
  char* ws = p.ws;
  const int tid = otid();
  const int lane = tid & 63;
  const int gw = blockIdx.x * 8 + (tid >> 6), nw = gridDim.x * 8;
  for (int row = gw; row < T_; row += nw) {
    const u16* r1 = (const u16*)(ws + O_R1) + (long)row * 2048;
    float4 v[8];
    float sum = 0.f;
#pragma unroll
    for (int i = 0; i < 8; ++i) {
      const uint2 q = *(const uint2*)(r1 + i * 256 + lane * 4);
      v[i] = make_float4(bflo(q.x), bfhi(q.x), bflo(q.y), bfhi(q.y));
      sum += v[i].x + v[i].y + v[i].z + v[i].w;
    }
    const float mu = allred64(sum) * (1.f / 2048.f);
    float sq = 0.f;
#pragma unroll
    for (int i = 0; i < 8; ++i) {
      v[i].x -= mu; v[i].y -= mu; v[i].z -= mu; v[i].w -= mu;
      sq += v[i].x * v[i].x + v[i].y * v[i].y + v[i].z * v[i].z + v[i].w * v[i].w;
    }
    const float rstd = rsqrtf(allred64(sq) * (1.f / 2048.f) + 1e-5f);
    float lg[16];
#pragma unroll
    for (int e = 0; e < 16; ++e) lg[e] = 0.f;
#pragma unroll
    for (int i = 0; i < 8; ++i) {
      const int c = i * 256 + lane * 4;
      float4 gq = *(const float4*)(p.ln1_g + c);
      float4 bq = *(const float4*)(p.ln1_b + c);
      float h0 = v[i].x * rstd * gq.x + bq.x, h1 = v[i].y * rstd * gq.y + bq.y;
      float h2 = v[i].z * rstd * gq.z + bq.z, h3 = v[i].w * rstd * gq.w + bq.w;
      *(uint2*)((u16*)(ws + O_HBF) + (long)row * 2048 + c) = make_uint2(pk2(h0, h1), pk2(h2, h3));
      const float hh[4] = {h0, h1, h2, h3};
#pragma unroll
      for (int q = 0; q < 4; ++q) {
        const float4* wr = (const float4*)(p.w_router + (long)(c + q) * 16);
#pragma unroll
        for (int e4 = 0; e4 < 4; ++e4) {
          float4 w = wr[e4];
          lg[e4 * 4 + 0] += hh[q] * w.x; lg[e4 * 4 + 1] += hh[q] * w.y;
          lg[e4 * 4 + 2] += hh[q] * w.z; lg[e4 * 4 + 3] += hh[q] * w.w;
        }
      }
    }
    float mx = -1e30f;
#pragma unroll
    for (int e = 0; e < 16; ++e) { lg[e] = allred64(lg[e]); mx = fmaxf(mx, lg[e]); }
    float den = 0.f;
#pragma unroll
    for (int e = 0; e < 16; ++e) { lg[e] = __expf(lg[e] - mx); den += lg[e]; }
    const float inv = 1.f / den;
    float mine = 0.f;
#pragma unroll
    for (int e = 0; e < 16; ++e) if (lane == e) mine = lg[e] * inv;
    if (lane < 16) {
      const int b = row >> 12, s = row & 4095;
      ((float*)(ws + O_AFF))[((long)(b * 16 + lane)) * 4096 + s] = mine;
      ((int*)(ws + O_INV))[row * 16 + lane] = -1;
    }
  }
}

DEVINL void phase8(const Params& p) {
  char* ws = p.ws;
  const int bid = blockIdx.x, nb = gridDim.x, tid = otid();
  for (int pr = bid; pr < 32; pr += nb) {
    const int b = pr >> 4, e = pr & 15;
    unsigned* cnt = (unsigned*)dynsmem;
    const float* aff = (const float*)(ws + O_AFF) + (long)pr * 4096;
    const int lane = tid & 63;
    unsigned key[8];
#pragma unroll
    for (int i = 0; i < 8; ++i) key[i] = __float_as_uint(aff[tid + 512 * i]);
    if (tid < 40) cnt[tid] = 0u;
    __syncthreads();
    unsigned T = 0u;
    for (int bit = 30; bit >= 0; --bit) {
      const unsigned cand = T | (1u << bit);
      int c = 0;
#pragma unroll
      for (int i = 0; i < 8; ++i) c += (key[i] >= cand) ? 1 : 0;
      const float cf = allred64((float)c);
      if (lane == 0) atomicAdd(&cnt[bit], (unsigned)cf);
      __syncthreads();
      if (cnt[bit] >= 512u) T = cand;
    }
    {
      int c = 0;
#pragma unroll
      for (int i = 0; i < 8; ++i) c += (key[i] > T) ? 1 : 0;
      const float cf = allred64((float)c);
      if (lane == 0) atomicAdd(&cnt[31], (unsigned)cf);
      __syncthreads();
    }
    const unsigned ngt = cnt[31];
#pragma unroll
    for (int i = 0; i < 8; ++i) {
      int slot = -1;
      if (key[i] > T) slot = (int)atomicAdd(&cnt[32], 1u);
      else if (key[i] == T) { unsigned s2 = atomicAdd(&cnt[33], 1u); if (ngt + s2 < 512u) slot = (int)(ngt + s2); }
      if (slot >= 0) {
        ((int*)(ws + O_SELT))[e * 1024 + b * 512 + slot] = b * 4096 + tid + 512 * i;
        ((float*)(ws + O_SELG))[e * 1024 + b * 512 + slot] = __uint_as_float(key[i]);
        ((int*)(ws + O_INV))[(b * 4096 + tid + 512 * i) * 16 + e] = e * 1024 + b * 512 + slot;
      }
    }
    __syncthreads();
  }
  {
    unsigned* ticket = (unsigned*)(ws + O_BAR);
    volatile int* slot = (volatile int*)(dynsmem + 120000);
    for (;;) {
      if (tid == 0) *slot = (int)atomicAdd(ticket, 1u);
      __syncthreads();
      const int t = *slot;
      if (t >= 16 * 128 * 3) break;
      const int which = t / (16 * 128), r = t % (16 * 128), e = r >> 7, tt = r & 127;
      if (which < 2) {
        const float* src = (which ? p.w3 : p.w1) + (long)e * 2048 * 1024;
        int kt = tt & 31, ntile = tt >> 5;
        tr_tile(src, 1024, 1024, kt * 64, ntile * 256, (u16*)(ws + O_W13T) + (long)e * 2048 * 2048, 2048, 128, 256, which * 128);
      } else {
        const float* src = p.w2 + (long)e * 1024 * 2048;
        int kt = tt & 15, ntile = tt >> 4;
        tr_tile(src, 2048, 2048, kt * 64, ntile * 256, (u16*)(ws + O_W2T) + (long)e * 2048 * 1024, 1024, 1 << 30, 0, 0);
      }
    }
  }
}

DEVINL void phase9(const Params& p) {
  const u16* A = (const u16*)(p.ws + O_XE);
  for (int t = blockIdx.x; t < 512; t += gridDim.x) {
    const int e = ((t >> 8) << 3) + (t & 7), pm = (t >> 3) & 3, pn = (t >> 5) & 7;
    const u16* Bt = (const u16*)(p.ws + O_W13T) + (long)e * 2048 * 2048;
    gemm_tile<EPI_HID, true>(p, (const u16*)(p.ws + O_HBF), 2048, (const int*)(p.ws + O_SELT), Bt, 2048, 2048, e * 1024 + pm * 256, pn * 256, e * 1024 + pm * 256, pn * 128);
  }
}
DEVINL void phase10(const Params& p) {
  const u16* A = (const u16*)(p.ws + O_HID);
  for (int t = blockIdx.x; t < 512; t += gridDim.x) {
    const int e = ((t >> 8) << 3) + (t & 7), pm = (t >> 3) & 3, pn = (t >> 5) & 7;
    const u16* Bt = (const u16*)(p.ws + O_W2T) + (long)e * 2048 * 1024;
    gemm_tile<EPI_MOE2, false>(p, A, 1024, nullptr, Bt, 1024, 1024, e * 1024 + pm * 256, pn * 256, e * 1024 + pm * 256, pn * 256);
  }
}

DEVINL void phase11(const Params& p) {
  const int tid = otid();
  const int lane = tid & 63;
  const int gw = blockIdx.x * 8 + (tid >> 6), nw = gridDim.x * 8;
  for (int row = gw; row < T_; row += nw) {
    const u16* hb = (const u16*)(p.ws + O_HBF) + (long)row * 2048;
    float4 v[8];
    float sum = 0.f;
#pragma unroll
    for (int i = 0; i < 8; ++i) {
      const uint2 q = *(const uint2*)(hb + i * 256 + lane * 4);
      v[i] = make_float4(ALPHA * bflo(q.x), ALPHA * bfhi(q.x), ALPHA * bflo(q.y), ALPHA * bfhi(q.y));
    }
    {
      const int* inv = (const int*)(p.ws + O_INV) + row * 16;
      const int myinv = inv[lane & 15];
#pragma unroll 1
      for (int e = 0; e < 16; ++e) {
        const int er = __builtin_amdgcn_readlane(myinv, e);
        if (er >= 0) {
          const u16* eo = (const u16*)(p.ws + O_EO) + (long)er * 2048 + lane * 4;
#pragma unroll
          for (int i = 0; i < 8; ++i) {
            uint2 q = *(const uint2*)(eo + i * 256);
            v[i].x += bflo(q.x); v[i].y += bfhi(q.x); v[i].z += bflo(q.y); v[i].w += bfhi(q.y);
          }
        }
      }
    }
#pragma unroll
    for (int i = 0; i < 8; ++i) sum += v[i].x + v[i].y + v[i].z + v[i].w;
    const float mu = allred64(sum) * (1.f / 2048.f);
    float sq = 0.f;
#pragma unroll
    for (int i = 0; i < 8; ++i) {
      v[i].x -= mu; v[i].y -= mu; v[i].z -= mu; v[i].w -= mu;
      sq += v[i].x * v[i].x + v[i].y * v[i].y + v[i].z * v[i].z + v[i].w * v[i].w;
    }
    const float rstd = rsqrtf(allred64(sq) * (1.f / 2048.f) + 1e-5f);
#pragma unroll
    for (int i = 0; i < 8; ++i) {
      const int c = i * 256 + lane * 4;
      float4 gq = *(const float4*)(p.ln2_g + c);
      float4 bq = *(const float4*)(p.ln2_b + c);
      const f32x4 ov = {v[i].x * rstd * gq.x + bq.x, v[i].y * rstd * gq.y + bq.y, v[i].z * rstd * gq.z + bq.z, v[i].w * rstd * gq.w + bq.w};
      __builtin_nontemporal_store(ov, (f32x4*)(p.out + (long)row * 2048 + c));
    }
  }
}

#define XB_TMO      128
#define XB_XCNT(j)  (256  + 64 * (j))
#define XB_XSUB(j)  (1280 + 64 * (j))
#define XB_XGEN(j)  (2304 + 64 * (j))
#define XB_TOP      3328
#define XB_TOPGEN   3392
#define XCD_BAR_WORDS 3456
#define XB_SPIN_CAP (1u << 20)
#define LAS __attribute__((address_space(3)))
DEVINL unsigned xb_ld(unsigned* p_) { return __hip_atomic_load(p_, __ATOMIC_RELAXED, __HIP_MEMORY_SCOPE_AGENT); }
DEVINL unsigned xb_add(unsigned* p_, unsigned v) { return __hip_atomic_fetch_add(p_, v, __ATOMIC_RELAXED, __HIP_MEMORY_SCOPE_AGENT); }
DEVINL unsigned xb_xcc_id() { return (unsigned)__builtin_amdgcn_s_getreg((3 << 11) | 20) & 0xFu; }
#define XB_SPIN(cond, bar) do { unsigned _sp = 0; while (cond) { __builtin_amdgcn_s_sleep(1); \
    if ((++_sp & 255u) == 0u) { if (xb_ld(&(bar)[XB_TMO])) break; if (_sp > XB_SPIN_CAP) { atomicAdd(&(bar)[XB_TMO], 1u); break; } } } } while (0)
struct XcdBarrier { unsigned* bar; unsigned x; volatile LAS unsigned* st; };
DEVINL XcdBarrier xcd_barrier_post(unsigned* bar, volatile LAS unsigned* st) {
  XcdBarrier b; b.bar = bar; b.x = xb_xcc_id(); b.st = st;
  if (threadIdx.x == 0) (void)xb_add(&bar[XB_XCNT(b.x)], 1u);
  return b;
}
DEVINL void xcd_barrier_complete(unsigned* bar, unsigned x, unsigned& nloc, unsigned& nx) {
  const unsigned G = gridDim.x * gridDim.y * gridDim.z;
  unsigned sum, cnt, mine, sp = 0u;
  for (;;) {
    sum = 0u; cnt = 0u; mine = 0u;
#pragma unroll
    for (unsigned j = 0; j < 16; ++j) { const unsigned c = xb_ld(&bar[XB_XCNT(j)]); sum += c; cnt += (c > 0u) ? 1u : 0u; mine = (j == x) ? c : mine; }
    if (sum == G) break;
    __builtin_amdgcn_s_sleep(1);
    if ((++sp & 255u) == 0u) { if (xb_ld(&bar[XB_TMO])) break; if (sp > XB_SPIN_CAP) { atomicAdd(&bar[XB_TMO], 1u); break; } }
  }
  nloc = mine > 0u ? mine : 1u; nx = cnt > 0u ? cnt : 1u;
}
DEVINL void xcd_barrier(const XcdBarrier& b) {
  asm volatile("s_waitcnt vmcnt(0)" ::: "memory");
  __syncthreads();
  if (threadIdx.x == 0) {
    unsigned* bar = b.bar;
    __builtin_amdgcn_s_waitcnt(0);
    unsigned nloc = b.st[0], nx = b.st[1];
    if (nloc == 0u) { xcd_barrier_complete(bar, b.x, nloc, nx); b.st[0] = nloc; b.st[1] = nx; }
    const unsigned old = xb_add(&bar[XB_XSUB(b.x)], 1u);
    const unsigned gen = old / nloc;
    if (old + 1u == (gen + 1u) * nloc) {
      __builtin_amdgcn_fence(__ATOMIC_RELEASE, "agent");
      asm volatile("s_waitcnt vmcnt(0)" ::: "memory");
      const unsigned og = xb_add(&bar[XB_TOP], 1u);
      const unsigned tg = og / nx;
      if (og + 1u == (tg + 1u) * nx) xb_add(&bar[XB_TOPGEN], 1u);
      else XB_SPIN(xb_ld(&bar[XB_TOPGEN]) == tg, bar);
      __builtin_amdgcn_fence(__ATOMIC_ACQUIRE, "agent");
      xb_add(&bar[XB_XGEN(b.x)], 1u);
      asm volatile("s_waitcnt vmcnt(0)" ::: "memory");
    } else {
      XB_SPIN(xb_ld(&bar[XB_XGEN(b.x)]) == gen, bar);
      __builtin_amdgcn_fence(__ATOMIC_ACQUIRE, "agent");
      asm volatile("s_waitcnt vmcnt(0)" ::: "memory");
    }
  }
  __syncthreads();
}

template <int PH> DEVINL void run_phase(const Params& p) {
  if (PH == 0) phase0(p);
  else if (PH == 1) phase1(p);
  else if (PH == 2) phase2(p);
  else if (PH == 3) phase3(p);
  else if (PH == 4) phase4(p);
  else if (PH == 5) phase5(p);
  else if (PH == 6) phase6(p);
  else if (PH == 7) phase7(p);
  else if (PH == 8) phase8(p);
  else if (PH == 9) phase9(p);
  else if (PH == 10) phase10(p);
  else if (PH == 11) phase11(p);
}

constexpr int SHM_BYTES = 131072;

#if MULTI
template <int PH> __global__ void __launch_bounds__(512, 2) k_phase(Params p) { run_phase<PH>(p); }
template <int PH> static void launch_phase(const Params& p, hipStream_t stream) {
  hipFuncSetAttribute((const void*)k_phase<PH>, hipFuncAttributeMaxDynamicSharedMemorySize, SHM_BYTES);
  k_phase<PH><<<256, 512, SHM_BYTES, stream>>>(p);
}
#else
__global__ void __launch_bounds__(512, 2) k_mega(Params p) {
  cg::grid_group grid = cg::this_grid();
  __shared__ uint4 xb_words;
  unsigned* bar = (unsigned*)(p.ws + O_BAR);
  if (threadIdx.x == 0) xb_words = make_uint4(0u, 0u, 0u, 0u);
  __syncthreads();
  XcdBarrier xb = xcd_barrier_post(bar, (volatile LAS unsigned*)&xb_words);
  if (p.out == nullptr) grid.sync();
  run_phase<0>(p); xcd_barrier(xb);
  run_phase<1>(p); xcd_barrier(xb);
  run_phase<2>(p); xcd_barrier(xb);
  run_phase<3>(p); xcd_barrier(xb);
  run_phase<4>(p); xcd_barrier(xb);
  run_phase<5>(p); xcd_barrier(xb);
  run_phase<6>(p); xcd_barrier(xb);
  run_phase<7>(p); xcd_barrier(xb);
  run_phase<8>(p); xcd_barrier(xb);
  run_phase<9>(p); xcd_barrier(xb);
  run_phase<10>(p); xcd_barrier(xb);
  run_phase<11>(p);
}
#endif

extern "C" void kernel_launch(void* const* d_in, const int* in_sizes, int n_in, void* d_out, int out_size,
                              void* d_ws, size_t ws_size, hipStream_t stream) {
  Params p{};
  const float** f = (const float**)&p;
  for (int i = 0; i < 31; ++i) f[i] = (const float*)d_in[i];
  p.out = (float*)d_out;
  p.ws = (char*)d_ws;
  if (ws_size < WS_NEED) { fprintf(stderr, "workspace too small: %zu < %zu\n", ws_size, (size_t)WS_NEED); return; }
#if MULTI
  launch_phase<0>(p, stream); launch_phase<1>(p, stream); launch_phase<2>(p, stream); launch_phase<3>(p, stream);
  launch_phase<4>(p, stream); launch_phase<5>(p, stream); launch_phase<6>(p, stream); launch_phase<7>(p, stream);
  launch_phase<8>(p, stream); launch_phase<9>(p, stream); launch_phase<10>(p, stream); launch_phase<11>(p, stream);
#else
  static int grid_blocks = 0;
  if (!grid_blocks) {
    int dev = 0, cus = 0, per_cu = 0;
    hipGetDevice(&dev);
    hipDeviceGetAttribute(&cus, hipDeviceAttributeMultiprocessorCount, dev);
    hipFuncSetAttribute((const void*)k_mega, hipFuncAttributeMaxDynamicSharedMemorySize, SHM_BYTES);
    hipOccupancyMaxActiveBlocksPerMultiprocessor(&per_cu, k_mega, 512, SHM_BYTES);
    if (per_cu < 1) per_cu = 1;
    grid_blocks = cus * per_cu;
    if (grid_blocks > 256) grid_blocks = 256;
  }
  hipMemsetAsync((char*)d_ws + O_BAR, 0, XCD_BAR_WORDS * sizeof(unsigned), stream);
  void* args[] = {&p};
  hipError_t e = hipLaunchCooperativeKernel((void*)k_mega, dim3(grid_blocks), dim3(512), args, SHM_BYTES, stream);
  if (e != hipSuccess) fprintf(stderr, "cooperative launch failed: %s (grid %d)\n", hipGetErrorString(e), grid_blocks);
#endif
}
```
